# Optimizing an MI355X kernel written in HIP

```python
import jax, jax.numpy as jnp
from jax import lax
import numpy as np

D_MODEL = 1024
BATCH = 8
SEQ = 2048
DEPTH = 2

MEM_LEN = 256
MEM_HEADS = 4
MEM_HEAD_DIM = D_MODEL // MEM_HEADS
D_FF = 2816
POOL_WINDOWS = (2, 4, 8, 16)
POOL_WIDTH = 512
POOL_GROUP = POOL_WIDTH // 4
NSA_HEADS = 8
NSA_KV_HEADS = 2
NSA_HPG = NSA_HEADS // NSA_KV_HEADS
NSA_HEAD_DIM = 64
NSA_WIDTH = NSA_HEADS * NSA_HEAD_DIM
NSA_KV_WIDTH = NSA_KV_HEADS * NSA_HEAD_DIM
CMP_BLOCK = 32
CMP_STRIDE = 16
CMP_HIDDEN = 256
SEL_BLOCK = 64
SEL_TOPK = 8
WINDOW = 256
Q_BLOCK = 128
GMLP_WIDTH = 512
GMLP_GROUPS = 4
GMLP_GROUP_DIM = GMLP_WIDTH // GMLP_GROUPS
GMLP_CHUNK = 128
IN_SIZES = (POOL_WIDTH, NSA_WIDTH, 6 * NSA_KV_WIDTH, 3 * NSA_HEADS, 2 * GMLP_WIDTH, 3 * D_MODEL)
IN_COLS = POOL_WIDTH + NSA_WIDTH + 6 * NSA_KV_WIDTH + 3 * NSA_HEADS + 2 * GMLP_WIDTH + 3 * D_MODEL
EPS = 1e-6
NEG = -1e30

kernel_name = "hybrid_pool_nsa_gmlp_macaron_block"


def rmsnorm(x, g):
    xf = x.astype(jnp.float32)
    y = xf * lax.rsqrt(jnp.mean(xf * xf, axis=-1, keepdims=True) + EPS)
    return (y * g.astype(jnp.float32)).astype(x.dtype)


def layernorm(x, g, b):
    xf = x.astype(jnp.float32)
    mu = jnp.mean(xf, axis=-1, keepdims=True)
    var = jnp.mean(jnp.square(xf - mu), axis=-1, keepdims=True)
    y = (xf - mu) * lax.rsqrt(var + EPS) * g.astype(jnp.float32) + b.astype(jnp.float32)
    return y.astype(x.dtype)


def masked_softmax(s, valid):
    s = jnp.where(valid, s.astype(jnp.float32), NEG)
    return jnp.where(valid, jax.nn.softmax(s, axis=-1), 0.0)


def swiglu(h, w1, w3, w2):
    return (jax.nn.silu(h @ w1) * (h @ w3)) @ w2


def pool_mixer(a, pool_w, pool_scale):
    B, S, _ = a.shape
    csum = jnp.cumsum(a.astype(jnp.float32), axis=1)
    count = jnp.arange(1, S + 1, dtype=jnp.float32)[:, None]
    means = []
    for gi, w in enumerate(POOL_WINDOWS):
        c = csum[..., gi * POOL_GROUP:(gi + 1) * POOL_GROUP]
        lagged = jnp.pad(c, ((0, 0), (w, 0), (0, 0)))[:, :S]
        means.append((c - lagged) / jnp.minimum(count, float(w)))
    pooled = jnp.concatenate(means, axis=-1).astype(a.dtype) - a
    pooled = pooled.reshape(B, S, len(POOL_WINDOWS), POOL_GROUP)
    mixed = jnp.einsum('bsgc,gcd->bsgd', pooled, pool_w).reshape(B, S, POOL_WIDTH)
    return mixed * pool_scale


def compress_blocks(kv, pos_emb, w1, w2):
    S = kv.shape[1]
    n_cmp = (S - CMP_BLOCK) // CMP_STRIDE + 1
    idx = np.arange(n_cmp)[:, None] * CMP_STRIDE + np.arange(CMP_BLOCK)[None, :]
    blocks = kv[:, idx] + pos_emb[:, None, :]
    h = jax.nn.gelu(jnp.einsum('bnlgd,ldh->bngh', blocks, w1))
    return jnp.einsum('bngh,hd->bngd', h, w2)


def cmp_sel_overlap(n_cmp, n_sel):
    cs = np.arange(n_cmp)[:, None] * CMP_STRIDE
    ss = np.arange(n_sel)[None, :] * SEL_BLOCK
    ov = np.minimum(cs + CMP_BLOCK, ss + SEL_BLOCK) - np.maximum(cs, ss)
    return (np.maximum(ov, 0) / CMP_BLOCK).astype(np.float32)


def nsa_mixer(q, k_cmp, v_cmp, k_slc, v_slc, k_win, v_win, gate_logits,
              cmp_pos_k, cmp_w1_k, cmp_w2_k, cmp_pos_v, cmp_w1_v, cmp_w2_v):
    B, S = q.shape[:2]
    G, HPG, dk = NSA_KV_HEADS, NSA_HPG, NSA_HEAD_DIM
    dt = q.dtype
    scale = dk ** -0.5
    qg = q.reshape(B, S, G, HPG, dk)
    pos = jnp.arange(S)

    n_cmp = (S - CMP_BLOCK) // CMP_STRIDE + 1
    kc = compress_blocks(k_cmp, cmp_pos_k, cmp_w1_k, cmp_w2_k)
    vc = compress_blocks(v_cmp, cmp_pos_v, cmp_w1_v, cmp_w2_v)
    s_cmp = jnp.einsum('bsghd,bngd->bghsn', qg, kc) * scale
    cmp_end = jnp.arange(n_cmp) * CMP_STRIDE + CMP_BLOCK - 1
    p_cmp = masked_softmax(s_cmp, cmp_end[None, :] <= pos[:, None])
    o_cmp = jnp.einsum('bghsn,bngd->bsghd', p_cmp.astype(dt), vc)

    n_sel = S // SEL_BLOCK
    top_k = min(SEL_TOPK, n_sel)
    imp = jnp.einsum('bghsn,nj->bgsj', p_cmp, jnp.asarray(cmp_sel_overlap(n_cmp, n_sel)))
    blk = jnp.arange(n_sel)[None, :]
    cur = (pos // SEL_BLOCK)[:, None]
    forced = (blk == 0) | (blk == cur) | (blk == cur - 1)
    valid = blk * SEL_BLOCK <= pos[:, None]
    imp = jnp.where(forced, 1e9, jnp.where(valid, imp, -1.0))
    _, sel_idx = lax.top_k(imp, top_k)

    n_q = S // Q_BLOCK
    ks_blk = k_slc.reshape(B, n_sel, SEL_BLOCK, G, dk).transpose(0, 3, 1, 2, 4)
    vs_blk = v_slc.reshape(B, n_sel, SEL_BLOCK, G, dk).transpose(0, 3, 1, 2, 4)
    bi = jnp.arange(B)[:, None, None, None]
    gi = jnp.arange(G)[None, :, None, None]
    q_blocks = qg.reshape(B, n_q, Q_BLOCK, G, HPG, dk).transpose(1, 0, 2, 3, 4, 5)
    idx_blocks = sel_idx.reshape(B, G, n_q, Q_BLOCK, top_k).transpose(2, 0, 1, 3, 4)
    starts = jnp.arange(n_q) * Q_BLOCK

    def sel_block(args):
        qb, ib, st = args
        k_sel = ks_blk[bi, gi, ib]
        v_sel = vs_blk[bi, gi, ib]
        s = jnp.einsum('btghd,bgtkld->bghtkl', qb, k_sel) * scale
        t = st + jnp.arange(Q_BLOCK)
        key_pos = ib[..., None] * SEL_BLOCK + jnp.arange(SEL_BLOCK)
        m = (key_pos <= t[None, None, :, None, None]).reshape(B, G, 1, Q_BLOCK, top_k * SEL_BLOCK)
        sh = s.shape
        p = masked_softmax(s.reshape(sh[0], sh[1], sh[2], sh[3], top_k * SEL_BLOCK), m).reshape(sh)
        return jnp.einsum('bghtkl,bgtkld->btghd', p.astype(v_sel.dtype), v_sel)

    o_sel = lax.map(sel_block, (q_blocks, idx_blocks, starts))
    o_sel = o_sel.transpose(1, 0, 2, 3, 4, 5).reshape(B, S, G, HPG, dk)

    n_shift = WINDOW // Q_BLOCK

    def windows(kv):
        kpad = jnp.pad(kv, ((0, 0), (WINDOW, 0), (0, 0), (0, 0)))
        kb = kpad.reshape(B, n_q + n_shift, Q_BLOCK, G, dk)
        return jnp.concatenate([kb[:, i:i + n_q] for i in range(n_shift + 1)], axis=2)

    kwb = windows(k_win)
    vwb = windows(v_win)
    qb_all = qg.reshape(B, n_q, Q_BLOCK, G, HPG, dk)
    s_win = jnp.einsum('bqtghd,bqjgd->bqghtj', qb_all, kwb) * scale
    i = jnp.arange(Q_BLOCK)[:, None]
    j = jnp.arange(WINDOW + Q_BLOCK)[None, :]
    key_pos = starts[:, None, None] - WINDOW + j[None]
    wmask = (j > i) & (j <= i + WINDOW) & (key_pos >= 0)
    p_win = masked_softmax(s_win, wmask[None, :, None, None])
    o_win = jnp.einsum('bqghtj,bqjgd->bqtghd', p_win.astype(dt), vwb).reshape(B, S, G, HPG, dk)

    g = jax.nn.sigmoid(gate_logits.reshape(B, S, G, HPG, 3))
    o = g[..., 0:1] * o_cmp + g[..., 1:2] * o_sel + g[..., 2:3] * o_win
    return o.reshape(B, S, NSA_WIDTH)


def gmlp_mixer(z, ln_g, ln_b, ws, bs):
    B, S, _ = z.shape
    z = jax.nn.gelu(z)
    u, v = jnp.split(z, 2, axis=-1)
    v = layernorm(v, ln_g, ln_b)
    n_chunk = S // GMLP_CHUNK
    v = v.reshape(B, n_chunk, GMLP_CHUNK, GMLP_GROUPS, GMLP_GROUP_DIM)
    causal = jnp.tril(jnp.ones((GMLP_CHUNK, GMLP_CHUNK), dtype=bool))
    w = jnp.where(causal[None], ws, 0.0).astype(v.dtype)
    s = jnp.einsum('gts,bcsgd->bctgd', w, v) + bs.T[None, None, :, :, None]
    return u * s.reshape(B, S, GMLP_WIDTH)


def token_mixer(h, w_in, b_in, pool_w, pool_scale,
                cmp_pos_k, cmp_w1_k, cmp_w2_k, cmp_pos_v, cmp_w1_v, cmp_w2_v,
                gmlp_ln_g, gmlp_ln_b, gmlp_ws, gmlp_bs,
                w_br_pool, w_br_nsa, w_br_gmlp, w_mix_out):
    B, S, _ = h.shape
    z = h @ w_in + b_in
    offs = np.cumsum(IN_SIZES)[:-1].tolist()
    a, q, kv, nsa_g, gm, mg = jnp.split(z, offs, axis=-1)
    q = q.reshape(B, S, NSA_HEADS, NSA_HEAD_DIM)
    kv = kv.reshape(B, S, 6, NSA_KV_HEADS, NSA_HEAD_DIM)
    y_pool = pool_mixer(a, pool_w, pool_scale) @ w_br_pool
    y_nsa = nsa_mixer(q, kv[:, :, 0], kv[:, :, 1], kv[:, :, 2], kv[:, :, 3], kv[:, :, 4], kv[:, :, 5], nsa_g,
                      cmp_pos_k, cmp_w1_k, cmp_w2_k, cmp_pos_v, cmp_w1_v, cmp_w2_v) @ w_br_nsa
    y_gmlp = gmlp_mixer(gm, gmlp_ln_g, gmlp_ln_b, gmlp_ws, gmlp_bs) @ w_br_gmlp
    g_pool, g_nsa, g_gmlp = jnp.split(jax.nn.sigmoid(mg), 3, axis=-1)
    return (g_pool * y_pool + g_nsa * y_nsa + g_gmlp * y_gmlp) @ w_mix_out


def memory_cross_attention(h, mem_n, wq, wk, wv, wo):
    B, S, _ = h.shape
    M = mem_n.shape[1]
    q = (h @ wq).reshape(B, S, MEM_HEADS, MEM_HEAD_DIM)
    k = (mem_n @ wk).reshape(B, M, MEM_HEADS, MEM_HEAD_DIM)
    v = (mem_n @ wv).reshape(B, M, MEM_HEADS, MEM_HEAD_DIM)
    s = jnp.einsum('bshd,bmhd->bhsm', q, k).astype(jnp.float32) * (MEM_HEAD_DIM ** -0.5)
    p = jax.nn.softmax(s, axis=-1).astype(v.dtype)
    o = jnp.einsum('bhsm,bmhd->bshd', p, v).reshape(B, S, D_MODEL)
    return o @ wo


def setup_inputs(seed: int = 0) -> dict:
    key = jax.random.key(seed)
    keys = iter(jax.random.split(key, 48))
    L = DEPTH

    def w(shape, fan_in):
        return jax.random.normal(next(keys), shape, jnp.float32) * fan_in ** -0.5

    def gain(shape):
        return 1.0 + 0.05 * jax.random.normal(next(keys), shape, jnp.float32)

    def small(shape):
        return 0.02 * jax.random.normal(next(keys), shape, jnp.float32)

    return {
        "x": jax.random.normal(next(keys), (BATCH, SEQ, D_MODEL), jnp.float32),
        "mem": jax.random.normal(next(keys), (BATCH, MEM_LEN, D_MODEL), jnp.float32),
        "ff1_pre_g": gain((L, D_MODEL)),
        "ff1_w1": w((L, D_MODEL, D_FF), D_MODEL),
        "ff1_w3": w((L, D_MODEL, D_FF), D_MODEL),
        "ff1_w2": w((L, D_FF, D_MODEL), D_FF),
        "ff1_post_g": gain((L, D_MODEL)),
        "mix_pre_g": gain((L, D_MODEL)),
        "w_in": w((L, D_MODEL, IN_COLS), D_MODEL),
        "b_in": small((L, IN_COLS)),
        "pool_w": w((L, len(POOL_WINDOWS), POOL_GROUP, POOL_GROUP), POOL_GROUP),
        "pool_scale": gain((L, POOL_WIDTH)),
        "cmp_pos_k": small((L, CMP_BLOCK, NSA_HEAD_DIM)),
        "cmp_w1_k": w((L, CMP_BLOCK, NSA_HEAD_DIM, CMP_HIDDEN), CMP_BLOCK * NSA_HEAD_DIM),
        "cmp_w2_k": w((L, CMP_HIDDEN, NSA_HEAD_DIM), CMP_HIDDEN),
        "cmp_pos_v": small((L, CMP_BLOCK, NSA_HEAD_DIM)),
        "cmp_w1_v": w((L, CMP_BLOCK, NSA_HEAD_DIM, CMP_HIDDEN), CMP_BLOCK * NSA_HEAD_DIM),
        "cmp_w2_v": w((L, CMP_HIDDEN, NSA_HEAD_DIM), CMP_HIDDEN),
        "gmlp_ln_g": gain((L, GMLP_WIDTH)),
        "gmlp_ln_b": small((L, GMLP_WIDTH)),
        "gmlp_ws": w((L, GMLP_GROUPS, GMLP_CHUNK, GMLP_CHUNK), GMLP_CHUNK),
        "gmlp_bs": gain((L, GMLP_GROUPS, GMLP_CHUNK)),
        "w_br_pool": w((L, POOL_WIDTH, D_MODEL), POOL_WIDTH),
        "w_br_nsa": w((L, NSA_WIDTH, D_MODEL), NSA_WIDTH),
        "w_br_gmlp": w((L, GMLP_WIDTH, D_MODEL), GMLP_WIDTH),
        "w_mix_out": w((L, D_MODEL, D_MODEL), D_MODEL),
        "mix_post_g": gain((L, D_MODEL)),
        "mem_pre_g": gain((L, D_MODEL)),
        "mem_kv_g": gain((L, D_MODEL)),
        "mem_wq": w((L, D_MODEL, D_MODEL), D_MODEL),
        "mem_wk": w((L, D_MODEL, D_MODEL), D_MODEL),
        "mem_wv": w((L, D_MODEL, D_MODEL), D_MODEL),
        "mem_wo": w((L, D_MODEL, D_MODEL), D_MODEL),
        "mem_post_g": gain((L, D_MODEL)),
        "ff2_pre_g": gain((L, D_MODEL)),
        "ff2_w1": w((L, D_MODEL, D_FF), D_MODEL),
        "ff2_w3": w((L, D_MODEL, D_FF), D_MODEL),
        "ff2_w2": w((L, D_FF, D_MODEL), D_FF),
        "ff2_post_g": gain((L, D_MODEL)),
    }


def reference(x, mem,
              ff1_pre_g, ff1_w1, ff1_w3, ff1_w2, ff1_post_g,
              mix_pre_g, w_in, b_in, pool_w, pool_scale,
              cmp_pos_k, cmp_w1_k, cmp_w2_k, cmp_pos_v, cmp_w1_v, cmp_w2_v,
              gmlp_ln_g, gmlp_ln_b, gmlp_ws, gmlp_bs,
              w_br_pool, w_br_nsa, w_br_gmlp, w_mix_out, mix_post_g,
              mem_pre_g, mem_kv_g, mem_wq, mem_wk, mem_wv, mem_wo, mem_post_g,
              ff2_pre_g, ff2_w1, ff2_w3, ff2_w2, ff2_post_g):
    for l in range(DEPTH):
        h = rmsnorm(x, ff1_pre_g[l])
        x = x + 0.5 * rmsnorm(swiglu(h, ff1_w1[l], ff1_w3[l], ff1_w2[l]), ff1_post_g[l])
        h = rmsnorm(x, mix_pre_g[l])
        y = token_mixer(h, w_in[l], b_in[l], pool_w[l], pool_scale[l],
                        cmp_pos_k[l], cmp_w1_k[l], cmp_w2_k[l], cmp_pos_v[l], cmp_w1_v[l], cmp_w2_v[l],
                        gmlp_ln_g[l], gmlp_ln_b[l], gmlp_ws[l], gmlp_bs[l],
                        w_br_pool[l], w_br_nsa[l], w_br_gmlp[l], w_mix_out[l])
        x = x + rmsnorm(y, mix_post_g[l])
        h = rmsnorm(x, mem_pre_g[l])
        y = memory_cross_attention(h, rmsnorm(mem, mem_kv_g[l]), mem_wq[l], mem_wk[l], mem_wv[l], mem_wo[l])
        x = x + rmsnorm(y, mem_post_g[l])
        h = rmsnorm(x, ff2_pre_g[l])
        x = x + 0.5 * rmsnorm(swiglu(h, ff2_w1[l], ff2_w3[l], ff2_w2[l]), ff2_post_g[l])
    return x
```

```cpp
#include <hip/hip_runtime.h>
#include <hip/hip_cooperative_groups.h>
#include <cstdio>
#include <cstdint>
namespace cg = cooperative_groups;
namespace pg8 {
#define PG8_LAS __attribute__((address_space(3)))
typedef unsigned short bf16_t;
typedef short bf16x8 __attribute__((ext_vector_type(8)));
typedef float f32x4 __attribute__((ext_vector_type(4)));
typedef unsigned u32x4 __attribute__((ext_vector_type(4)));
constexpr int BM = 256, BK = 64, HALF = 128, HTB = HALF * BK * 2  , STAGE_BYTES = 8 * HTB, NXCD = 8, WGM = 8;

__host__ __device__ __forceinline__ int lds_byte(int r, int c) { const int st = (r >> 4) * 2 + (c >> 5), rr = r & 15, cc = c & 31, ob = rr * 64 + cc * 2; return st * 1024 + (ob ^ (((ob >> 9) & 1) << 5)); }
__host__ __device__ __forceinline__ void stage_rc(int b, int& R, int& C) { const int st = b / 1024, sb = b % 1024, swz = sb ^ (((sb >> 9) & 1) << 5); R = (st >> 1) * 16 + swz / 64; C = (st & 1) * 32 + (swz % 64) / 2; }
__host__ __device__ __forceinline__ int perm32(int rho) { const int n = rho >> 4, i = rho & 15; return 8 * (i >> 2) + 4 * n + (i & 3); }

struct Unit { int pm, pn; };
struct Gemm { const bf16_t* A; const bf16_t* Bt; int M, N, K; };

struct StaticOrder {
    int nM, nN, nwg, G, c;
    __host__ __device__ void init(int M, int N, int G_, int c_) { nM = M / BM; nN = N / BM; nwg = nM * nN; G = G_; c = c_; }
    __host__ __device__ bool next(int i, Unit& u) const {
        const long L = (long)i * G + c; if (L >= nwg) return false;
        int wgid = (int)L; { const int q = nwg / NXCD, r = nwg % NXCD, xcd = wgid % NXCD, off = wgid / NXCD; wgid = (xcd < r ? xcd * (q + 1) : r * (q + 1) + (xcd - r) * q) + off; }
        const int nig = WGM * nN, gid = wgid / nig, fm = gid * WGM, gsz = (nM - fm) < WGM ? (nM - fm) : WGM;
        u.pm = fm + ((wgid % nig) % gsz); u.pn = (wgid % nig) / gsz; return true;
    }
    __device__ __forceinline__ void a_ready(const Unit&) const {}
    __device__ __forceinline__ void done(const Unit&) const {}
};

typedef float f32x2_cv __attribute__((ext_vector_type(2))); typedef __bf16 bf16x2_cv __attribute__((ext_vector_type(2)));
__device__ __forceinline__ unsigned cvt_pk_bf16(float lo, float hi) { const f32x2_cv v = {lo, hi}; const bf16x2_cv b = __builtin_convertvector(v, bf16x2_cv); return __builtin_bit_cast(unsigned, b); }
typedef float f32x2 __attribute__((ext_vector_type(2)));
typedef unsigned u32x2 __attribute__((ext_vector_type(2)));
__device__ __forceinline__ float fsigmoid(float v) { return __builtin_amdgcn_rcpf(1.0f + __expf(-v)); }
__device__ __forceinline__ float fgelu_tanh(float v) { const float z = 1.5957691216f * (v + 0.044715f * v * v * v); return v * fsigmoid(z); }
__device__ __forceinline__ float bflo(unsigned w) { return __uint_as_float(w << 16); }
__device__ __forceinline__ float bfhi(unsigned w) { return __uint_as_float(w & 0xffff0000u); }

struct EpiF32 {
    static constexpr bool PERM = false, AFTER_DRAIN = false;
    float* C; int ldc;
    __device__ __forceinline__ void operator()(const f32x4 (&acc)[2][2][4][2], const Unit& u, int wr, int wc, int fr, int fq) const {
        const int row0 = u.pm * BM + wr * 64 + fr, col0 = u.pn * BM + wc * 32 + 4 * fq;
#pragma unroll
        for (int ai = 0; ai < 2; ++ai)
#pragma unroll
            for (int m = 0; m < 4; ++m) { float* rowp = C + (size_t)(row0 + ai * HALF + m * 16) * ldc + col0;
#pragma unroll
                for (int bj = 0; bj < 2; ++bj)
#pragma unroll
                    for (int n = 0; n < 2; ++n) *(f32x4*)(rowp + bj * HALF + n * 16) = acc[ai][bj][m][n]; }
    }
};
struct EpiBf16S {
    static constexpr bool PERM = true, AFTER_DRAIN = false;
    bf16_t* O; int ldc; float scale;
    __device__ __forceinline__ void operator()(const f32x4 (&acc)[2][2][4][2], const Unit& u, int wr, int wc, int fr, int fq) const {
        const int row0 = u.pm * BM + wr * 64 + fr, col0 = u.pn * BM + wc * 32 + 8 * fq;
#pragma unroll
        for (int ai = 0; ai < 2; ++ai)
#pragma unroll
            for (int m = 0; m < 4; ++m) { bf16_t* rowp = O + (size_t)(row0 + ai * HALF + m * 16) * ldc + col0;
#pragma unroll
                for (int bj = 0; bj < 2; ++bj) { const f32x4 v0 = acc[ai][bj][m][0] * scale, v1 = acc[ai][bj][m][1] * scale;
                    u32x4 w; w.x = cvt_pk_bf16(v0[0], v0[1]); w.y = cvt_pk_bf16(v0[2], v0[3]); w.z = cvt_pk_bf16(v1[0], v1[1]); w.w = cvt_pk_bf16(v1[2], v1[3]);
                    *(u32x4*)(rowp + bj * HALF) = w; } }
    }
};
struct EpiSwiGLU {
    static constexpr bool PERM = true, AFTER_DRAIN = false;
    bf16_t* H; int ldh;
    __device__ __forceinline__ void operator()(const f32x4 (&acc)[2][2][4][2], const Unit& u, int wr, int wc, int fr, int fq) const {
        const int row0 = u.pm * BM + wr * 64 + fr, col0 = u.pn * HALF + wc * 32 + 8 * fq;
#pragma unroll
        for (int ai = 0; ai < 2; ++ai)
#pragma unroll
            for (int m = 0; m < 4; ++m) { bf16_t* p = H + (size_t)(row0 + ai * HALF + m * 16) * ldh + col0;
                f32x4 h0, h1;
#pragma unroll
                for (int i = 0; i < 4; ++i) { const float g0 = acc[ai][0][m][0][i], g1 = acc[ai][0][m][1][i];
                    h0[i] = g0 * fsigmoid(g0) * acc[ai][1][m][0][i]; h1[i] = g1 * fsigmoid(g1) * acc[ai][1][m][1][i]; }
                u32x4 w; w.x = cvt_pk_bf16(h0[0], h0[1]); w.y = cvt_pk_bf16(h0[2], h0[3]); w.z = cvt_pk_bf16(h1[0], h1[1]); w.w = cvt_pk_bf16(h1[2], h1[3]);
                *(u32x4*)p = w; }
    }
};
struct EpiZin {
    static constexpr bool PERM = true, AFTER_DRAIN = false;
    const float* bias; bf16_t *ZA, *ZQ, *ZKV, *ZGM, *ZG; int mode;
    __device__ __forceinline__ void operator()(const f32x4 (&acc)[2][2][4][2], const Unit& u, int wr, int wc, int fr, int fq) const {
        const int pn = u.pn; const int row0 = u.pm * BM + wr * 64 + fr;
        bf16_t* base; int ld, cb; int act = 0; float sc = 1.f; bool only0 = false;
        if (mode == 1) { base = ZA; ld = 3072; cb = pn * 256; act = 2; }
        else if (pn < 2) { base = ZA; ld = 512; cb = pn * 256; }
        else if (pn < 4) { base = ZQ; ld = 512; cb = (pn - 2) * 256; sc = 0.125f; }
        else if (pn < 7) { base = ZKV; ld = 768; cb = (pn - 4) * 256; }
        else if (pn < 11) { base = ZGM; ld = 1024; cb = (pn - 7) * 256; act = 1; }
        else { base = ZG; ld = 32; cb = 0; only0 = true; }
        const int ct = wc * 32 + 8 * fq;
        bf16_t* bp = base + (size_t)row0 * ld + cb + ct;
        f32x4 bv[2][2];
#pragma unroll
        for (int bj = 0; bj < 2; ++bj)
#pragma unroll
            for (int n = 0; n < 2; ++n) bv[bj][n] = *(const f32x4*)(bias + pn * 256 + bj * HALF + ct + 4 * n);
#pragma unroll
        for (int ai = 0; ai < 2; ++ai)
#pragma unroll
            for (int m = 0; m < 4; ++m) {
#pragma unroll
                for (int bj = 0; bj < 2; ++bj) {
                    f32x4 v0 = (acc[ai][bj][m][0] + bv[bj][0]) * sc, v1 = (acc[ai][bj][m][1] + bv[bj][1]) * sc;
                    if (act == 1) {
#pragma unroll
                        for (int i = 0; i < 4; ++i) { v0[i] = fgelu_tanh(v0[i]); v1[i] = fgelu_tanh(v1[i]); } }
                    else if (act == 2) {
#pragma unroll
                        for (int i = 0; i < 4; ++i) { v0[i] = fsigmoid(v0[i]); v1[i] = fsigmoid(v1[i]); } }
                    u32x4 w; w.x = cvt_pk_bf16(v0[0], v0[1]); w.y = cvt_pk_bf16(v0[2], v0[3]); w.z = cvt_pk_bf16(v1[0], v1[1]); w.w = cvt_pk_bf16(v1[2], v1[3]);
                    if (!only0 || (wc == 0 && bj == 0)) *(u32x4*)(bp + (ai * HALF + m * 16) * ld + bj * HALF) = w; }
                asm volatile("" ::: "memory"); }
    }
};
struct EpiMerge {
    static constexpr bool PERM = true, AFTER_DRAIN = false;
    const bf16_t* G; int goff; bf16_t* MRG; int accum;
    __device__ __forceinline__ void operator()(const f32x4 (&acc)[2][2][4][2], const Unit& u, int wr, int wc, int fr, int fq) const {
        const int row0 = u.pm * BM + wr * 64 + fr, col0 = u.pn * BM + wc * 32 + 8 * fq;
#pragma unroll
        for (int ai = 0; ai < 2; ++ai)
#pragma unroll
            for (int m = 0; m < 4; ++m) { const size_t r = (size_t)(row0 + ai * HALF + m * 16);
#pragma unroll
                for (int bj = 0; bj < 2; ++bj) {
#ifdef MERGE_NOGATE
                    const u32x4 g = (u32x4){0x3f803f80u, 0x3f803f80u, 0x3f803f80u, 0x3f803f80u};
#else
                    const u32x4 g = *(const u32x4*)(G + r * 3072 + goff + col0 + bj * HALF);
#endif
                    bf16_t* p = MRG + r * 1024 + col0 + bj * HALF;
                    f32x4 v0 = acc[ai][bj][m][0], v1 = acc[ai][bj][m][1];
                    v0[0] *= bflo(g.x); v0[1] *= bfhi(g.x); v0[2] *= bflo(g.y); v0[3] *= bfhi(g.y);
                    v1[0] *= bflo(g.z); v1[1] *= bfhi(g.z); v1[2] *= bflo(g.w); v1[3] *= bfhi(g.w);
                    if (accum) { const u32x4 o = *(const u32x4*)p;
                        v0[0] += bflo(o.x); v0[1] += bfhi(o.x); v0[2] += bflo(o.y); v0[3] += bfhi(o.y);
                        v1[0] += bflo(o.z); v1[1] += bfhi(o.z); v1[2] += bflo(o.w); v1[3] += bfhi(o.w); }
                    u32x4 w; w.x = cvt_pk_bf16(v0[0], v0[1]); w.y = cvt_pk_bf16(v0[2], v0[3]); w.z = cvt_pk_bf16(v1[0], v1[1]); w.w = cvt_pk_bf16(v1[2], v1[3]);
                    *(u32x4*)p = w; } }
    }
};
template <class Epi, class Sched, bool ALIGN_EPI = false, bool SP2 = false>
__device__ __forceinline__ void gemm_phase(PG8_LAS unsigned char* lds, const Gemm g, const Sched& S, const Epi& E) {
    int tid_o = threadIdx.x; asm volatile("" : "+v"(tid_o));
    const int tid = tid_o, wid = __builtin_amdgcn_readfirstlane(tid >> 6), lane = tid & 63, wr = wid >> 2, wc = wid & 3, fr = lane & 15, fq = lane >> 4;
    const int K = g.K, nt = K / BK;
    unsigned voffA[2], voffB[2];
#pragma unroll
    for (int i = 0; i < 2; ++i) { int R, C; stage_rc(tid * 16 + i * 8192, R, C); const int Rb = Epi::PERM ? ((R & ~31) + perm32(R & 31)) : R;
        voffA[i] = (unsigned)(R * K + C) * 2u; voffB[i] = (unsigned)(Rb * K + C) * 2u; }
    const size_t kstep = (size_t)(BK * 2);
    const size_t hstep = (size_t)HALF * K * 2;
    const size_t tstep = 2 * hstep;
    const unsigned ldsw = (unsigned)wid * 1024u;
    const int aoff = lds_byte(wr * 64 + fr, fq * 8), boff = lds_byte(wc * 32 + fr, fq * 8);
#define PG8_SA(b, h) (((b) * 2 + (h)) * HTB)
#define PG8_SB(b, h) ((4 + (b) * 2 + (h)) * HTB)
#define PG8_STAGE(bufoff, gbase, voff) do { _Pragma("unroll") for (int _i = 0; _i < 2; ++_i) \
        __builtin_amdgcn_global_load_lds((const unsigned*)((const char*)(gbase) + (voff)[_i]), (PG8_LAS unsigned*)(lds + (bufoff) + ldsw + _i * 8192), 16, 0, 0); } while (0)
#define PG8_LDA(dst, b, h) do { _Pragma("unroll") for (int m = 0; m < 4; ++m) _Pragma("unroll") for (int k = 0; k < 2; ++k) dst[m][k] = *(const PG8_LAS bf16x8*)(lds + PG8_SA(b, h) + aoff + m * 2048 + k * 1024); } while (0)
#define PG8_LDB(dst, b, h) do { _Pragma("unroll") for (int n = 0; n < 2; ++n) _Pragma("unroll") for (int k = 0; k < 2; ++k) dst[n][k] = *(const PG8_LAS bf16x8*)(lds + PG8_SB(b, h) + boff + n * 2048 + k * 1024); } while (0)
#define PG8_MMA(ai, bj, At, Bt) do { __builtin_amdgcn_s_setprio(1); _Pragma("unroll") for (int m = 0; m < 4; ++m) _Pragma("unroll") for (int n = 0; n < 2; ++n) _Pragma("unroll") for (int k = 0; k < 2; ++k) \
        acc[ai][bj][m][n] = __builtin_amdgcn_mfma_f32_16x16x32_bf16(Bt[n][k], At[m][k], acc[ai][bj][m][n], 0, 0, 0); __builtin_amdgcn_s_setprio(0); } while (0)
#define PG8_WAIT_V(n) asm volatile("s_waitcnt vmcnt(" #n ")" ::: "memory")
#define PG8_WAIT_L(n) asm volatile("s_waitcnt lgkmcnt(" #n ")" ::: "memory")
#define PG8_BAR __builtin_amdgcn_s_barrier()
#define PG8_SCHED __builtin_amdgcn_sched_barrier(0)
    Unit cur, nxt; int ui = 0;
    if (!S.next(0, cur)) return;
    f32x4 acc[2][2][4][2];
#pragma unroll
    for (int a = 0; a < 2; ++a)
#pragma unroll
        for (int b = 0; b < 2; ++b)
#pragma unroll
            for (int m = 0; m < 4; ++m)
#pragma unroll
                for (int n = 0; n < 2; ++n) acc[a][b][m][n] = (f32x4){0.f, 0.f, 0.f, 0.f};
    bf16x8 At[4][2], B0[2][2], B1[2][2];
    const char* cA = (const char*)g.A + (size_t)cur.pm * tstep; const char* cB = (const char*)g.Bt + (size_t)cur.pn * tstep;
    S.a_ready(cur);
    if constexpr (SP2) {
        PG8_STAGE(PG8_SB(0, 0), cB, voffB); PG8_STAGE(PG8_SB(0, 1), cB + hstep, voffB); PG8_STAGE(PG8_SA(0, 0), cA, voffA); PG8_STAGE(PG8_SA(0, 1), cA + hstep, voffA);
        if (wr == 1) PG8_BAR;
        PG8_WAIT_V(2); PG8_BAR;
        PG8_STAGE(PG8_SB(1, 0), cB + kstep, voffB); PG8_STAGE(PG8_SA(1, 0), cA + kstep, voffA); PG8_STAGE(PG8_SB(1, 1), cB + hstep + kstep, voffB);
        PG8_WAIT_V(6); PG8_BAR;
    } else {
        PG8_STAGE(PG8_SB(0, 0), cB, voffB); PG8_STAGE(PG8_SA(0, 0), cA, voffA); PG8_STAGE(PG8_SB(0, 1), cB + hstep, voffB); PG8_STAGE(PG8_SA(0, 1), cA + hstep, voffA);
        if (wr == 1) PG8_BAR;
        PG8_WAIT_V(4); PG8_BAR;
        PG8_STAGE(PG8_SB(1, 0), cB + kstep, voffB); PG8_STAGE(PG8_SA(1, 0), cA + kstep, voffA); PG8_STAGE(PG8_SB(1, 1), cB + hstep + kstep, voffB);
        PG8_WAIT_V(6); PG8_BAR;
    }
    for (;;) {
        const bool has_next = S.next(ui + 1, nxt);
        const char* nA = has_next ? (const char*)g.A + (size_t)nxt.pm * tstep : cA; const char* nB = has_next ? (const char*)g.Bt + (size_t)nxt.pn * tstep : cB;
        for (int t = 0; t < nt; t += 2) {
            const bool last = (t == nt - 2);
            const char* a1 = cA + (size_t)(t + 1) * kstep;
            const char* a2 = last ? nA : cA + (size_t)(t + 2) * kstep; const char* b2 = last ? nB : cB + (size_t)(t + 2) * kstep;
            const char* a3 = a2 + kstep; const char* b3 = b2 + kstep;
            if (last && has_next) S.a_ready(nxt);
            if constexpr (SP2) {
            PG8_LDB(B0, 0, 0); PG8_LDB(B1, 0, 1); PG8_SCHED; PG8_LDA(At, 0, 0); PG8_STAGE(PG8_SA(1, 1), a1 + hstep, voffA);
            PG8_WAIT_V(8); PG8_WAIT_L(0); PG8_BAR; PG8_MMA(0, 0, At, B0); PG8_MMA(0, 1, At, B1); PG8_BAR; PG8_SCHED;
            PG8_LDA(At, 0, 1); PG8_STAGE(PG8_SB(0, 0), b2, voffB); PG8_STAGE(PG8_SB(0, 1), b2 + hstep, voffB); PG8_STAGE(PG8_SA(0, 0), a2, voffA);
            PG8_WAIT_V(8); PG8_WAIT_L(0); PG8_BAR; PG8_MMA(1, 0, At, B0); PG8_MMA(1, 1, At, B1); PG8_BAR; PG8_SCHED;
            PG8_LDB(B0, 1, 0); PG8_LDB(B1, 1, 1); PG8_SCHED; PG8_LDA(At, 1, 0); PG8_STAGE(PG8_SA(0, 1), a2 + hstep, voffA);
            PG8_WAIT_V(8); PG8_WAIT_L(0); PG8_BAR; PG8_MMA(0, 0, At, B0); PG8_MMA(0, 1, At, B1); PG8_BAR; PG8_SCHED;
            PG8_LDA(At, 1, 1); PG8_STAGE(PG8_SB(1, 0), b3, voffB); PG8_STAGE(PG8_SB(1, 1), b3 + hstep, voffB); PG8_STAGE(PG8_SA(1, 0), a3, voffA);
            PG8_WAIT_V(8); PG8_WAIT_L(0); PG8_BAR; PG8_MMA(1, 0, At, B0); PG8_MMA(1, 1, At, B1); PG8_BAR; PG8_SCHED;
            } else {
            PG8_LDB(B0, 0, 0); PG8_SCHED; PG8_LDA(At, 0, 0); PG8_STAGE(PG8_SA(1, 1), a1 + hstep, voffA);
            PG8_WAIT_L(8); PG8_BAR; PG8_WAIT_L(0); PG8_MMA(0, 0, At, B0); PG8_BAR; PG8_SCHED;
            PG8_LDB(B1, 0, 1); PG8_STAGE(PG8_SB(0, 0), b2, voffB);
            PG8_BAR; PG8_WAIT_L(0); PG8_MMA(0, 1, At, B1); PG8_BAR;
            PG8_LDA(At, 0, 1); PG8_STAGE(PG8_SA(0, 0), a2, voffA);
            PG8_BAR; PG8_WAIT_L(0); PG8_MMA(1, 0, At, B0); PG8_BAR; PG8_SCHED;
            PG8_STAGE(PG8_SB(0, 1), b2 + hstep, voffB);
            PG8_WAIT_V(6); PG8_BAR; PG8_MMA(1, 1, At, B1); PG8_BAR;
            PG8_LDB(B0, 1, 0); PG8_SCHED; PG8_LDA(At, 1, 0); PG8_STAGE(PG8_SA(0, 1), a2 + hstep, voffA);
            PG8_WAIT_L(8); PG8_BAR; PG8_WAIT_L(0); PG8_MMA(0, 0, At, B0); PG8_BAR; PG8_SCHED;
            PG8_LDB(B1, 1, 1); PG8_STAGE(PG8_SB(1, 0), b3, voffB);
            PG8_BAR; PG8_WAIT_L(0); PG8_MMA(0, 1, At, B1); PG8_BAR;
            PG8_LDA(At, 1, 1); PG8_STAGE(PG8_SA(1, 0), a3, voffA);
            PG8_BAR; PG8_WAIT_L(0); PG8_MMA(1, 0, At, B0); PG8_BAR; PG8_SCHED;
            PG8_STAGE(PG8_SB(1, 1), b3 + hstep, voffB);
            PG8_WAIT_V(6); PG8_BAR; PG8_MMA(1, 1, At, B1); PG8_BAR;
            }
        }
        if constexpr (ALIGN_EPI) { if (wr == 0) PG8_BAR; }
        if constexpr (!Epi::AFTER_DRAIN) { E(acc, cur, wr, wc, fr, fq); S.done(cur); }
        if (!has_next) break;
#pragma unroll
        for (int a = 0; a < 2; ++a)
#pragma unroll
            for (int b = 0; b < 2; ++b)
#pragma unroll
                for (int m = 0; m < 4; ++m)
#pragma unroll
                    for (int n = 0; n < 2; ++n) acc[a][b][m][n] = (f32x4){0.f, 0.f, 0.f, 0.f};
        cur = nxt; cA = nA; cB = nB; ++ui;
        if constexpr (ALIGN_EPI) { if (wr == 1) PG8_BAR; }
    }
    PG8_WAIT_V(0);
    if constexpr (!ALIGN_EPI) { if (wr == 0) PG8_BAR; }
    PG8_BAR;
    if constexpr (Epi::AFTER_DRAIN) { E.fused(acc, cur, wr, wc, fr, fq, lds, wid, lane); S.done(cur); }
#undef PG8_SA
#undef PG8_SB
#undef PG8_STAGE
#undef PG8_LDA
#undef PG8_LDB
#undef PG8_MMA
#undef PG8_WAIT_V
#undef PG8_WAIT_L
#undef PG8_BAR
#undef PG8_SCHED
}
}
#define LAS __attribute__((address_space(3)))
typedef unsigned short bf16_t;
typedef short bf16x8 __attribute__((ext_vector_type(8)));
typedef short s16x4 __attribute__((ext_vector_type(4)));
typedef float f32x4 __attribute__((ext_vector_type(4)));
typedef unsigned u32x4 __attribute__((ext_vector_type(4)));
typedef unsigned u32x2 __attribute__((ext_vector_type(2)));
using pg8::cvt_pk_bf16; using pg8::fsigmoid; using pg8::bflo; using pg8::bfhi;
#define MFMA16(a, b, c) __builtin_amdgcn_mfma_f32_16x16x32_bf16((a), (b), (c), 0, 0, 0)

constexpr int DM = 1024, NBATCH = 8, SEQ = 2048, MT = NBATCH * SEQ, DFF = 2816, MEML = 256, MM = NBATCH * MEML, DEPTH = 2, INC = 5912;
constexpr int NWAVES = 8, NTHREADS = 512;
constexpr float EPS = 1e-6f, LOG2E = 1.4426950408889634f;
constexpr int PH_PER_LAYER = 17, NPHASES = 1 + DEPTH * PH_PER_LAYER;

enum { I_X = 0, I_MEM, I_FF1_PRE, I_FF1_W1, I_FF1_W3, I_FF1_W2, I_FF1_POST, I_MIX_PRE, I_WIN, I_BIN, I_POOLW, I_POOLS, I_CPK, I_CW1K, I_CW2K, I_CPV, I_CW1V, I_CW2V,
       I_GLNG, I_GLNB, I_GWS, I_GBS, I_WBRP, I_WBRN, I_WBRG, I_WMIX, I_MIX_POST, I_MEM_PRE, I_MEM_KVG, I_WQ, I_WK, I_WV, I_WO, I_MEM_POST, I_FF2_PRE, I_FF2_W1, I_FF2_W3, I_FF2_W2, I_FF2_POST, N_IN };

constexpr size_t MiB = 1u << 20, KiB = 1024;
constexpr size_t WS_W13A = 1 * MiB, WS_W2A = 12 * MiB, WS_W13B = 17 * MiB + 512 * KiB, WS_W2B = 28 * MiB + 512 * KiB, WS_WIN = 34 * MiB, WS_WMG = 40 * MiB,
                 WS_WCOMB = 46 * MiB, WS_WBRN = 47 * MiB, WS_WBRG = 48 * MiB, WS_WMIX = 49 * MiB, WS_WQ = 51 * MiB, WS_WKV = 53 * MiB, WS_WO = 57 * MiB,
                 WS_W1K = 59 * MiB, WS_W1V = 60 * MiB, WS_W2K = 61 * MiB, WS_W2V = 61 * MiB + 32 * KiB, WS_GWS = 61 * MiB + 64 * KiB, WS_BIASIN = 61 * MiB + 192 * KiB,
                 WS_POSB = 61 * MiB + 208 * KiB;
constexpr size_t WS_XN = 62 * MiB, WS_MEMN = 94 * MiB, WS_KVM = 98 * MiB, WS_KC = 106 * MiB, WS_VC = 106 * MiB + 512 * KiB, WS_BIG = 107 * MiB;
constexpr size_t WS_H = WS_BIG, WS_YF = WS_BIG + 88 * MiB;
constexpr size_t WS_ZA = WS_BIG, WS_ZQ = WS_BIG + 16 * MiB, WS_ZKV = WS_BIG + 32 * MiB, WS_ZGM = WS_BIG + 56 * MiB, WS_ZG = WS_BIG + 88 * MiB;
constexpr size_t WS_G = WS_BIG, WS_P = WS_BIG + 96 * MiB, WS_O = WS_BIG + 112 * MiB, WS_U = WS_BIG + 128 * MiB, WS_MRG = WS_BIG + 144 * MiB, WS_YM = WS_BIG;
constexpr size_t WS_QX = WS_BIG, WS_OX = WS_BIG + 32 * MiB;
constexpr size_t WS_END = WS_BIG + 176 * MiB;

constexpr int LDS_BYTES = 147456;

struct Args { const float* in[N_IN]; float* out; unsigned char* ws; int ph_lo, ph_hi; };
typedef const unsigned char __attribute__((address_space(4)))* karg_t;
#define AIN(i) (*(const float* const __attribute__((address_space(4)))*)(kp + 8 * (i)))

__device__ __forceinline__ float wave_sum(float v) {
#pragma unroll
    for (int o = 1; o < 64; o <<= 1) v += __shfl_xor(v, o);
    return v;
}
#define LDS_WAIT() asm volatile("s_waitcnt lgkmcnt(0)" ::: "memory")

struct TSeg { const float* W; int K, N, col0, ncols, nvalid; bf16_t* WT; int mode, row0; };
__device__ __forceinline__ void transpose_item(const TSeg& s, LAS float* scr, int item, int lane) {
    const int nblk = s.ncols / 32, kb = item / nblk, nb = item % nblk, k0 = 64 * kb, n0 = 32 * nb;
    const int nl = n0 + (lane & 31);
#pragma unroll 8
    for (int i = 0; i < 32; ++i) { const int kk = 2 * i + (lane >> 5);
        scr[kk * 33 + (lane & 31)] = (nl < s.nvalid) ? s.W[(size_t)(k0 + kk) * s.N + s.col0 + nl] : 0.f; }
    LDS_WAIT(); asm volatile("" ::: "memory");
    const int c = lane & 7;
#pragma unroll
    for (int j = 0; j < 4; ++j) { const int nloc = (lane >> 3) + 8 * j, n = n0 + nloc; const LAS float* sp = scr + (8 * c) * 33 + nloc;
        const int drow = s.mode == 0 ? s.row0 + n : (n >> 7) * 256 + (n & 127) + s.row0;
        u32x4 o; o.x = cvt_pk_bf16(sp[0 * 33], sp[1 * 33]); o.y = cvt_pk_bf16(sp[2 * 33], sp[3 * 33]); o.z = cvt_pk_bf16(sp[4 * 33], sp[5 * 33]); o.w = cvt_pk_bf16(sp[6 * 33], sp[7 * 33]);
        *(u32x4*)(s.WT + (size_t)drow * s.K + k0 + 8 * c) = o; }
    LDS_WAIT(); asm volatile("" ::: "memory");
}
constexpr int NSEG = 21;
__device__ __forceinline__ TSeg get_seg(karg_t kp, unsigned char* ws, int l, int seg) {
    TSeg s; s.col0 = 0; s.mode = 0; s.row0 = 0;
#define W(idx, per) (AIN(idx) + (size_t)l * (per))
    switch (seg) {
    case 0: s.W = W(I_FF1_W1, (size_t)DM * DFF); s.K = DM; s.N = DFF; s.ncols = DFF; s.WT = (bf16_t*)(ws + WS_W13A); s.mode = 1; s.row0 = 0; break;
    case 1: s.W = W(I_FF1_W3, (size_t)DM * DFF); s.K = DM; s.N = DFF; s.ncols = DFF; s.WT = (bf16_t*)(ws + WS_W13A); s.mode = 1; s.row0 = 128; break;
    case 2: s.W = W(I_FF1_W2, (size_t)DM * DFF); s.K = DFF; s.N = DM; s.ncols = DM; s.WT = (bf16_t*)(ws + WS_W2A); break;
    case 3: s.W = W(I_FF2_W1, (size_t)DM * DFF); s.K = DM; s.N = DFF; s.ncols = DFF; s.WT = (bf16_t*)(ws + WS_W13B); s.mode = 1; s.row0 = 0; break;
    case 4: s.W = W(I_FF2_W3, (size_t)DM * DFF); s.K = DM; s.N = DFF; s.ncols = DFF; s.WT = (bf16_t*)(ws + WS_W13B); s.mode = 1; s.row0 = 128; break;
    case 5: s.W = W(I_FF2_W2, (size_t)DM * DFF); s.K = DFF; s.N = DM; s.ncols = DM; s.WT = (bf16_t*)(ws + WS_W2B); break;
    case 6: s.W = W(I_WIN, (size_t)DM * INC); s.K = DM; s.N = INC; s.col0 = 0; s.ncols = 1792; s.WT = (bf16_t*)(ws + WS_WIN); s.row0 = 0; break;
    case 7: s.W = W(I_WIN, (size_t)DM * INC); s.K = DM; s.N = INC; s.col0 = 1816; s.ncols = 1024; s.WT = (bf16_t*)(ws + WS_WIN); s.row0 = 1792; break;
    case 8: s.W = W(I_WIN, (size_t)DM * INC); s.K = DM; s.N = INC; s.col0 = 1792; s.ncols = 256; s.WT = (bf16_t*)(ws + WS_WIN); s.row0 = 2816; break;
    case 9: s.W = W(I_WIN, (size_t)DM * INC); s.K = DM; s.N = INC; s.col0 = 2840; s.ncols = 3072; s.WT = (bf16_t*)(ws + WS_WMG); break;
    case 10: s.W = W(I_WBRN, (size_t)512 * DM); s.K = 512; s.N = DM; s.ncols = DM; s.WT = (bf16_t*)(ws + WS_WBRN); break;
    case 11: s.W = W(I_WBRG, (size_t)512 * DM); s.K = 512; s.N = DM; s.ncols = DM; s.WT = (bf16_t*)(ws + WS_WBRG); break;
    case 12: s.W = W(I_WMIX, (size_t)DM * DM); s.K = DM; s.N = DM; s.ncols = DM; s.WT = (bf16_t*)(ws + WS_WMIX); break;
    case 13: s.W = W(I_WQ, (size_t)DM * DM); s.K = DM; s.N = DM; s.ncols = DM; s.WT = (bf16_t*)(ws + WS_WQ); break;
    case 14: s.W = W(I_WK, (size_t)DM * DM); s.K = DM; s.N = DM; s.ncols = DM; s.WT = (bf16_t*)(ws + WS_WKV); s.row0 = 0; break;
    case 15: s.W = W(I_WV, (size_t)DM * DM); s.K = DM; s.N = DM; s.ncols = DM; s.WT = (bf16_t*)(ws + WS_WKV); s.row0 = 1024; break;
    case 16: s.W = W(I_WO, (size_t)DM * DM); s.K = DM; s.N = DM; s.ncols = DM; s.WT = (bf16_t*)(ws + WS_WO); break;
    case 17: s.W = W(I_CW1K, (size_t)2048 * 256); s.K = 2048; s.N = 256; s.ncols = 256; s.WT = (bf16_t*)(ws + WS_W1K); break;
    case 18: s.W = W(I_CW1V, (size_t)2048 * 256); s.K = 2048; s.N = 256; s.ncols = 256; s.WT = (bf16_t*)(ws + WS_W1V); break;
    case 19: s.W = W(I_CW2K, (size_t)256 * 64); s.K = 256; s.N = 64; s.ncols = 64; s.WT = (bf16_t*)(ws + WS_W2K); break;
    default: s.W = W(I_CW2V, (size_t)256 * 64); s.K = 256; s.N = 64; s.ncols = 64; s.WT = (bf16_t*)(ws + WS_W2V); break;
    }
#undef W
    s.nvalid = (seg == 8) ? 24 : s.ncols;
    return s;
}
__device__ __forceinline__ void row_pass(const float* Y, const float* gpost, float coef, const float* xin, float* xout, const float* gnext, bf16_t* XN, int nrows, int gw, int NGW, int lane) {
    for (int m = gw; m < nrows; m += NGW) {
        f32x4 xv[4];
#pragma unroll
        for (int j = 0; j < 4; ++j) xv[j] = *((const f32x4*)(xin + (size_t)m * DM) + lane + 64 * j);
        if (Y) {
            f32x4 yv[4]; float ss = 0.f;
#pragma unroll
            for (int j = 0; j < 4; ++j) { yv[j] = *((const f32x4*)(Y + (size_t)m * DM) + lane + 64 * j); ss += (yv[j].x * yv[j].x + yv[j].y * yv[j].y) + (yv[j].z * yv[j].z + yv[j].w * yv[j].w); }
            const float r = coef / sqrtf(wave_sum(ss) * (1.0f / DM) + EPS);
#pragma unroll
            for (int j = 0; j < 4; ++j) { const f32x4 g = *((const f32x4*)gpost + lane + 64 * j); xv[j] = xv[j] + yv[j] * g * r; }
        }
        if (xout) {
#pragma unroll
            for (int j = 0; j < 4; ++j) *((f32x4*)(xout + (size_t)m * DM) + lane + 64 * j) = xv[j];
        }
        if (gnext) {
            float ss = 0.f;
#pragma unroll
            for (int j = 0; j < 4; ++j) ss += (xv[j].x * xv[j].x + xv[j].y * xv[j].y) + (xv[j].z * xv[j].z + xv[j].w * xv[j].w);
            const float r = 1.0f / sqrtf(wave_sum(ss) * (1.0f / DM) + EPS);
#pragma unroll
            for (int j = 0; j < 4; ++j) { const f32x4 g = *((const f32x4*)gnext + lane + 64 * j); const f32x4 o = xv[j] * g * r;
                u32x2 w; w.x = cvt_pk_bf16(o.x, o.y); w.y = cvt_pk_bf16(o.z, o.w);
                *((u32x2*)(XN + (size_t)m * DM) + lane + 64 * j) = w; }
        }
    }
}
__device__ __forceinline__ void prep_layer(karg_t kp, unsigned char* ws, int l, LAS unsigned char* lds, int gw, int NGW, int wave, int lane, int tid, int G, int bid) {
    LAS float* scr = (LAS float*)(lds + wave * 16384);
#pragma unroll
    for (int seg = 0; seg < NSEG; ++seg) {
        karg_t kq = kp; asm volatile("" : "+s"(kq) :: "memory");
        const TSeg s = get_seg(kq, ws, l, seg);
        const int nitems = (s.K / 64) * (s.ncols / 32);
        for (int it = gw; it < nitems; it += NGW) transpose_item(s, scr, it, lane);
    }
    const int gt = bid * NTHREADS + tid, NGT = G * NTHREADS;
    { const float* pw = AIN(I_POOLW) + (size_t)l * 4 * 128 * 128; const float* psc = AIN(I_POOLS) + (size_t)l * 512; const float* wb = AIN(I_WBRP) + (size_t)l * 512 * DM;
      bf16_t* out = (bf16_t*)(ws + WS_WCOMB);
      for (int o = gt; o < 512 * DM; o += NGT) { const int n = o & (DM - 1), k = o >> 10, gi = k >> 7, c = k & 127; float s = 0.f;
          const float* pr = pw + ((size_t)gi * 128 + c) * 128;
          for (int d = 0; d < 128; ++d) s += pr[d] * psc[gi * 128 + d] * wb[(size_t)(gi * 128 + d) * DM + n];
          out[(size_t)n * 512 + k] = (bf16_t)(cvt_pk_bf16(s, 0.f) & 0xffffu); } }
    { const float* gws = AIN(I_GWS) + (size_t)l * 4 * 128 * 128; bf16_t* out = (bf16_t*)(ws + WS_GWS);
      for (int o = gt; o < 4 * 128 * 128; o += NGT) { const int s2 = o & 127, t = (o >> 7) & 127; const float v = (s2 <= t) ? gws[o] : 0.f; out[o] = (bf16_t)(cvt_pk_bf16(v, 0.f) & 0xffffu); } }
    { const float* b = AIN(I_BIN) + (size_t)l * INC; float* out = (float*)(ws + WS_BIASIN);
      for (int o = gt; o < 3072; o += NGT) out[o] = o < 1792 ? b[o] : (o < 2816 ? b[o + 24] : (o < 2840 ? b[1792 + o - 2816] : 0.f)); }
    for (int task = bid; task < 8; task += G) {
        const int which = task >> 2, hb = task & 3, part = tid >> 6, h = hb * 64 + (tid & 63);
        const float* pos = (which ? AIN(I_CPV) : AIN(I_CPK)) + (size_t)l * 2048; const float* w1 = (which ? AIN(I_CW1V) : AIN(I_CW1K)) + (size_t)l * 2048 * 256;
        float s = 0.f;
        for (int k = part * 256; k < part * 256 + 256; ++k) s += pos[k] * w1[(size_t)k * 256 + h];
        LAS float* red = (LAS float*)(lds + 131072);
        __syncthreads(); red[tid] = s; __syncthreads();
        if (tid < 64) { float t = 0.f;
#pragma unroll
            for (int p = 0; p < 8; ++p) t += red[p * 64 + tid];
            ((float*)(ws + WS_POSB))[which * 256 + h] = t; }
        __syncthreads();
    }
    row_pass(nullptr, nullptr, 0.f, AIN(I_MEM), nullptr, AIN(I_MEM_KVG) + (size_t)l * DM, (bf16_t*)(ws + WS_MEMN), MM, gw, NGW, lane);
}
__device__ __forceinline__ void pool_pass(const bf16_t* ZA, bf16_t* P, int gt, int NGT) {
    for (int o = gt; o < MT * 64; o += NGT) {
        const int cc = o & 63, m = o >> 6, t = m & (SEQ - 1), w = 2 << (cc >> 4), cnt = (t + 1 < w) ? t + 1 : w;
        float s[8];
#pragma unroll
        for (int i = 0; i < 8; ++i) s[i] = 0.f;
        u32x4 self = (u32x4){0u, 0u, 0u, 0u};
        for (int i = 0; i < cnt; ++i) { const u32x4 v = *(const u32x4*)(ZA + (size_t)(m - i) * 512 + cc * 8);
            if (i == 0) self = v;
            s[0] += bflo(v.x); s[1] += bfhi(v.x); s[2] += bflo(v.y); s[3] += bfhi(v.y); s[4] += bflo(v.z); s[5] += bfhi(v.z); s[6] += bflo(v.w); s[7] += bfhi(v.w); }
        const float inv = 1.0f / (float)cnt;
        u32x4 r; r.x = cvt_pk_bf16(s[0] * inv - bflo(self.x), s[1] * inv - bfhi(self.x)); r.y = cvt_pk_bf16(s[2] * inv - bflo(self.y), s[3] * inv - bfhi(self.y));
        r.z = cvt_pk_bf16(s[4] * inv - bflo(self.z), s[5] * inv - bfhi(self.z)); r.w = cvt_pk_bf16(s[6] * inv - bflo(self.w), s[7] * inv - bfhi(self.w));
        *(u32x4*)(P + (size_t)m * 512 + cc * 8) = r;
    }
}
__device__ __forceinline__ void compress_unit(int unit, const bf16_t* ZKV, const bf16_t* W1t_k, const bf16_t* W1t_v, const bf16_t* W2t_k, const bf16_t* W2t_v, const float* posb,
                                              bf16_t* KC, bf16_t* VC, LAS unsigned char* lds, int wave, int lane) {
    const int which = unit & 1, nc = (unit >> 1) & 7, g = (unit >> 4) & 1, b = unit >> 5;
    const int r16 = lane & 15, quad = lane >> 4;
    const bf16_t* W1t = which ? W1t_v : W1t_k; const bf16_t* W2t = which ? W2t_v : W2t_k;
    const int n = nc * 16 + r16, ne = n < 127 ? n : 126;
    const bf16_t* arow = ZKV + ((size_t)b * SEQ + 16 * ne) * 768 + which * 128 + g * 64 + quad * 8;
    const bf16_t* b0 = W1t + (size_t)(wave * 32 + r16) * 2048 + quad * 8; const bf16_t* b1 = b0 + (size_t)16 * 2048;
    f32x4 acc0 = (f32x4){0.f, 0.f, 0.f, 0.f}, acc1 = acc0;
#pragma unroll 4
    for (int ks = 0; ks < 64; ++ks) {
        const bf16x8 af = *(const bf16x8*)(arow + (size_t)(ks >> 1) * 768 + (ks & 1) * 32);
        const bf16x8 bf0 = *(const bf16x8*)(b0 + ks * 32), bf1 = *(const bf16x8*)(b1 + ks * 32);
        acc0 = MFMA16(af, bf0, acc0); acc1 = MFMA16(af, bf1, acc1);
    }
    LAS bf16_t* Hs = (LAS bf16_t*)lds;
    { const float pb0 = posb[which * 256 + wave * 32 + r16], pb1 = posb[which * 256 + wave * 32 + 16 + r16];
#pragma unroll
      for (int i = 0; i < 4; ++i) { const int row = quad * 4 + i;
          Hs[row * 264 + wave * 32 + r16] = (bf16_t)(cvt_pk_bf16(pg8::fgelu_tanh(acc0[i] + pb0), 0.f) & 0xffffu);
          Hs[row * 264 + wave * 32 + 16 + r16] = (bf16_t)(cvt_pk_bf16(pg8::fgelu_tanh(acc1[i] + pb1), 0.f) & 0xffffu); } }
    __syncthreads();
    if (wave < 4) {
        f32x4 acc = (f32x4){0.f, 0.f, 0.f, 0.f};
#pragma unroll
        for (int ks = 0; ks < 8; ++ks) {
            const bf16x8 af = *(const LAS bf16x8*)(Hs + r16 * 264 + ks * 32 + quad * 8);
            const bf16x8 bfr = *(const bf16x8*)(W2t + (size_t)(wave * 16 + r16) * 256 + ks * 32 + quad * 8);
            acc = MFMA16(af, bfr, acc);
        }
        bf16_t* out = (which ? VC : KC) + ((size_t)(b * 2 + g) * 128 + nc * 16) * 64 + wave * 16 + r16;
#pragma unroll
        for (int i = 0; i < 4; ++i) { const int row = quad * 4 + i; const float v = (nc * 16 + row < 127) ? acc[i] : 0.f;
            out[(size_t)row * 64] = (bf16_t)(cvt_pk_bf16(v, 0.f) & 0xffffu); }
    }
    __syncthreads();
}
__device__ __forceinline__ void gmlp_unit(int unit, const bf16_t* ZGM, const bf16_t* Wg, const float* lng, const float* lnb, const float* bs, bf16_t* U, LAS unsigned char* lds, int wave, int lane, int tid) {
    const int gq = unit & 3, c = unit >> 2, m0 = c * 128;
    LAS bf16_t* Vt = (LAS bf16_t*)lds;
    LAS float* st = (LAS float*)(lds + 128 * 136 * 2);
    for (int i = 0; i < 16; ++i) { const int tok = wave * 16 + i;
        const u32x4 v = *(const u32x4*)(ZGM + (size_t)(m0 + tok) * 1024 + 512 + lane * 8);
        float f[8] = {bflo(v.x), bfhi(v.x), bflo(v.y), bfhi(v.y), bflo(v.z), bfhi(v.z), bflo(v.w), bfhi(v.w)};
        float s = 0.f;
#pragma unroll
        for (int j = 0; j < 8; ++j) s += f[j];
        const float mean = wave_sum(s) * (1.0f / 512.f); float q = 0.f;
#pragma unroll
        for (int j = 0; j < 8; ++j) { const float d = f[j] - mean; q += d * d; }
        const float rstd = 1.0f / sqrtf(wave_sum(q) * (1.0f / 512.f) + EPS);
        if (lane == 0) { st[tok * 2] = mean; st[tok * 2 + 1] = rstd; } }
    __syncthreads();
    { const int tok = tid >> 2, part = tid & 3; const float mean = st[tok * 2], rstd = st[tok * 2 + 1];
#pragma unroll
      for (int q4 = 0; q4 < 4; ++q4) { const int d0 = part * 32 + q4 * 8, ch = gq * 128 + d0;
          const u32x4 v = *(const u32x4*)(ZGM + (size_t)(m0 + tok) * 1024 + 512 + ch);
          const f32x4 g0 = *(const f32x4*)(lng + ch), g1 = *(const f32x4*)(lng + ch + 4), b0 = *(const f32x4*)(lnb + ch), b1 = *(const f32x4*)(lnb + ch + 4);
          float f[8] = {bflo(v.x), bfhi(v.x), bflo(v.y), bfhi(v.y), bflo(v.z), bfhi(v.z), bflo(v.w), bfhi(v.w)};
          float gg[8] = {g0.x, g0.y, g0.z, g0.w, g1.x, g1.y, g1.z, g1.w}, bb[8] = {b0.x, b0.y, b0.z, b0.w, b1.x, b1.y, b1.z, b1.w};
#pragma unroll
          for (int j = 0; j < 8; ++j) Vt[(d0 + j) * 136 + tok] = (bf16_t)(cvt_pk_bf16((f[j] - mean) * rstd * gg[j] + bb[j], 0.f) & 0xffffu); } }
    __syncthreads();
    { const int r16 = lane & 15, quad = lane >> 4, t = wave * 16 + r16;
      f32x4 acc[8];
#pragma unroll
      for (int dt = 0; dt < 8; ++dt) acc[dt] = (f32x4){0.f, 0.f, 0.f, 0.f};
      const int nks = (wave * 16 + 15) / 32 + 1;
      for (int ks = 0; ks < nks; ++ks) {
          const bf16x8 bfr = *(const bf16x8*)(Wg + ((size_t)gq * 128 + t) * 128 + ks * 32 + quad * 8);
#pragma unroll
          for (int dt = 0; dt < 8; ++dt) { const bf16x8 af = *(const LAS bf16x8*)(Vt + (dt * 16 + r16) * 136 + ks * 32 + quad * 8); acc[dt] = MFMA16(af, bfr, acc[dt]); }
      }
      const float bias = bs[gq * 128 + t];
#pragma unroll
      for (int dt = 0; dt < 8; ++dt) { const int d = gq * 128 + dt * 16 + quad * 4;
          const u32x2 uu = *(const u32x2*)(ZGM + (size_t)(m0 + t) * 1024 + d);
          u32x2 w; w.x = cvt_pk_bf16(bflo(uu.x) * (acc[dt][0] + bias), bfhi(uu.x) * (acc[dt][1] + bias)); w.y = cvt_pk_bf16(bflo(uu.y) * (acc[dt][2] + bias), bfhi(uu.y) * (acc[dt][3] + bias));
          *(u32x2*)(U + (size_t)(m0 + t) * 512 + d) = w; } }
    __syncthreads();
}
template <int D> __device__ __forceinline__ void stage_kv(LAS bf16_t* Ks, LAS bf16_t* Vt, const bf16_t* Kg, const bf16_t* Vg, int ld, int tid) {
    constexpr int CPR = D / 8;
#pragma unroll
    for (int c = tid; c < 64 * CPR; c += NTHREADS) { const int r = c / CPR, cc = c % CPR;
        const u32x4 kv = *(const u32x4*)(Kg + (size_t)r * ld + cc * 8); *(LAS u32x4*)(Ks + r * (D + 8) + cc * 8) = kv;
        const u32x4 vv = *(const u32x4*)(Vg + (size_t)r * ld + cc * 8); LAS bf16_t* vp = Vt + (cc * 8) * 72 + r;
        vp[0 * 72] = (bf16_t)(vv.x & 0xffffu); vp[1 * 72] = (bf16_t)(vv.x >> 16); vp[2 * 72] = (bf16_t)(vv.y & 0xffffu); vp[3 * 72] = (bf16_t)(vv.y >> 16);
        vp[4 * 72] = (bf16_t)(vv.z & 0xffffu); vp[5 * 72] = (bf16_t)(vv.z >> 16); vp[6 * 72] = (bf16_t)(vv.w & 0xffffu); vp[7 * 72] = (bf16_t)(vv.w >> 16); }
}
template <int D, int QS, class MaskF>
__device__ __forceinline__ void flash_block(const LAS bf16_t* Ks, const LAS bf16_t* Vt, const bf16x8 (&qf)[QS][D / 32], f32x4 (&acc)[QS][D / 16], float (&mrun)[QS], float (&lrun)[QS], const MaskF& allowed, int lane) {
    const int r16 = lane & 15, quad = lane >> 4;
#pragma unroll
    for (int qs = 0; qs < QS; ++qs) {
        f32x4 s[4];
#pragma unroll
        for (int kt = 0; kt < 4; ++kt) { s[kt] = (f32x4){0.f, 0.f, 0.f, 0.f};
#pragma unroll
            for (int ks = 0; ks < D / 32; ++ks) { const bf16x8 kf = *(const LAS bf16x8*)(Ks + (kt * 16 + r16) * (D + 8) + ks * 32 + quad * 8); s[kt] = MFMA16(kf, qf[qs][ks], s[kt]); } }
        float mx = -1e30f;
#pragma unroll
        for (int kt = 0; kt < 4; ++kt)
#pragma unroll
            for (int i = 0; i < 4; ++i) { const bool ok = allowed(qs, kt * 16 + quad * 4 + i); const float v = ok ? s[kt][i] * LOG2E : -1e30f; s[kt][i] = v; mx = fmaxf(mx, v); }
        mx = fmaxf(mx, __shfl_xor(mx, 16)); mx = fmaxf(mx, __shfl_xor(mx, 32));
        const float mnew = fmaxf(mrun[qs], mx), alpha = __builtin_amdgcn_exp2f(mrun[qs] - mnew); mrun[qs] = mnew;
        float ps = 0.f;
#pragma unroll
        for (int kt = 0; kt < 4; ++kt)
#pragma unroll
            for (int i = 0; i < 4; ++i) { const float p = (s[kt][i] > -1e29f) ? __builtin_amdgcn_exp2f(s[kt][i] - mnew) : 0.f; s[kt][i] = p; ps += p; }
        ps += __shfl_xor(ps, 16); ps += __shfl_xor(ps, 32);
        lrun[qs] = lrun[qs] * alpha + ps;
        bf16x8 pf[2];
#pragma unroll
        for (int kk = 0; kk < 2; ++kk) { u32x4 w; w.x = cvt_pk_bf16(s[2 * kk][0], s[2 * kk][1]); w.y = cvt_pk_bf16(s[2 * kk][2], s[2 * kk][3]); w.z = cvt_pk_bf16(s[2 * kk + 1][0], s[2 * kk + 1][1]); w.w = cvt_pk_bf16(s[2 * kk + 1][2], s[2 * kk + 1][3]);
            pf[kk] = __builtin_bit_cast(bf16x8, w); }
#pragma unroll
        for (int dt = 0; dt < D / 16; ++dt) { acc[qs][dt] = acc[qs][dt] * alpha;
#pragma unroll
            for (int kk = 0; kk < 2; ++kk) { const LAS bf16_t* vp = Vt + (dt * 16 + r16) * 72 + kk * 32 + quad * 4;
                const s16x4 lo = *(const LAS s16x4*)vp, hi = *(const LAS s16x4*)(vp + 16);
                const bf16x8 vf = __builtin_shufflevector(lo, hi, 0, 1, 2, 3, 4, 5, 6, 7);
                acc[qs][dt] = MFMA16(vf, pf[kk], acc[qs][dt]); } }
    }
}
constexpr int NSA_KS = 0, NSA_VT = 18432, NSA_IMP = NSA_VT + 17408, NSA_SEL = NSA_IMP + 32768, NSA_UNI = NSA_SEL + 256;
__device__ __forceinline__ void nsa_unit(int unit, const bf16_t* ZQ, const bf16_t* ZKV, const bf16_t* ZG, const bf16_t* KC, const bf16_t* VC, bf16_t* O, LAS unsigned char* lds, int wave, int lane, int tid) {
    const int qb = unit & 63, g = (unit >> 6) & 1, b = unit >> 7, cur = qb >> 1;
    const int r16 = lane & 15, quad = lane >> 4, hh = wave & 3, h = g * 4 + hh, t0 = qb * 32;
    LAS bf16_t* Ks = (LAS bf16_t*)(lds + NSA_KS); LAS bf16_t* Vt = (LAS bf16_t*)(lds + NSA_VT);
    LAS float* impS = (LAS float*)(lds + NSA_IMP); LAS unsigned* selS = (LAS unsigned*)(lds + NSA_SEL); LAS unsigned* uniS = (LAS unsigned*)(lds + NSA_UNI);
    int tok[1], tq[1]; bf16x8 qf[1][2]; float gate[1][3];
#pragma unroll
    for (int qs = 0; qs < 1; ++qs) { tok[qs] = (wave >> 2) * 16 + r16; tq[qs] = t0 + tok[qs];
        const size_t row = (size_t)b * SEQ + tq[qs];
#pragma unroll
        for (int ks = 0; ks < 2; ++ks) qf[qs][ks] = *(const bf16x8*)(ZQ + row * 512 + h * 64 + ks * 32 + quad * 8);
#pragma unroll
        for (int c = 0; c < 3; ++c) gate[qs][c] = fsigmoid(__uint_as_float((unsigned)ZG[row * 32 + h * 3 + c] << 16)); }
    f32x4 outv[1][4];
    { const bf16_t* Kg = KC + (size_t)(b * 2 + g) * 128 * 64; const bf16_t* Vg = VC + (size_t)(b * 2 + g) * 128 * 64;
      for (int c = tid; c < 128 * 8; c += NTHREADS) { const int r = c >> 3, cc = c & 7;
          const u32x4 kv = *(const u32x4*)(Kg + r * 64 + cc * 8); *(LAS u32x4*)(Ks + r * 72 + cc * 8) = kv;
          const u32x4 vv = *(const u32x4*)(Vg + r * 64 + cc * 8); LAS bf16_t* vp = Vt + (cc * 8) * 136 + r;
          vp[0 * 136] = (bf16_t)(vv.x & 0xffffu); vp[1 * 136] = (bf16_t)(vv.x >> 16); vp[2 * 136] = (bf16_t)(vv.y & 0xffffu); vp[3 * 136] = (bf16_t)(vv.y >> 16);
          vp[4 * 136] = (bf16_t)(vv.z & 0xffffu); vp[5 * 136] = (bf16_t)(vv.z >> 16); vp[6 * 136] = (bf16_t)(vv.w & 0xffffu); vp[7 * 136] = (bf16_t)(vv.w >> 16); }
      if (tid == 0) uniS[0] = 0u;
      __syncthreads();
#pragma unroll
      for (int qs = 0; qs < 1; ++qs) {
          f32x4 s[8]; float mx = -1e30f;
#pragma unroll
          for (int kt = 0; kt < 8; ++kt) { s[kt] = (f32x4){0.f, 0.f, 0.f, 0.f};
#pragma unroll
              for (int ks = 0; ks < 2; ++ks) { const bf16x8 kf = *(const LAS bf16x8*)(Ks + (kt * 16 + r16) * 72 + ks * 32 + quad * 8); s[kt] = MFMA16(kf, qf[qs][ks], s[kt]); }
#pragma unroll
              for (int i = 0; i < 4; ++i) { const int n = kt * 16 + quad * 4 + i; const bool ok = (n < 127) && (16 * n + 31 <= tq[qs]); const float v = ok ? s[kt][i] * LOG2E : -1e30f; s[kt][i] = v; mx = fmaxf(mx, v); } }
          mx = fmaxf(mx, __shfl_xor(mx, 16)); mx = fmaxf(mx, __shfl_xor(mx, 32));
          float ps = 0.f;
#pragma unroll
          for (int kt = 0; kt < 8; ++kt)
#pragma unroll
              for (int i = 0; i < 4; ++i) { const float p = (s[kt][i] > -1e29f) ? __builtin_amdgcn_exp2f(s[kt][i] - mx) : 0.f; s[kt][i] = p; ps += p; }
          ps += __shfl_xor(ps, 16); ps += __shfl_xor(ps, 32);
          const float inv = ps > 0.f ? 1.0f / ps : 0.f;
          float so_prev = 0.f; const int src = (lane - 16) & 63;
#pragma unroll
          for (int kt = 0; kt < 8; ++kt) { s[kt] = s[kt] * inv;
              const float so = 0.5f * s[kt][3]; const float a1 = __shfl(so, src), a2 = __shfl(so_prev, src);
              const float v = (s[kt][0] + s[kt][1]) + (s[kt][2] + so) + (quad > 0 ? a1 : a2);
              impS[(hh * 32 + tok[qs]) * 32 + kt * 4 + quad] = v; so_prev = so; }
          f32x4 acc[4];
#pragma unroll
          for (int dt = 0; dt < 4; ++dt) acc[dt] = (f32x4){0.f, 0.f, 0.f, 0.f};
#pragma unroll
          for (int kk = 0; kk < 4; ++kk) { u32x4 w; w.x = cvt_pk_bf16(s[2 * kk][0], s[2 * kk][1]); w.y = cvt_pk_bf16(s[2 * kk][2], s[2 * kk][3]); w.z = cvt_pk_bf16(s[2 * kk + 1][0], s[2 * kk + 1][1]); w.w = cvt_pk_bf16(s[2 * kk + 1][2], s[2 * kk + 1][3]);
              const bf16x8 pf = __builtin_bit_cast(bf16x8, w);
#pragma unroll
              for (int dt = 0; dt < 4; ++dt) { const LAS bf16_t* vp = Vt + (dt * 16 + r16) * 136 + kk * 32 + quad * 4;
                  const s16x4 lo = *(const LAS s16x4*)vp, hi = *(const LAS s16x4*)(vp + 16);
                  acc[dt] = MFMA16(__builtin_shufflevector(lo, hi, 0, 1, 2, 3, 4, 5, 6, 7), pf, acc[dt]); } }
#pragma unroll
          for (int dt = 0; dt < 4; ++dt) outv[qs][dt] = acc[dt] * gate[qs][0];
      }
      __syncthreads();
      if (tid < 32) { unsigned sel = 0u;
          for (int j = 0; j < 32; ++j) impS[tid * 32 + j] = (impS[tid * 32 + j] + impS[(32 + tid) * 32 + j]) + (impS[(64 + tid) * 32 + j] + impS[(96 + tid) * 32 + j]);
          for (int rnd = 0; rnd < 8; ++rnd) { float best = -3.0e38f; int bi = 0;
              for (int j = 0; j < 32; ++j) { if ((sel >> j) & 1u) continue;
                  const bool forced = (j == 0) || (j == cur) || (j == cur - 1);
                  const float v = forced ? 1e9f : (j <= cur ? impS[tid * 32 + j] : -1.0f);
                  if (v > best) { best = v; bi = j; } }
              sel |= 1u << bi; }
          selS[tid] = sel; atomicOr((unsigned*)uniS, sel); }
      __syncthreads();
    }
    unsigned selm[1]; selm[0] = selS[tok[0]];
    const unsigned uni = uniS[0];
    f32x4 acc[1][4]; float mrun[1], lrun[1];
#define NSA_RESET() do { _Pragma("unroll") for (int qs = 0; qs < 1; ++qs) { mrun[qs] = -1e30f; lrun[qs] = 0.f; _Pragma("unroll") for (int dt = 0; dt < 4; ++dt) acc[qs][dt] = (f32x4){0.f, 0.f, 0.f, 0.f}; } } while (0)
#define NSA_ACCUM(c) do { _Pragma("unroll") for (int qs = 0; qs < 1; ++qs) { const float f = (lrun[qs] > 0.f ? 1.0f / lrun[qs] : 0.f) * gate[qs][c]; _Pragma("unroll") for (int dt = 0; dt < 4; ++dt) outv[qs][dt] = outv[qs][dt] + acc[qs][dt] * f; } } while (0)
    NSA_RESET();
#ifndef NSA_NO_SEL
#pragma unroll 1
    for (int j = 0; j <= cur; ++j) {
        if (!((uni >> j) & 1u)) continue;
        const bf16_t* Kg = ZKV + ((size_t)b * SEQ + j * 64) * 768 + 2 * 128 + g * 64;
        stage_kv<64>(Ks, Vt, Kg, Kg + 128, 768, tid);
        __syncthreads();
        auto mask = [=](int qs, int kl) { return (((selm[qs] >> j) & 1u) != 0u) && (j * 64 + kl <= tq[qs]); };
        flash_block<64, 1>(Ks, Vt, qf, acc, mrun, lrun, mask, lane);
        __syncthreads();
    }
#endif
    NSA_ACCUM(1);
    NSA_RESET();
#ifndef NSA_NO_WIN
#pragma unroll 1
    for (int j = (cur > 4 ? cur - 4 : 0); j <= cur; ++j) {
        const bf16_t* Kg = ZKV + ((size_t)b * SEQ + j * 64) * 768 + 4 * 128 + g * 64;
        stage_kv<64>(Ks, Vt, Kg, Kg + 128, 768, tid);
        __syncthreads();
        auto mask = [=](int qs, int kl) { const int kp = j * 64 + kl; return (kp <= tq[qs]) && (kp + 256 > tq[qs]); };
        flash_block<64, 1>(Ks, Vt, qf, acc, mrun, lrun, mask, lane);
        __syncthreads();
    }
#endif
    NSA_ACCUM(2);
#undef NSA_RESET
#undef NSA_ACCUM
#pragma unroll
    for (int qs = 0; qs < 1; ++qs)
#pragma unroll
        for (int dt = 0; dt < 4; ++dt) { u32x2 w; w.x = cvt_pk_bf16(outv[qs][dt][0], outv[qs][dt][1]); w.y = cvt_pk_bf16(outv[qs][dt][2], outv[qs][dt][3]);
            *(u32x2*)(O + ((size_t)b * SEQ + tq[qs]) * 512 + h * 64 + dt * 16 + quad * 4) = w; }
}
__device__ __forceinline__ void cross_unit(int unit, const bf16_t* QX, const bf16_t* KVM, bf16_t* OX, LAS unsigned char* lds, int wave, int lane, int tid) {
    const int qblk = unit & 15, hd = (unit >> 4) & 3, b = unit >> 6;
    const int r16 = lane & 15, quad = lane >> 4;
    LAS bf16_t* Ks = (LAS bf16_t*)lds; LAS bf16_t* Vt = (LAS bf16_t*)(lds + 64 * 264 * 2);
    const size_t row = (size_t)b * SEQ + qblk * 128 + wave * 16 + r16;
    bf16x8 qf[1][8];
#pragma unroll
    for (int ks = 0; ks < 8; ++ks) qf[0][ks] = *(const bf16x8*)(QX + row * DM + hd * 256 + ks * 32 + quad * 8);
    f32x4 acc[1][16]; float mrun[1] = {-1e30f}, lrun[1] = {0.f};
#pragma unroll
    for (int dt = 0; dt < 16; ++dt) acc[0][dt] = (f32x4){0.f, 0.f, 0.f, 0.f};
#pragma unroll 1
    for (int j = 0; j < 4; ++j) {
        const bf16_t* Kg = KVM + ((size_t)b * MEML + j * 64) * 2048 + hd * 256;
        stage_kv<256>(Ks, Vt, Kg, Kg + 1024, 2048, tid);
        __syncthreads();
        auto mask = [](int, int) { return true; };
        flash_block<256, 1>(Ks, Vt, qf, acc, mrun, lrun, mask, lane);
        __syncthreads();
    }
    const float inv = 1.0f / lrun[0];
#pragma unroll
    for (int dt = 0; dt < 16; ++dt) { const f32x4 o = acc[0][dt] * inv; u32x2 w; w.x = cvt_pk_bf16(o[0], o[1]); w.y = cvt_pk_bf16(o[2], o[3]);
        *(u32x2*)(OX + row * DM + hd * 256 + dt * 16 + quad * 4) = w; }
}
template <class Epi> __device__ __forceinline__ void run_gemm(LAS unsigned char* lds, const bf16_t* A, const bf16_t* Bt, int M, int N, int K, int G, int c, const Epi& E) {
    asm volatile("" : "+s"(K), "+s"(N), "+s"(M));
    pg8::Gemm g{A, Bt, M, N, K}; pg8::StaticOrder S; S.init(M, N, G, c);
    pg8::gemm_phase<Epi, pg8::StaticOrder, true, true>(lds, g, S, E);
}
__global__ void __launch_bounds__(NTHREADS, 2) hybrid_fwd(Args args) {
    extern __shared__ __attribute__((aligned(16))) unsigned char lds_raw[];
    LAS unsigned char* lds = (LAS unsigned char*)lds_raw;
    for (int ph = args.ph_lo; ph < args.ph_hi; ++ph) {
        int G = gridDim.x, bid = blockIdx.x; asm volatile("" : "+s"(G), "+s"(bid));
        int tid = threadIdx.x; asm volatile("" : "+v"(tid));
        const int lane = tid & 63, wave = __builtin_amdgcn_readfirstlane(tid >> 6);
        const int gw = bid * NWAVES + wave, NGW = G * NWAVES, gt = bid * NTHREADS + tid, NGT = G * NTHREADS;
        karg_t kp = (karg_t)__builtin_amdgcn_kernarg_segment_ptr(); asm volatile("" : "+s"(kp));
        unsigned char* ws = *(unsigned char* const __attribute__((address_space(4)))*)(kp + 8 * (N_IN + 1));
        float* X = *(float* const __attribute__((address_space(4)))*)(kp + 8 * N_IN); bf16_t* XN = (bf16_t*)(ws + WS_XN);
        if (ph > args.ph_lo) { asm volatile("s_waitcnt vmcnt(0)" ::: "memory"); cg::this_grid().sync(); }
        const int l = ph == 0 ? 0 : (ph - 1) / PH_PER_LAYER, k = ph == 0 ? -1 : (ph - 1) % PH_PER_LAYER;
#define LP(idx, per) (AIN(idx) + (size_t)l * (per))
#ifndef PHM
#define PHM 0xFFFFFFFFu
#endif
#define EN(b) (((PHM) >> (b)) & 1u)
        if (EN(0) && k == -1) {
            prep_layer(kp, ws, 0, lds, gw, NGW, wave, lane, tid, G, bid);
            row_pass(nullptr, nullptr, 0.f, AIN(I_X), X, AIN(I_FF1_PRE), XN, MT, gw, NGW, lane);
        } else if (EN(1) && (k == 0 || k == 14)) {
            pg8::EpiSwiGLU E{(bf16_t*)(ws + WS_H), DFF};
            run_gemm(lds, XN, (const bf16_t*)(ws + (k == 0 ? WS_W13A : WS_W13B)), MT, 2 * DFF, DM, G, bid, E);
        } else if (EN(2) && (k == 1 || k == 15 || k == 8 || k == 12)) {
            const bf16_t* A; const bf16_t* Bt; int K; float* Y;
            if (k == 1) { A = (const bf16_t*)(ws + WS_H); Bt = (const bf16_t*)(ws + WS_W2A); K = DFF; Y = (float*)(ws + WS_YF); }
            else if (k == 15) { A = (const bf16_t*)(ws + WS_H); Bt = (const bf16_t*)(ws + WS_W2B); K = DFF; Y = (float*)(ws + WS_YF); }
            else if (k == 8) { A = (const bf16_t*)(ws + WS_MRG); Bt = (const bf16_t*)(ws + WS_WMIX); K = DM; Y = (float*)(ws + WS_YM); }
            else { A = (const bf16_t*)(ws + WS_OX); Bt = (const bf16_t*)(ws + WS_WO); K = DM; Y = (float*)(ws + WS_YF); }
            pg8::EpiF32 E{Y, DM};
            run_gemm(lds, A, Bt, MT, DM, K, G, bid, E);
        } else if (EN(3) && (k == 2 || k == 9 || k == 13 || k == 16)) {
            const float *Y, *gpost, *gnext; float coef;
            if (k == 2) { Y = (const float*)(ws + WS_YF); gpost = LP(I_FF1_POST, DM); gnext = LP(I_MIX_PRE, DM); coef = 0.5f; }
            else if (k == 9) { Y = (const float*)(ws + WS_YM); gpost = LP(I_MIX_POST, DM); gnext = LP(I_MEM_PRE, DM); coef = 1.0f; }
            else if (k == 13) { Y = (const float*)(ws + WS_YF); gpost = LP(I_MEM_POST, DM); gnext = LP(I_FF2_PRE, DM); coef = 1.0f; }
            else { Y = (const float*)(ws + WS_YF); gpost = LP(I_FF2_POST, DM); gnext = (l + 1 < DEPTH) ? AIN(I_FF1_PRE) + (size_t)(l + 1) * DM : nullptr; coef = 0.5f; }
            row_pass(Y, gpost, coef, X, X, gnext, XN, MT, gw, NGW, lane);
            if (k == 16 && l + 1 < DEPTH) prep_layer(kp, ws, l + 1, lds, gw, NGW, wave, lane, tid, G, bid);
        } else if (EN(4) && (k == 3 || k == 6)) {
            const bool gt6 = (k == 6);
            pg8::EpiZin E{gt6 ? LP(I_BIN, INC) + 2840 : (const float*)(ws + WS_BIASIN), (bf16_t*)(ws + (gt6 ? WS_G : WS_ZA)), (bf16_t*)(ws + WS_ZQ), (bf16_t*)(ws + WS_ZKV), (bf16_t*)(ws + WS_ZGM), (bf16_t*)(ws + WS_ZG), gt6 ? 1 : 0};
            run_gemm(lds, XN, (const bf16_t*)(ws + (gt6 ? WS_WMG : WS_WIN)), MT, 3072, DM, G, bid, E);
        } else if (EN(5) && k == 4) {
            for (int u = bid; u < 256; u += G)
                compress_unit(u, (const bf16_t*)(ws + WS_ZKV), (const bf16_t*)(ws + WS_W1K), (const bf16_t*)(ws + WS_W1V), (const bf16_t*)(ws + WS_W2K), (const bf16_t*)(ws + WS_W2V),
                              (const float*)(ws + WS_POSB), (bf16_t*)(ws + WS_KC), (bf16_t*)(ws + WS_VC), lds, wave, lane);
            pool_pass((const bf16_t*)(ws + WS_ZA), (bf16_t*)(ws + WS_P), gt, NGT);
            for (int u = bid; u < 512; u += G)
                gmlp_unit(u, (const bf16_t*)(ws + WS_ZGM), (const bf16_t*)(ws + WS_GWS), LP(I_GLNG, 512), LP(I_GLNB, 512), LP(I_GBS, 512), (bf16_t*)(ws + WS_U), lds, wave, lane, tid);
        } else if (EN(6) && k == 5) {
            for (int u = bid; u < 1024; u += G) { const int uu = (u & ~63) | (63 - (u & 63));
                nsa_unit(uu, (const bf16_t*)(ws + WS_ZQ), (const bf16_t*)(ws + WS_ZKV), (const bf16_t*)(ws + WS_ZG), (const bf16_t*)(ws + WS_KC), (const bf16_t*)(ws + WS_VC), (bf16_t*)(ws + WS_O), lds, wave, lane, tid);
                __syncthreads(); }
        } else if (EN(8) && k == 7) {
#ifndef MERGE_MASK
#define MERGE_MASK 7
#endif
            int nacc = 0;
            for (int i = 0; i < 3; ++i) {
                if (!((MERGE_MASK >> i) & 1)) continue;
                const bf16_t* A = (const bf16_t*)(ws + (i == 0 ? WS_P : (i == 1 ? WS_O : WS_U)));
                const bf16_t* Bt = (const bf16_t*)(ws + (i == 0 ? WS_WCOMB : (i == 1 ? WS_WBRN : WS_WBRG)));
                pg8::EpiMerge E{(const bf16_t*)(ws + WS_G), i * 1024, (bf16_t*)(ws + WS_MRG), nacc}; nacc = 1;
#ifdef PROBE_BF16S
                { pg8::EpiBf16S E2{(bf16_t*)(ws + WS_MRG), DM, 1.0f}; run_gemm(lds, A, Bt, MT, DM, 512, G, bid, E2); }
#else
                run_gemm(lds, A, Bt, MT, DM, 512, G, bid, E);
#endif
                asm volatile("s_waitcnt vmcnt(0)" ::: "memory"); __builtin_amdgcn_fence(__ATOMIC_RELEASE, "agent"); __syncthreads(); __builtin_amdgcn_fence(__ATOMIC_ACQUIRE, "agent");
            }
        } else if (k == 10) {
        } else if (EN(9) && k == 11) {
            for (int u = bid; u < 512; u += G) { cross_unit(u, (const bf16_t*)(ws + WS_QX), (const bf16_t*)(ws + WS_KVM), (bf16_t*)(ws + WS_OX), lds, wave, lane, tid); __syncthreads(); }
        }
        if (EN(10) && (k == 0 || k == 10)) {
            const bool kv = (k == 0);
            pg8::EpiBf16S E{(bf16_t*)(ws + (kv ? WS_KVM : WS_QX)), kv ? 2048 : DM, kv ? 1.0f : 0.0625f};
            run_gemm(lds, kv ? (const bf16_t*)(ws + WS_MEMN) : XN, (const bf16_t*)(ws + (kv ? WS_WKV : WS_WQ)), kv ? MM : MT, kv ? 2048 : DM, DM, G, kv ? (bid + G / 2) % G : bid, E);
        }
#undef LP
    }
}

__global__ void dump_kernel(const unsigned short* src, float* out, size_t n, size_t ld_src, size_t cols) {
    for (size_t i = (size_t)blockIdx.x * blockDim.x + threadIdx.x; i < n; i += (size_t)gridDim.x * blockDim.x) { const size_t r = i / cols, c = i % cols; out[i] = ld_src == 0 ? ((const float*)src)[i] : __uint_as_float((unsigned)src[r * ld_src + c] << 16); }
}
#ifndef MK_SPLIT
#define MK_SPLIT 0
#endif
extern "C" void kernel_launch(void* const* d_in, const int* in_sizes, int n_in, void* d_out, int out_size, void* d_ws, size_t ws_size, hipStream_t stream) {
    static int grid = 0;
    if (grid == 0) {
        if (n_in != N_IN || out_size != MT * DM || ws_size < WS_END) { fprintf(stderr, "kernel_launch: unexpected shapes (n_in %d out %d ws %zu)\n", n_in, out_size, ws_size); grid = -1; return; }
        int dev = 0, cus = 0, per_cu = 0;
        hipGetDevice(&dev); hipDeviceGetAttribute(&cus, hipDeviceAttributeMultiprocessorCount, dev);
        hipFuncSetAttribute((const void*)hybrid_fwd, hipFuncAttributeMaxDynamicSharedMemorySize, LDS_BYTES);
        hipOccupancyMaxActiveBlocksPerMultiprocessor(&per_cu, (const void*)hybrid_fwd, NTHREADS, LDS_BYTES);
        (void)hipGetLastError();
        if (per_cu < 1) per_cu = 1;
        grid = cus;
        if (grid <= 0) grid = 256;
    }
    if (grid < 0) return;
    Args a{};
    for (int i = 0; i < N_IN; ++i) a.in[i] = (const float*)d_in[i];
    a.out = (float*)d_out; a.ws = (unsigned char*)d_ws;
#if MK_SPLIT
#ifndef PH_LIMIT
#define PH_LIMIT NPHASES
#endif
    for (int ph = 0; ph < PH_LIMIT; ++ph) { a.ph_lo = ph; a.ph_hi = ph + 1; hipLaunchKernelGGL(hybrid_fwd, dim3(grid), dim3(NTHREADS), LDS_BYTES, stream, a); }
#ifdef DUMP_OFF
    hipLaunchKernelGGL(dump_kernel, dim3(2048), dim3(256), 0, stream, (const unsigned short*)((unsigned char*)d_ws + (DUMP_OFF)), (float*)d_out, (size_t)MT * DUMP_COLS, (size_t)DUMP_LD, (size_t)DUMP_COLS);
#endif
#else
    a.ph_lo = 0; a.ph_hi = NPHASES;
    void* kargs[] = {&a};
    hipError_t e = hipLaunchCooperativeKernel((const void*)hybrid_fwd, dim3(grid), dim3(NTHREADS), kargs, LDS_BYTES, stream);
    if (e != hipSuccess) fprintf(stderr, "cooperative launch failed: %s (grid %d)\n", hipGetErrorString(e), grid);
#endif
}
```

```cpp
#include <hip/hip_runtime.h>
#include <hip/hip_cooperative_groups.h>
#include <cstdio>
#include <cstdint>
namespace cg = cooperative_groups;
namespace pg8 {
#define PG8_LAS __attribute__((address_space(3)))
typedef unsigned short bf16_t;
typedef short bf16x8 __attribute__((ext_vector_type(8)));
typedef float f32x4 __attribute__((ext_vector_type(4)));
typedef unsigned u32x4 __attribute__((ext_vector_type(4)));
constexpr int BM = 256, BK = 64, HALF = 128, HTB = HALF * BK * 2  , STAGE_BYTES = 8 * HTB, NXCD = 8, WGM = 8;

__host__ __device__ __forceinline__ int lds_byte(int r, int c) { const int st = (r >> 4) * 2 + (c >> 5), rr = r & 15, cc = c & 31, ob = rr * 64 + cc * 2; return st * 1024 + (ob ^ (((ob >> 9) & 1) << 5)); }
__host__ __device__ __forceinline__ void stage_rc(int b, int& R, int& C) { const int st = b / 1024, sb = b % 1024, swz = sb ^ (((sb >> 9) & 1) << 5); R = (st >> 1) * 16 + swz / 64; C = (st & 1) * 32 + (swz % 64) / 2; }
__host__ __device__ __forceinline__ int perm32(int rho) { const int n = rho >> 4, i = rho & 15; return 8 * (i >> 2) + 4 * n + (i & 3); }

struct Unit { int pm, pn; };
struct Gemm { const bf16_t* A; const bf16_t* Bt; int M, N, K; };

struct StaticOrder {
    int nM, nN, nwg, G, c;
    __host__ __device__ void init(int M, int N, int G_, int c_) { nM = M / BM; nN = N / BM; nwg = nM * nN; G = G_; c = c_; }
    __host__ __device__ bool next(int i, Unit& u) const {
        const long L = (long)i * G + c; if (L >= nwg) return false;
        int wgid = (int)L; { const int q = nwg / NXCD, r = nwg % NXCD, xcd = wgid % NXCD, off = wgid / NXCD; wgid = (xcd < r ? xcd * (q + 1) : r * (q + 1) + (xcd - r) * q) + off; }
        const int nig = WGM * nN, gid = wgid / nig, fm = gid * WGM, gsz = (nM - fm) < WGM ? (nM - fm) : WGM;
        u.pm = fm + ((wgid % nig) % gsz); u.pn = (wgid % nig) / gsz; return true;
    }
    __device__ __forceinline__ void a_ready(const Unit&) const {}
    __device__ __forceinline__ void done(const Unit&) const {}
};

typedef float f32x2_cv __attribute__((ext_vector_type(2))); typedef __bf16 bf16x2_cv __attribute__((ext_vector_type(2)));
__device__ __forceinline__ unsigned cvt_pk_bf16(float lo, float hi) { const f32x2_cv v = {lo, hi}; const bf16x2_cv b = __builtin_convertvector(v, bf16x2_cv); return __builtin_bit_cast(unsigned, b); }
typedef float f32x2 __attribute__((ext_vector_type(2)));
typedef unsigned u32x2 __attribute__((ext_vector_type(2)));
__device__ __forceinline__ float fsigmoid(float v) { return __builtin_amdgcn_rcpf(1.0f + __expf(-v)); }
__device__ __forceinline__ float fgelu_tanh(float v) { const float z = 1.5957691216f * (v + 0.044715f * v * v * v); return v * fsigmoid(z); }
__device__ __forceinline__ float bflo(unsigned w) { return __uint_as_float(w << 16); }
__device__ __forceinline__ float bfhi(unsigned w) { return __uint_as_float(w & 0xffff0000u); }

struct EpiF32 {
    static constexpr bool PERM = false, AFTER_DRAIN = false;
    float* C; int ldc;
    __device__ __forceinline__ void operator()(const f32x4 (&acc)[2][2][4][2], const Unit& u, int wr, int wc, int fr, int fq) const {
        const int row0 = u.pm * BM + wr * 64 + fr, col0 = u.pn * BM + wc * 32 + 4 * fq;
#pragma unroll
        for (int ai = 0; ai < 2; ++ai)
#pragma unroll
            for (int m = 0; m < 4; ++m) { float* rowp = C + (size_t)(row0 + ai * HALF + m * 16) * ldc + col0;
#pragma unroll
                for (int bj = 0; bj < 2; ++bj)
#pragma unroll
                    for (int n = 0; n < 2; ++n) *(f32x4*)(rowp + bj * HALF + n * 16) = acc[ai][bj][m][n]; }
    }
};
struct EpiBf16S {
    static constexpr bool PERM = true, AFTER_DRAIN = false;
    bf16_t* O; int ldc; float scale; bf16_t* vt;
    __device__ __forceinline__ void operator()(const f32x4 (&acc)[2][2][4][2], const Unit& u, int wr, int wc, int fr, int fq) const {
        const int row0 = u.pm * BM + wr * 64 + fr, col0 = u.pn * BM + wc * 32 + 8 * fq;
        const bool tr = (vt != nullptr) && (u.pn >= 4);
#pragma unroll
        for (int ai = 0; ai < 2; ++ai)
#pragma unroll
            for (int m = 0; m < 4; ++m) { const int row = row0 + ai * HALF + m * 16; bf16_t* rowp = O + (size_t)row * ldc + col0;
#pragma unroll
                for (int bj = 0; bj < 2; ++bj) { const f32x4 v0 = acc[ai][bj][m][0] * scale, v1 = acc[ai][bj][m][1] * scale;
                    u32x4 w; w.x = cvt_pk_bf16(v0[0], v0[1]); w.y = cvt_pk_bf16(v0[2], v0[3]); w.z = cvt_pk_bf16(v1[0], v1[1]); w.w = cvt_pk_bf16(v1[2], v1[3]);
                    if (tr) { bf16_t* p = vt + ((size_t)(((row >> 8) * 4 + (u.pn - 4)) * 256 + bj * HALF + wc * 32 + 8 * fq)) * 256 + (row & 255);
                        p[0 * 256] = (bf16_t)(w.x & 0xffffu); p[1 * 256] = (bf16_t)(w.x >> 16); p[2 * 256] = (bf16_t)(w.y & 0xffffu); p[3 * 256] = (bf16_t)(w.y >> 16);
                        p[4 * 256] = (bf16_t)(w.z & 0xffffu); p[5 * 256] = (bf16_t)(w.z >> 16); p[6 * 256] = (bf16_t)(w.w & 0xffffu); p[7 * 256] = (bf16_t)(w.w >> 16); }
                    else *(u32x4*)(rowp + bj * HALF) = w; }
                asm volatile("" ::: "memory"); }
    }
};
struct EpiSwiGLU {
    static constexpr bool PERM = true, AFTER_DRAIN = false;
    bf16_t* H; int ldh;
    __device__ __forceinline__ void operator()(const f32x4 (&acc)[2][2][4][2], const Unit& u, int wr, int wc, int fr, int fq) const {
        const int row0 = u.pm * BM + wr * 64 + fr, col0 = u.pn * HALF + wc * 32 + 8 * fq;
#pragma unroll
        for (int ai = 0; ai < 2; ++ai)
#pragma unroll
            for (int m = 0; m < 4; ++m) { bf16_t* p = H + (size_t)(row0 + ai * HALF + m * 16) * ldh + col0;
                f32x4 h0, h1;
#pragma unroll
                for (int i = 0; i < 4; ++i) { const float g0 = acc[ai][0][m][0][i], g1 = acc[ai][0][m][1][i];
                    h0[i] = g0 * fsigmoid(g0) * acc[ai][1][m][0][i]; h1[i] = g1 * fsigmoid(g1) * acc[ai][1][m][1][i]; }
                u32x4 w; w.x = cvt_pk_bf16(h0[0], h0[1]); w.y = cvt_pk_bf16(h0[2], h0[3]); w.z = cvt_pk_bf16(h1[0], h1[1]); w.w = cvt_pk_bf16(h1[2], h1[3]);
                *(u32x4*)p = w; }
    }
};
struct EpiZin {
    static constexpr bool PERM = true, AFTER_DRAIN = false;
    const float* bias; bf16_t *ZA, *ZQ, *ZKV, *ZGM, *ZG; int mode; bf16_t *VTS, *VTW;
    __device__ __forceinline__ void operator()(const f32x4 (&acc)[2][2][4][2], const Unit& u, int wr, int wc, int fr, int fq) const {
        const int pn = u.pn; const int row0 = u.pm * BM + wr * 64 + fr;
        bf16_t* base; int ld, cb; int act = 0; float sc = 1.f; bool only0 = false;
        if (mode == 1) { base = ZA; ld = 3072; cb = pn * 256; act = 2; }
        else if (pn < 2) { base = ZA; ld = 512; cb = pn * 256; }
        else if (pn < 4) { base = ZQ; ld = 512; cb = (pn - 2) * 256; sc = 0.125f; }
        else if (pn < 7) { base = ZKV; ld = 768; cb = (pn - 4) * 256; }
        else if (pn < 11) { base = ZGM; ld = 1024; cb = (pn - 7) * 256; act = 1; }
        else { base = ZG; ld = 32; cb = 0; only0 = true; }
        const int ct = wc * 32 + 8 * fq;
        bf16_t* bp = base + (size_t)row0 * ld + cb + ct;
        f32x4 bv[2][2];
#pragma unroll
        for (int bj = 0; bj < 2; ++bj)
#pragma unroll
            for (int n = 0; n < 2; ++n) bv[bj][n] = *(const f32x4*)(bias + pn * 256 + bj * HALF + ct + 4 * n);
#pragma unroll
        for (int ai = 0; ai < 2; ++ai)
#pragma unroll
            for (int m = 0; m < 4; ++m) {
#pragma unroll
                for (int bj = 0; bj < 2; ++bj) {
                    f32x4 v0 = (acc[ai][bj][m][0] + bv[bj][0]) * sc, v1 = (acc[ai][bj][m][1] + bv[bj][1]) * sc;
                    if (act == 1) {
#pragma unroll
                        for (int i = 0; i < 4; ++i) { v0[i] = fgelu_tanh(v0[i]); v1[i] = fgelu_tanh(v1[i]); } }
                    else if (act == 2) {
#pragma unroll
                        for (int i = 0; i < 4; ++i) { v0[i] = fsigmoid(v0[i]); v1[i] = fsigmoid(v1[i]); } }
                    u32x4 w; w.x = cvt_pk_bf16(v0[0], v0[1]); w.y = cvt_pk_bf16(v0[2], v0[3]); w.z = cvt_pk_bf16(v1[0], v1[1]); w.w = cvt_pk_bf16(v1[2], v1[3]);
                    if (mode == 0 && bj == 1 && (pn == 5 || pn == 6)) {
                        const int row = row0 + ai * HALF + m * 16, bb = row >> 11, t = row & 2047;
                        bf16_t* vt = (pn == 5 ? VTS : VTW) + ((size_t)((bb * 2 + (wc >> 1)) * 64 + (wc & 1) * 32 + 8 * fq)) * 2048 + t;
                        vt[0 * 2048] = (bf16_t)(w.x & 0xffffu); vt[1 * 2048] = (bf16_t)(w.x >> 16); vt[2 * 2048] = (bf16_t)(w.y & 0xffffu); vt[3 * 2048] = (bf16_t)(w.y >> 16);
                        vt[4 * 2048] = (bf16_t)(w.z & 0xffffu); vt[5 * 2048] = (bf16_t)(w.z >> 16); vt[6 * 2048] = (bf16_t)(w.w & 0xffffu); vt[7 * 2048] = (bf16_t)(w.w >> 16);
                    } else if (!only0 || (wc == 0 && bj == 0)) *(u32x4*)(bp + (ai * HALF + m * 16) * ld + bj * HALF) = w; }
                asm volatile("" ::: "memory"); }
    }
};
struct EpiMerge {
    static constexpr bool PERM = true, AFTER_DRAIN = false;
    const bf16_t* G; int goff; bf16_t* MRG; int accum;
    __device__ __forceinline__ void operator()(const f32x4 (&acc)[2][2][4][2], const Unit& u, int wr, int wc, int fr, int fq) const {
        const int row0 = u.pm * BM + wr * 64 + fr, col0 = u.pn * BM + wc * 32 + 8 * fq;
#pragma unroll
        for (int ai = 0; ai < 2; ++ai)
#pragma unroll
            for (int m = 0; m < 4; ++m) { const size_t r = (size_t)(row0 + ai * HALF + m * 16);
#pragma unroll
                for (int bj = 0; bj < 2; ++bj) {
#ifdef MERGE_NOGATE
                    const u32x4 g = (u32x4){0x3f803f80u, 0x3f803f80u, 0x3f803f80u, 0x3f803f80u};
#else
                    const u32x4 g = *(const u32x4*)(G + r * 3072 + goff + col0 + bj * HALF);
#endif
                    bf16_t* p = MRG + r * 1024 + col0 + bj * HALF;
                    f32x4 v0 = acc[ai][bj][m][0], v1 = acc[ai][bj][m][1];
                    v0[0] *= bflo(g.x); v0[1] *= bfhi(g.x); v0[2] *= bflo(g.y); v0[3] *= bfhi(g.y);
                    v1[0] *= bflo(g.z); v1[1] *= bfhi(g.z); v1[2] *= bflo(g.w); v1[3] *= bfhi(g.w);
                    if (accum) { const u32x4 o = *(const u32x4*)p;
                        v0[0] += bflo(o.x); v0[1] += bfhi(o.x); v0[2] += bflo(o.y); v0[3] += bfhi(o.y);
                        v1[0] += bflo(o.z); v1[1] += bfhi(o.z); v1[2] += bflo(o.w); v1[3] += bfhi(o.w); }
                    u32x4 w; w.x = cvt_pk_bf16(v0[0], v0[1]); w.y = cvt_pk_bf16(v0[2], v0[3]); w.z = cvt_pk_bf16(v1[0], v1[1]); w.w = cvt_pk_bf16(v1[2], v1[3]);
                    *(u32x4*)p = w; } }
    }
};
template <class Epi, class Sched, bool ALIGN_EPI = false, bool SP2 = false>
__device__ __forceinline__ void gemm_phase(PG8_LAS unsigned char* lds, const Gemm g, const Sched& S, const Epi& E) {
    int tid_o = threadIdx.x; asm volatile("" : "+v"(tid_o));
    const int tid = tid_o, wid = __builtin_amdgcn_readfirstlane(tid >> 6), lane = tid & 63, wr = wid >> 2, wc = wid & 3, fr = lane & 15, fq = lane >> 4;
    const int K = g.K, nt = K / BK;
    unsigned voffA[2], voffB[2];
#pragma unroll
    for (int i = 0; i < 2; ++i) { int R, C; stage_rc(tid * 16 + i * 8192, R, C); const int Rb = Epi::PERM ? ((R & ~31) + perm32(R & 31)) : R;
        voffA[i] = (unsigned)(R * K + C) * 2u; voffB[i] = (unsigned)(Rb * K + C) * 2u; }
    const size_t kstep = (size_t)(BK * 2);
    const size_t hstep = (size_t)HALF * K * 2;
    const size_t tstep = 2 * hstep;
    const unsigned ldsw = (unsigned)wid * 1024u;
    const int aoff = lds_byte(wr * 64 + fr, fq * 8), boff = lds_byte(wc * 32 + fr, fq * 8);
#define PG8_SA(b, h) (((b) * 2 + (h)) * HTB)
#define PG8_SB(b, h) ((4 + (b) * 2 + (h)) * HTB)
#define PG8_STAGE(bufoff, gbase, voff) do { _Pragma("unroll") for (int _i = 0; _i < 2; ++_i) \
        __builtin_amdgcn_global_load_lds((const unsigned*)((const char*)(gbase) + (voff)[_i]), (PG8_LAS unsigned*)(lds + (bufoff) + ldsw + _i * 8192), 16, 0, 0); } while (0)
#define PG8_LDA(dst, b, h) do { _Pragma("unroll") for (int m = 0; m < 4; ++m) _Pragma("unroll") for (int k = 0; k < 2; ++k) dst[m][k] = *(const PG8_LAS bf16x8*)(lds + PG8_SA(b, h) + aoff + m * 2048 + k * 1024); } while (0)
#define PG8_LDB(dst, b, h) do { _Pragma("unroll") for (int n = 0; n < 2; ++n) _Pragma("unroll") for (int k = 0; k < 2; ++k) dst[n][k] = *(const PG8_LAS bf16x8*)(lds + PG8_SB(b, h) + boff + n * 2048 + k * 1024); } while (0)
#define PG8_MMA(ai, bj, At, Bt) do { __builtin_amdgcn_s_setprio(1); _Pragma("unroll") for (int m = 0; m < 4; ++m) _Pragma("unroll") for (int n = 0; n < 2; ++n) _Pragma("unroll") for (int k = 0; k < 2; ++k) \
        acc[ai][bj][m][n] = __builtin_amdgcn_mfma_f32_16x16x32_bf16(Bt[n][k], At[m][k], acc[ai][bj][m][n], 0, 0, 0); __builtin_amdgcn_s_setprio(0); } while (0)
#define PG8_WAIT_V(n) asm volatile("s_waitcnt vmcnt(" #n ")" ::: "memory")
#define PG8_WAIT_L(n) asm volatile("s_waitcnt lgkmcnt(" #n ")" ::: "memory")
#define PG8_BAR __builtin_amdgcn_s_barrier()
#define PG8_SCHED __builtin_amdgcn_sched_barrier(0)
    Unit cur, nxt; int ui = 0;
    if (!S.next(0, cur)) return;
    f32x4 acc[2][2][4][2];
#pragma unroll
    for (int a = 0; a < 2; ++a)
#pragma unroll
        for (int b = 0; b < 2; ++b)
#pragma unroll
            for (int m = 0; m < 4; ++m)
#pragma unroll
                for (int n = 0; n < 2; ++n) acc[a][b][m][n] = (f32x4){0.f, 0.f, 0.f, 0.f};
    bf16x8 At[4][2], B0[2][2], B1[2][2];
    const char* cA = (const char*)g.A + (size_t)cur.pm * tstep; const char* cB = (const char*)g.Bt + (size_t)cur.pn * tstep;
    S.a_ready(cur);
    if constexpr (SP2) {
        PG8_STAGE(PG8_SB(0, 0), cB, voffB); PG8_STAGE(PG8_SB(0, 1), cB + hstep, voffB); PG8_STAGE(PG8_SA(0, 0), cA, voffA); PG8_STAGE(PG8_SA(0, 1), cA + hstep, voffA);
        if (wr == 1) PG8_BAR;
        PG8_WAIT_V(2); PG8_BAR;
        PG8_STAGE(PG8_SB(1, 0), cB + kstep, voffB); PG8_STAGE(PG8_SA(1, 0), cA + kstep, voffA); PG8_STAGE(PG8_SB(1, 1), cB + hstep + kstep, voffB);
        PG8_WAIT_V(6); PG8_BAR;
    } else {
        PG8_STAGE(PG8_SB(0, 0), cB, voffB); PG8_STAGE(PG8_SA(0, 0), cA, voffA); PG8_STAGE(PG8_SB(0, 1), cB + hstep, voffB); PG8_STAGE(PG8_SA(0, 1), cA + hstep, voffA);
        if (wr == 1) PG8_BAR;
        PG8_WAIT_V(4); PG8_BAR;
        PG8_STAGE(PG8_SB(1, 0), cB + kstep, voffB); PG8_STAGE(PG8_SA(1, 0), cA + kstep, voffA); PG8_STAGE(PG8_SB(1, 1), cB + hstep + kstep, voffB);
        PG8_WAIT_V(6); PG8_BAR;
    }
    for (;;) {
        const bool has_next = S.next(ui + 1, nxt);
        const char* nA = has_next ? (const char*)g.A + (size_t)nxt.pm * tstep : cA; const char* nB = has_next ? (const char*)g.Bt + (size_t)nxt.pn * tstep : cB;
        for (int t = 0; t < nt; t += 2) {
            const bool last = (t == nt - 2);
            const char* a1 = cA + (size_t)(t + 1) * kstep;
            const char* a2 = last ? nA : cA + (size_t)(t + 2) * kstep; const char* b2 = last ? nB : cB + (size_t)(t + 2) * kstep;
            const char* a3 = a2 + kstep; const char* b3 = b2 + kstep;
            if (last && has_next) S.a_ready(nxt);
            if constexpr (SP2) {
            PG8_LDB(B0, 0, 0); PG8_LDB(B1, 0, 1); PG8_SCHED; PG8_LDA(At, 0, 0); PG8_STAGE(PG8_SA(1, 1), a1 + hstep, voffA);
            PG8_WAIT_V(8); PG8_WAIT_L(0); PG8_BAR; PG8_MMA(0, 0, At, B0); PG8_MMA(0, 1, At, B1); PG8_BAR; PG8_SCHED;
            PG8_LDA(At, 0, 1); PG8_STAGE(PG8_SB(0, 0), b2, voffB); PG8_STAGE(PG8_SB(0, 1), b2 + hstep, voffB); PG8_STAGE(PG8_SA(0, 0), a2, voffA);
            PG8_WAIT_V(8); PG8_WAIT_L(0); PG8_BAR; PG8_MMA(1, 0, At, B0); PG8_MMA(1, 1, At, B1); PG8_BAR; PG8_SCHED;
            PG8_LDB(B0, 1, 0); PG8_LDB(B1, 1, 1); PG8_SCHED; PG8_LDA(At, 1, 0); PG8_STAGE(PG8_SA(0, 1), a2 + hstep, voffA);
            PG8_WAIT_V(8); PG8_WAIT_L(0); PG8_BAR; PG8_MMA(0, 0, At, B0); PG8_MMA(0, 1, At, B1); PG8_BAR; PG8_SCHED;
            PG8_LDA(At, 1, 1); PG8_STAGE(PG8_SB(1, 0), b3, voffB); PG8_STAGE(PG8_SB(1, 1), b3 + hstep, voffB); PG8_STAGE(PG8_SA(1, 0), a3, voffA);
            PG8_WAIT_V(8); PG8_WAIT_L(0); PG8_BAR; PG8_MMA(1, 0, At, B0); PG8_MMA(1, 1, At, B1); PG8_BAR; PG8_SCHED;
            } else {
            PG8_LDB(B0, 0, 0); PG8_SCHED; PG8_LDA(At, 0, 0); PG8_STAGE(PG8_SA(1, 1), a1 + hstep, voffA);
            PG8_WAIT_L(8); PG8_BAR; PG8_WAIT_L(0); PG8_MMA(0, 0, At, B0); PG8_BAR; PG8_SCHED;
            PG8_LDB(B1, 0, 1); PG8_STAGE(PG8_SB(0, 0), b2, voffB);
            PG8_BAR; PG8_WAIT_L(0); PG8_MMA(0, 1, At, B1); PG8_BAR;
            PG8_LDA(At, 0, 1); PG8_STAGE(PG8_SA(0, 0), a2, voffA);
            PG8_BAR; PG8_WAIT_L(0); PG8_MMA(1, 0, At, B0); PG8_BAR; PG8_SCHED;
            PG8_STAGE(PG8_SB(0, 1), b2 + hstep, voffB);
            PG8_WAIT_V(6); PG8_BAR; PG8_MMA(1, 1, At, B1); PG8_BAR;
            PG8_LDB(B0, 1, 0); PG8_SCHED; PG8_LDA(At, 1, 0); PG8_STAGE(PG8_SA(0, 1), a2 + hstep, voffA);
            PG8_WAIT_L(8); PG8_BAR; PG8_WAIT_L(0); PG8_MMA(0, 0, At, B0); PG8_BAR; PG8_SCHED;
            PG8_LDB(B1, 1, 1); PG8_STAGE(PG8_SB(1, 0), b3, voffB);
            PG8_BAR; PG8_WAIT_L(0); PG8_MMA(0, 1, At, B1); PG8_BAR;
            PG8_LDA(At, 1, 1); PG8_STAGE(PG8_SA(1, 0), a3, voffA);
            PG8_BAR; PG8_WAIT_L(0); PG8_MMA(1, 0, At, B0); PG8_BAR; PG8_SCHED;
            PG8_STAGE(PG8_SB(1, 1), b3 + hstep, voffB);
            PG8_WAIT_V(6); PG8_BAR; PG8_MMA(1, 1, At, B1); PG8_BAR;
            }
        }
        if constexpr (ALIGN_EPI) { if (wr == 0) PG8_BAR; }
        if constexpr (!Epi::AFTER_DRAIN) { E(acc, cur, wr, wc, fr, fq); S.done(cur); }
        if (!has_next) break;
#pragma unroll
        for (int a = 0; a < 2; ++a)
#pragma unroll
            for (int b = 0; b < 2; ++b)
#pragma unroll
                for (int m = 0; m < 4; ++m)
#pragma unroll
                    for (int n = 0; n < 2; ++n) acc[a][b][m][n] = (f32x4){0.f, 0.f, 0.f, 0.f};
        cur = nxt; cA = nA; cB = nB; ++ui;
        if constexpr (ALIGN_EPI) { if (wr == 1) PG8_BAR; }
    }
    PG8_WAIT_V(0);
    if constexpr (!ALIGN_EPI) { if (wr == 0) PG8_BAR; }
    PG8_BAR;
    if constexpr (Epi::AFTER_DRAIN) { E.fused(acc, cur, wr, wc, fr, fq, lds, wid, lane); S.done(cur); }
#undef PG8_SA
#undef PG8_SB
#undef PG8_STAGE
#undef PG8_LDA
#undef PG8_LDB
#undef PG8_MMA
#undef PG8_WAIT_V
#undef PG8_WAIT_L
#undef PG8_BAR
#undef PG8_SCHED
}
}
#define LAS __attribute__((address_space(3)))
typedef unsigned short bf16_t;
typedef short bf16x8 __attribute__((ext_vector_type(8)));
typedef short s16x4 __attribute__((ext_vector_type(4)));
typedef float f32x4 __attribute__((ext_vector_type(4)));
typedef unsigned u32x4 __attribute__((ext_vector_type(4)));
typedef unsigned u32x2 __attribute__((ext_vector_type(2)));
using pg8::cvt_pk_bf16; using pg8::fsigmoid; using pg8::bflo; using pg8::bfhi;
#define MFMA16(a, b, c) __builtin_amdgcn_mfma_f32_16x16x32_bf16((a), (b), (c), 0, 0, 0)

constexpr int DM = 1024, NBATCH = 8, SEQ = 2048, MT = NBATCH * SEQ, DFF = 2816, MEML = 256, MM = NBATCH * MEML, DEPTH = 2, INC = 5912;
constexpr int NWAVES = 8, NTHREADS = 512;
constexpr float EPS = 1e-6f, LOG2E = 1.4426950408889634f;
constexpr int PH_PER_LAYER = 17, NPHASES = 1 + DEPTH * PH_PER_LAYER;

enum { I_X = 0, I_MEM, I_FF1_PRE, I_FF1_W1, I_FF1_W3, I_FF1_W2, I_FF1_POST, I_MIX_PRE, I_WIN, I_BIN, I_POOLW, I_POOLS, I_CPK, I_CW1K, I_CW2K, I_CPV, I_CW1V, I_CW2V,
       I_GLNG, I_GLNB, I_GWS, I_GBS, I_WBRP, I_WBRN, I_WBRG, I_WMIX, I_MIX_POST, I_MEM_PRE, I_MEM_KVG, I_WQ, I_WK, I_WV, I_WO, I_MEM_POST, I_FF2_PRE, I_FF2_W1, I_FF2_W3, I_FF2_W2, I_FF2_POST, N_IN };

constexpr size_t MiB = 1u << 20, KiB = 1024;
constexpr size_t WS_W13A = 1 * MiB, WS_W2A = 12 * MiB, WS_W13B = 17 * MiB + 512 * KiB, WS_W2B = 28 * MiB + 512 * KiB, WS_WIN = 34 * MiB, WS_WMG = 40 * MiB,
                 WS_WCOMB = 46 * MiB, WS_WBRN = 47 * MiB, WS_WBRG = 48 * MiB, WS_WMIX = 49 * MiB, WS_WQ = 51 * MiB, WS_WKV = 53 * MiB, WS_WO = 57 * MiB,
                 WS_W1K = 59 * MiB, WS_W1V = 60 * MiB, WS_W2K = 61 * MiB, WS_W2V = 61 * MiB + 32 * KiB, WS_GWS = 61 * MiB + 64 * KiB, WS_BIASIN = 61 * MiB + 192 * KiB,
                 WS_POSB = 61 * MiB + 208 * KiB;
constexpr size_t WS_XN = 62 * MiB, WS_MEMN = 94 * MiB, WS_KVM = 98 * MiB, WS_KC = 106 * MiB, WS_VC = 106 * MiB + 512 * KiB, WS_BIG = 107 * MiB;
constexpr size_t WS_H = WS_BIG, WS_YF = WS_BIG + 88 * MiB;
constexpr size_t WS_ZA = WS_BIG, WS_ZQ = WS_BIG + 16 * MiB, WS_ZKV = WS_BIG + 32 * MiB, WS_ZGM = WS_BIG + 56 * MiB, WS_ZG = WS_BIG + 88 * MiB;
constexpr size_t WS_G = WS_BIG, WS_P = WS_BIG + 96 * MiB, WS_O = WS_BIG + 112 * MiB, WS_U = WS_BIG + 128 * MiB, WS_MRG = WS_BIG + 144 * MiB, WS_YM = WS_BIG;
constexpr size_t WS_QX = WS_BIG, WS_OX = WS_BIG + 32 * MiB;
constexpr size_t WS_VTS = WS_BIG + 176 * MiB, WS_VTW = WS_VTS + 4 * MiB, WS_VTM = WS_VTW + 4 * MiB;
constexpr size_t WS_END = WS_VTM + 4 * MiB;

constexpr int LDS_BYTES = 147456;

struct Args { const float* in[N_IN]; float* out; unsigned char* ws; int ph_lo, ph_hi; };
typedef const unsigned char __attribute__((address_space(4)))* karg_t;
#define AIN(i) (*(const float* const __attribute__((address_space(4)))*)(kp + 8 * (i)))

__device__ __forceinline__ float wave_sum(float v) {
#pragma unroll
    for (int o = 1; o < 64; o <<= 1) v += __shfl_xor(v, o);
    return v;
}
#define LDS_WAIT() asm volatile("s_waitcnt lgkmcnt(0)" ::: "memory")

struct TSeg { const float* W; int K, N, col0, ncols, nvalid; bf16_t* WT; int mode, row0; };
__device__ __forceinline__ void transpose_item(const TSeg& s, LAS float* scr, int item, int lane) {
    const int nblk = s.ncols / 32, kb = item / nblk, nb = item % nblk, k0 = 64 * kb, n0 = 32 * nb;
    const int c4 = (lane & 7) * 4, nl = n0 + c4;
    f32x4 v[8];
#pragma unroll
    for (int i = 0; i < 8; ++i) { const int kk = i * 8 + (lane >> 3);
        v[i] = (nl < s.nvalid) ? *(const f32x4*)(s.W + (size_t)(k0 + kk) * s.N + s.col0 + nl) : (f32x4){0.f, 0.f, 0.f, 0.f}; }
#pragma unroll
    for (int i = 0; i < 8; ++i) { const int kk = i * 8 + (lane >> 3); *(LAS f32x4*)(scr + kk * 36 + c4) = v[i]; }
    LDS_WAIT(); asm volatile("" ::: "memory");
    const int c = lane & 7;
#pragma unroll
    for (int j = 0; j < 4; ++j) { const int nloc = (lane >> 3) + 8 * j, n = n0 + nloc; const LAS float* sp = scr + (8 * c) * 36 + nloc;
        const int drow = s.mode == 0 ? s.row0 + n : (n >> 7) * 256 + (n & 127) + s.row0;
        u32x4 o; o.x = cvt_pk_bf16(sp[0 * 36], sp[1 * 36]); o.y = cvt_pk_bf16(sp[2 * 36], sp[3 * 36]); o.z = cvt_pk_bf16(sp[4 * 36], sp[5 * 36]); o.w = cvt_pk_bf16(sp[6 * 36], sp[7 * 36]);
        *(u32x4*)(s.WT + (size_t)drow * s.K + k0 + 8 * c) = o; }
    LDS_WAIT(); asm volatile("" ::: "memory");
}
constexpr int NSEG = 21;
__device__ __forceinline__ TSeg get_seg(karg_t kp, unsigned char* ws, int l, int seg) {
    TSeg s; s.col0 = 0; s.mode = 0; s.row0 = 0;
#define W(idx, per) (AIN(idx) + (size_t)l * (per))
    switch (seg) {
    case 0: s.W = W(I_FF1_W1, (size_t)DM * DFF); s.K = DM; s.N = DFF; s.ncols = DFF; s.WT = (bf16_t*)(ws + WS_W13A); s.mode = 1; s.row0 = 0; break;
    case 1: s.W = W(I_FF1_W3, (size_t)DM * DFF); s.K = DM; s.N = DFF; s.ncols = DFF; s.WT = (bf16_t*)(ws + WS_W13A); s.mode = 1; s.row0 = 128; break;
    case 2: s.W = W(I_FF1_W2, (size_t)DM * DFF); s.K = DFF; s.N = DM; s.ncols = DM; s.WT = (bf16_t*)(ws + WS_W2A); break;
    case 3: s.W = W(I_FF2_W1, (size_t)DM * DFF); s.K = DM; s.N = DFF; s.ncols = DFF; s.WT = (bf16_t*)(ws + WS_W13B); s.mode = 1; s.row0 = 0; break;
    case 4: s.W = W(I_FF2_W3, (size_t)DM * DFF); s.K = DM; s.N = DFF; s.ncols = DFF; s.WT = (bf16_t*)(ws + WS_W13B); s.mode = 1; s.row0 = 128; break;
    case 5: s.W = W(I_FF2_W2, (size_t)DM * DFF); s.K = DFF; s.N = DM; s.ncols = DM; s.WT = (bf16_t*)(ws + WS_W2B); break;
    case 6: s.W = W(I_WIN, (size_t)DM * INC); s.K = DM; s.N = INC; s.col0 = 0; s.ncols = 1792; s.WT = (bf16_t*)(ws + WS_WIN); s.row0 = 0; break;
    case 7: s.W = W(I_WIN, (size_t)DM * INC); s.K = DM; s.N = INC; s.col0 = 1816; s.ncols = 1024; s.WT = (bf16_t*)(ws + WS_WIN); s.row0 = 1792; break;
    case 8: s.W = W(I_WIN, (size_t)DM * INC); s.K = DM; s.N = INC; s.col0 = 1792; s.ncols = 256; s.WT = (bf16_t*)(ws + WS_WIN); s.row0 = 2816; break;
    case 9: s.W = W(I_WIN, (size_t)DM * INC); s.K = DM; s.N = INC; s.col0 = 2840; s.ncols = 3072; s.WT = (bf16_t*)(ws + WS_WMG); break;
    case 10: s.W = W(I_WBRN, (size_t)512 * DM); s.K = 512; s.N = DM; s.ncols = DM; s.WT = (bf16_t*)(ws + WS_WBRN); break;
    case 11: s.W = W(I_WBRG, (size_t)512 * DM); s.K = 512; s.N = DM; s.ncols = DM; s.WT = (bf16_t*)(ws + WS_WBRG); break;
    case 12: s.W = W(I_WMIX, (size_t)DM * DM); s.K = DM; s.N = DM; s.ncols = DM; s.WT = (bf16_t*)(ws + WS_WMIX); break;
    case 13: s.W = W(I_WQ, (size_t)DM * DM); s.K = DM; s.N = DM; s.ncols = DM; s.WT = (bf16_t*)(ws + WS_WQ); break;
    case 14: s.W = W(I_WK, (size_t)DM * DM); s.K = DM; s.N = DM; s.ncols = DM; s.WT = (bf16_t*)(ws + WS_WKV); s.row0 = 0; break;
    case 15: s.W = W(I_WV, (size_t)DM * DM); s.K = DM; s.N = DM; s.ncols = DM; s.WT = (bf16_t*)(ws + WS_WKV); s.row0 = 1024; break;
    case 16: s.W = W(I_WO, (size_t)DM * DM); s.K = DM; s.N = DM; s.ncols = DM; s.WT = (bf16_t*)(ws + WS_WO); break;
    case 17: s.W = W(I_CW1K, (size_t)2048 * 256); s.K = 2048; s.N = 256; s.ncols = 256; s.WT = (bf16_t*)(ws + WS_W1K); break;
    case 18: s.W = W(I_CW1V, (size_t)2048 * 256); s.K = 2048; s.N = 256; s.ncols = 256; s.WT = (bf16_t*)(ws + WS_W1V); break;
    case 19: s.W = W(I_CW2K, (size_t)256 * 64); s.K = 256; s.N = 64; s.ncols = 64; s.WT = (bf16_t*)(ws + WS_W2K); break;
    default: s.W = W(I_CW2V, (size_t)256 * 64); s.K = 256; s.N = 64; s.ncols = 64; s.WT = (bf16_t*)(ws + WS_W2V); break;
    }
#undef W
    s.nvalid = (seg == 8) ? 24 : s.ncols;
    return s;
}
__device__ __forceinline__ void row_pass(const float* Y, const float* gpost, float coef, const float* xin, float* xout, const float* gnext, bf16_t* XN, int nrows, int gw, int NGW, int lane) {
    for (int m = gw; m < nrows; m += NGW) {
        f32x4 xv[4];
#pragma unroll
        for (int j = 0; j < 4; ++j) xv[j] = *((const f32x4*)(xin + (size_t)m * DM) + lane + 64 * j);
        if (Y) {
            f32x4 yv[4]; float ss = 0.f;
#pragma unroll
            for (int j = 0; j < 4; ++j) { yv[j] = *((const f32x4*)(Y + (size_t)m * DM) + lane + 64 * j); ss += (yv[j].x * yv[j].x + yv[j].y * yv[j].y) + (yv[j].z * yv[j].z + yv[j].w * yv[j].w); }
            const float r = coef / sqrtf(wave_sum(ss) * (1.0f / DM) + EPS);
#pragma unroll
            for (int j = 0; j < 4; ++j) { const f32x4 g = *((const f32x4*)gpost + lane + 64 * j); xv[j] = xv[j] + yv[j] * g * r; }
        }
        if (xout) {
#pragma unroll
            for (int j = 0; j < 4; ++j) *((f32x4*)(xout + (size_t)m * DM) + lane + 64 * j) = xv[j];
        }
        if (gnext) {
            float ss = 0.f;
#pragma unroll
            for (int j = 0; j < 4; ++j) ss += (xv[j].x * xv[j].x + xv[j].y * xv[j].y) + (xv[j].z * xv[j].z + xv[j].w * xv[j].w);
            const float r = 1.0f / sqrtf(wave_sum(ss) * (1.0f / DM) + EPS);
#pragma unroll
            for (int j = 0; j < 4; ++j) { const f32x4 g = *((const f32x4*)gnext + lane + 64 * j); const f32x4 o = xv[j] * g * r;
                u32x2 w; w.x = cvt_pk_bf16(o.x, o.y); w.y = cvt_pk_bf16(o.z, o.w);
                *((u32x2*)(XN + (size_t)m * DM) + lane + 64 * j) = w; }
        }
    }
}
__device__ __forceinline__ void prep_layer(karg_t kp, unsigned char* ws, int l, LAS unsigned char* lds, int gw, int NGW, int wave, int lane, int tid, int G, int bid) {
    LAS float* scr = (LAS float*)(lds + wave * 16384);
#pragma unroll
    for (int seg = 0; seg < NSEG; ++seg) {
        karg_t kq = kp; asm volatile("" : "+s"(kq) :: "memory");
        const TSeg s = get_seg(kq, ws, l, seg);
        const int nitems = (s.K / 64) * (s.ncols / 32);
        for (int it = gw; it < nitems; it += NGW) transpose_item(s, scr, it, lane);
    }
    const int gt = bid * NTHREADS + tid, NGT = G * NTHREADS;
    { const float* pw = AIN(I_POOLW) + (size_t)l * 4 * 128 * 128; const float* psc = AIN(I_POOLS) + (size_t)l * 512; const float* wb = AIN(I_WBRP) + (size_t)l * 512 * DM;
      bf16_t* out = (bf16_t*)(ws + WS_WCOMB);
      for (int o = gt; o < 128 * DM; o += NGT) { const int n = o & (DM - 1), c = o >> 10; float s0 = 0.f, s1 = 0.f, s2 = 0.f, s3 = 0.f;
          const float* pr = pw + (size_t)c * 128;
#pragma unroll 8
          for (int d = 0; d < 128; ++d) {
              s0 += pr[d] * psc[d] * wb[(size_t)d * DM + n];
              s1 += pr[16384 + d] * psc[128 + d] * wb[(size_t)(128 + d) * DM + n];
              s2 += pr[32768 + d] * psc[256 + d] * wb[(size_t)(256 + d) * DM + n];
              s3 += pr[49152 + d] * psc[384 + d] * wb[(size_t)(384 + d) * DM + n]; }
          bf16_t* op = out + (size_t)n * 512 + c;
          op[0] = (bf16_t)(cvt_pk_bf16(s0, 0.f) & 0xffffu); op[128] = (bf16_t)(cvt_pk_bf16(s1, 0.f) & 0xffffu); op[256] = (bf16_t)(cvt_pk_bf16(s2, 0.f) & 0xffffu); op[384] = (bf16_t)(cvt_pk_bf16(s3, 0.f) & 0xffffu); } }
    { const float* gws = AIN(I_GWS) + (size_t)l * 4 * 128 * 128; bf16_t* out = (bf16_t*)(ws + WS_GWS);
      for (int o = gt; o < 4 * 128 * 128; o += NGT) { const int s2 = o & 127, t = (o >> 7) & 127; const float v = (s2 <= t) ? gws[o] : 0.f; out[o] = (bf16_t)(cvt_pk_bf16(v, 0.f) & 0xffffu); } }
    { const float* b = AIN(I_BIN) + (size_t)l * INC; float* out = (float*)(ws + WS_BIASIN);
      for (int o = gt; o < 3072; o += NGT) out[o] = o < 1792 ? b[o] : (o < 2816 ? b[o + 24] : (o < 2840 ? b[1792 + o - 2816] : 0.f)); }
    row_pass(nullptr, nullptr, 0.f, AIN(I_MEM), nullptr, AIN(I_MEM_KVG) + (size_t)l * DM, (bf16_t*)(ws + WS_MEMN), MM, gw, NGW, lane);
}
__device__ __forceinline__ void pool_pass(const bf16_t* ZA, bf16_t* P, int gt, int NGT) {
    for (int o = gt; o < MT * 64; o += NGT) {
        const int cc = o & 63, m = o >> 6, t = m & (SEQ - 1), w = 2 << (cc >> 4), cnt = (t + 1 < w) ? t + 1 : w;
        float s[8];
#pragma unroll
        for (int i = 0; i < 8; ++i) s[i] = 0.f;
        u32x4 self = (u32x4){0u, 0u, 0u, 0u};
        for (int i = 0; i < cnt; ++i) { const u32x4 v = *(const u32x4*)(ZA + (size_t)(m - i) * 512 + cc * 8);
            if (i == 0) self = v;
            s[0] += bflo(v.x); s[1] += bfhi(v.x); s[2] += bflo(v.y); s[3] += bfhi(v.y); s[4] += bflo(v.z); s[5] += bfhi(v.z); s[6] += bflo(v.w); s[7] += bfhi(v.w); }
        const float inv = 1.0f / (float)cnt;
        u32x4 r; r.x = cvt_pk_bf16(s[0] * inv - bflo(self.x), s[1] * inv - bfhi(self.x)); r.y = cvt_pk_bf16(s[2] * inv - bflo(self.y), s[3] * inv - bfhi(self.y));
        r.z = cvt_pk_bf16(s[4] * inv - bflo(self.z), s[5] * inv - bfhi(self.z)); r.w = cvt_pk_bf16(s[6] * inv - bflo(self.w), s[7] * inv - bfhi(self.w));
        *(u32x4*)(P + (size_t)m * 512 + cc * 8) = r;
    }
}
__device__ __forceinline__ void compress_unit(int unit, const bf16_t* ZKV, const bf16_t* W1t_k, const bf16_t* W1t_v, const bf16_t* W2t_k, const bf16_t* W2t_v, const float* pos_k, const float* pos_v,
                                              bf16_t* KC, bf16_t* VC, LAS unsigned char* lds, int wave, int lane) {
    const int which = unit & 1, nc = (unit >> 1) & 7, g = (unit >> 4) & 1, b = unit >> 5;
    const int r16 = lane & 15, quad = lane >> 4;
    const bf16_t* W1t = which ? W1t_v : W1t_k; const bf16_t* W2t = which ? W2t_v : W2t_k;
    const int n = nc * 16 + r16, ne = n < 127 ? n : 126;
    const bf16_t* arow = ZKV + ((size_t)b * SEQ + 16 * ne) * 768 + which * 128 + g * 64 + quad * 8;
    const bf16_t* b0 = W1t + (size_t)(wave * 32 + r16) * 2048 + quad * 8; const bf16_t* b1 = b0 + (size_t)16 * 2048;
    f32x4 acc0 = (f32x4){0.f, 0.f, 0.f, 0.f}, acc1 = acc0;
    const float* pos = (which ? pos_v : pos_k) + quad * 8;
#pragma unroll 8
    for (int ks = 0; ks < 64; ++ks) {
        const u32x4 ar = *(const u32x4*)(arow + (size_t)(ks >> 1) * 768 + (ks & 1) * 32);
        const f32x4 p0 = *(const f32x4*)(pos + ks * 32), p1 = *(const f32x4*)(pos + ks * 32 + 4);
        const bf16x8 bf0 = *(const bf16x8*)(b0 + ks * 32), bf1 = *(const bf16x8*)(b1 + ks * 32);
        u32x4 aw; aw.x = cvt_pk_bf16(bflo(ar.x) + p0.x, bfhi(ar.x) + p0.y); aw.y = cvt_pk_bf16(bflo(ar.y) + p0.z, bfhi(ar.y) + p0.w);
        aw.z = cvt_pk_bf16(bflo(ar.z) + p1.x, bfhi(ar.z) + p1.y); aw.w = cvt_pk_bf16(bflo(ar.w) + p1.z, bfhi(ar.w) + p1.w);
        const bf16x8 af = __builtin_bit_cast(bf16x8, aw);
        acc0 = MFMA16(af, bf0, acc0); acc1 = MFMA16(af, bf1, acc1);
    }
    LAS bf16_t* Hs = (LAS bf16_t*)lds;
    {
#pragma unroll
      for (int i = 0; i < 4; ++i) { const int row = quad * 4 + i;
          Hs[row * 264 + wave * 32 + r16] = (bf16_t)(cvt_pk_bf16(pg8::fgelu_tanh(acc0[i]), 0.f) & 0xffffu);
          Hs[row * 264 + wave * 32 + 16 + r16] = (bf16_t)(cvt_pk_bf16(pg8::fgelu_tanh(acc1[i]), 0.f) & 0xffffu); } }
    __syncthreads();
    if (wave < 4) {
        f32x4 acc = (f32x4){0.f, 0.f, 0.f, 0.f};
#pragma unroll
        for (int ks = 0; ks < 8; ++ks) {
            const bf16x8 af = *(const LAS bf16x8*)(Hs + r16 * 264 + ks * 32 + quad * 8);
            const bf16x8 bfr = *(const bf16x8*)(W2t + (size_t)(wave * 16 + r16) * 256 + ks * 32 + quad * 8);
            acc = MFMA16(af, bfr, acc);
        }
        f32x4 v = acc;
#pragma unroll
        for (int i = 0; i < 4; ++i) if (nc * 16 + quad * 4 + i >= 127) v[i] = 0.f;
        if (which) {
            u32x2 w; w.x = cvt_pk_bf16(v[0], v[1]); w.y = cvt_pk_bf16(v[2], v[3]);
            *(u32x2*)(VC + ((size_t)(b * 2 + g) * 64 + wave * 16 + r16) * 128 + nc * 16 + quad * 4) = w;
        } else {
            bf16_t* out = KC + ((size_t)(b * 2 + g) * 128 + nc * 16) * 64 + wave * 16 + r16;
#pragma unroll
            for (int i = 0; i < 4; ++i) out[(size_t)(quad * 4 + i) * 64] = (bf16_t)(cvt_pk_bf16(v[i], 0.f) & 0xffffu);
        }
    }
    __syncthreads();
}
__device__ __forceinline__ void gmlp_unit(int unit, const bf16_t* ZGM, const bf16_t* Wg, const float* lng, const float* lnb, const float* bs, bf16_t* U, LAS unsigned char* lds, int wave, int lane, int tid) {
    const int gq = unit & 3, c = unit >> 2, m0 = c * 128;
    LAS bf16_t* Vt = (LAS bf16_t*)lds;
    LAS float* st = (LAS float*)(lds + 128 * 136 * 2);
#pragma unroll
    for (int i = 0; i < 16; ++i) { const int tok = wave * 16 + i;
        const u32x4 v = *(const u32x4*)(ZGM + (size_t)(m0 + tok) * 1024 + 512 + lane * 8);
        float f[8] = {bflo(v.x), bfhi(v.x), bflo(v.y), bfhi(v.y), bflo(v.z), bfhi(v.z), bflo(v.w), bfhi(v.w)};
        float s = 0.f;
#pragma unroll
        for (int j = 0; j < 8; ++j) s += f[j];
        const float mean = wave_sum(s) * (1.0f / 512.f); float q = 0.f;
#pragma unroll
        for (int j = 0; j < 8; ++j) { const float d = f[j] - mean; q += d * d; }
        const float rstd = 1.0f / sqrtf(wave_sum(q) * (1.0f / 512.f) + EPS);
        if (lane == 0) { st[tok * 2] = mean; st[tok * 2 + 1] = rstd; } }
    __syncthreads();
    { const int tok = tid >> 2, part = tid & 3; const float mean = st[tok * 2], rstd = st[tok * 2 + 1];
#pragma unroll
      for (int q4 = 0; q4 < 4; ++q4) { const int d0 = part * 32 + q4 * 8, ch = gq * 128 + d0;
          const u32x4 v = *(const u32x4*)(ZGM + (size_t)(m0 + tok) * 1024 + 512 + ch);
          const f32x4 g0 = *(const f32x4*)(lng + ch), g1 = *(const f32x4*)(lng + ch + 4), b0 = *(const f32x4*)(lnb + ch), b1 = *(const f32x4*)(lnb + ch + 4);
          float f[8] = {bflo(v.x), bfhi(v.x), bflo(v.y), bfhi(v.y), bflo(v.z), bfhi(v.z), bflo(v.w), bfhi(v.w)};
          float gg[8] = {g0.x, g0.y, g0.z, g0.w, g1.x, g1.y, g1.z, g1.w}, bb[8] = {b0.x, b0.y, b0.z, b0.w, b1.x, b1.y, b1.z, b1.w};
#pragma unroll
          for (int j = 0; j < 8; ++j) Vt[(d0 + j) * 136 + tok] = (bf16_t)(cvt_pk_bf16((f[j] - mean) * rstd * gg[j] + bb[j], 0.f) & 0xffffu); } }
    __syncthreads();
    { const int r16 = lane & 15, quad = lane >> 4, t = wave * 16 + r16;
      f32x4 acc[8];
#pragma unroll
      for (int dt = 0; dt < 8; ++dt) acc[dt] = (f32x4){0.f, 0.f, 0.f, 0.f};
      const int nks = (wave * 16 + 15) / 32 + 1;
      for (int ks = 0; ks < nks; ++ks) {
          const bf16x8 bfr = *(const bf16x8*)(Wg + ((size_t)gq * 128 + t) * 128 + ks * 32 + quad * 8);
#pragma unroll
          for (int dt = 0; dt < 8; ++dt) { const bf16x8 af = *(const LAS bf16x8*)(Vt + (dt * 16 + r16) * 136 + ks * 32 + quad * 8); acc[dt] = MFMA16(af, bfr, acc[dt]); }
      }
      const float bias = bs[gq * 128 + t];
#pragma unroll
      for (int dt = 0; dt < 8; ++dt) { const int d = gq * 128 + dt * 16 + quad * 4;
          const u32x2 uu = *(const u32x2*)(ZGM + (size_t)(m0 + t) * 1024 + d);
          u32x2 w; w.x = cvt_pk_bf16(bflo(uu.x) * (acc[dt][0] + bias), bfhi(uu.x) * (acc[dt][1] + bias)); w.y = cvt_pk_bf16(bflo(uu.y) * (acc[dt][2] + bias), bfhi(uu.y) * (acc[dt][3] + bias));
          *(u32x2*)(U + (size_t)(m0 + t) * 512 + d) = w; } }
    __syncthreads();
}
template <int D> struct KVRegs { u32x4 k[D / 64], v[D / 64]; };
template <int D> __device__ __forceinline__ void kv_load(KVRegs<D>& R, const bf16_t* Kg, int ldk, const bf16_t* Vg, int ldv, int tid) {
#pragma unroll
    for (int i = 0; i < D / 64; ++i) { const int c = tid + i * NTHREADS;
        { const int r = c / (D / 8), cc = c % (D / 8); R.k[i] = *(const u32x4*)(Kg + (size_t)r * ldk + cc * 8); }
        { const int d = c >> 3, cc = c & 7; R.v[i] = *(const u32x4*)(Vg + (size_t)d * ldv + cc * 8); } }
}
template <int D> __device__ __forceinline__ void kv_store(const KVRegs<D>& R, LAS bf16_t* Ks, LAS bf16_t* Vt, int tid) {
#pragma unroll
    for (int i = 0; i < D / 64; ++i) { const int c = tid + i * NTHREADS;
        { const int r = c / (D / 8), cc = c % (D / 8); *(LAS u32x4*)(Ks + r * (D + 8) + cc * 8) = R.k[i]; }
        { const int d = c >> 3, cc = c & 7; *(LAS u32x4*)(Vt + d * 72 + cc * 8) = R.v[i]; } }
}
template <int D, int QS, class MaskF>
__device__ __forceinline__ void flash_block(const LAS bf16_t* Ks, const LAS bf16_t* Vt, const bf16x8 (&qf)[QS][D / 32], f32x4 (&acc)[QS][D / 16], float (&mrun)[QS], float (&lrun)[QS], const MaskF& allowed, int lane) {
    const int r16 = lane & 15, quad = lane >> 4;
#pragma unroll
    for (int qs = 0; qs < QS; ++qs) {
        f32x4 s[4];
#pragma unroll
        for (int kt = 0; kt < 4; ++kt) { s[kt] = (f32x4){0.f, 0.f, 0.f, 0.f};
#pragma unroll
            for (int ks = 0; ks < D / 32; ++ks) { const bf16x8 kf = *(const LAS bf16x8*)(Ks + (kt * 16 + r16) * (D + 8) + ks * 32 + quad * 8); s[kt] = MFMA16(kf, qf[qs][ks], s[kt]); } }
        float mx = -1e30f;
#pragma unroll
        for (int kt = 0; kt < 4; ++kt)
#pragma unroll
            for (int i = 0; i < 4; ++i) { const bool ok = allowed(qs, kt * 16 + quad * 4 + i); const float v = ok ? s[kt][i] * LOG2E : -1e30f; s[kt][i] = v; mx = fmaxf(mx, v); }
        mx = fmaxf(mx, __shfl_xor(mx, 16)); mx = fmaxf(mx, __shfl_xor(mx, 32));
        const float mnew = fmaxf(mrun[qs], mx), alpha = __builtin_amdgcn_exp2f(mrun[qs] - mnew); mrun[qs] = mnew;
        float ps = 0.f;
#pragma unroll
        for (int kt = 0; kt < 4; ++kt)
#pragma unroll
            for (int i = 0; i < 4; ++i) { const float p = (s[kt][i] > -1e29f) ? __builtin_amdgcn_exp2f(s[kt][i] - mnew) : 0.f; s[kt][i] = p; ps += p; }
        ps += __shfl_xor(ps, 16); ps += __shfl_xor(ps, 32);
        lrun[qs] = lrun[qs] * alpha + ps;
        bf16x8 pf[2];
#pragma unroll
        for (int kk = 0; kk < 2; ++kk) { u32x4 w; w.x = cvt_pk_bf16(s[2 * kk][0], s[2 * kk][1]); w.y = cvt_pk_bf16(s[2 * kk][2], s[2 * kk][3]); w.z = cvt_pk_bf16(s[2 * kk + 1][0], s[2 * kk + 1][1]); w.w = cvt_pk_bf16(s[2 * kk + 1][2], s[2 * kk + 1][3]);
            pf[kk] = __builtin_bit_cast(bf16x8, w); }
#pragma unroll
        for (int dt = 0; dt < D / 16; ++dt) { acc[qs][dt] = acc[qs][dt] * alpha;
#pragma unroll
            for (int kk = 0; kk < 2; ++kk) { const LAS bf16_t* vp = Vt + (dt * 16 + r16) * 72 + kk * 32 + quad * 4;
                const s16x4 lo = *(const LAS s16x4*)vp, hi = *(const LAS s16x4*)(vp + 16);
                const bf16x8 vf = __builtin_shufflevector(lo, hi, 0, 1, 2, 3, 4, 5, 6, 7);
                acc[qs][dt] = MFMA16(vf, pf[kk], acc[qs][dt]); } }
    }
}
constexpr int NSA_KS = 0, NSA_VT = 18432, NSA_IMP = NSA_VT + 17408, NSA_SEL = NSA_IMP + 32768, NSA_UNI = NSA_SEL + 256;
__device__ __forceinline__ void nsa_unit(int unit, const bf16_t* ZQ, const bf16_t* ZKV, const bf16_t* ZG, const bf16_t* KC, const bf16_t* VCT, const bf16_t* VTS, const bf16_t* VTW, bf16_t* O,
                                         LAS unsigned char* lds, int wave, int lane, int tid) {
    const int qb = unit & 63, g = (unit >> 6) & 1, b = unit >> 7, cur = qb >> 1;
    const int r16 = lane & 15, quad = lane >> 4, hh = wave & 3, h = g * 4 + hh, t0 = qb * 32;
    LAS bf16_t* Ks = (LAS bf16_t*)(lds + NSA_KS); LAS bf16_t* Vt = (LAS bf16_t*)(lds + NSA_VT);
    LAS float* impS = (LAS float*)(lds + NSA_IMP); LAS unsigned* selS = (LAS unsigned*)(lds + NSA_SEL); LAS unsigned* uniS = (LAS unsigned*)(lds + NSA_UNI);
    const int tok = (wave >> 2) * 16 + r16, tq = t0 + tok;
    const size_t row = (size_t)b * SEQ + tq;
    bf16x8 qf[1][2]; float gate[3];
#pragma unroll
    for (int ks = 0; ks < 2; ++ks) qf[0][ks] = *(const bf16x8*)(ZQ + row * 512 + h * 64 + ks * 32 + quad * 8);
#pragma unroll
    for (int c = 0; c < 3; ++c) gate[c] = fsigmoid(__uint_as_float((unsigned)ZG[row * 32 + h * 3 + c] << 16));
    const bf16_t* Kslc = ZKV + ((size_t)b * SEQ) * 768 + 2 * 128 + g * 64; const bf16_t* Kwin = Kslc + 2 * 128;
    const bf16_t* Vslc = VTS + (size_t)(b * 2 + g) * 64 * 2048; const bf16_t* Vwin = VTW + (size_t)(b * 2 + g) * 64 * 2048;
    KVRegs<64> R;
    kv_load<64>(R, Kslc, 768, Vslc, 2048, tid);
    f32x4 outv[4];
    { const bf16_t* Kg = KC + (size_t)(b * 2 + g) * 128 * 64; const bf16_t* Vg = VCT + (size_t)(b * 2 + g) * 64 * 128;
#pragma unroll
      for (int i = 0; i < 2; ++i) { const int c = tid + i * NTHREADS;
          { const int r = c >> 3, cc = c & 7; *(LAS u32x4*)(Ks + r * 72 + cc * 8) = *(const u32x4*)(Kg + r * 64 + cc * 8); }
          { const int d = c >> 4, cc = c & 15; *(LAS u32x4*)(Vt + d * 136 + cc * 8) = *(const u32x4*)(Vg + d * 128 + cc * 8); } }
      if (tid == 0) uniS[0] = 0u;
      __syncthreads();
      {
          f32x4 s[8]; float mx = -1e30f;
#pragma unroll
          for (int kt = 0; kt < 8; ++kt) { s[kt] = (f32x4){0.f, 0.f, 0.f, 0.f};
#pragma unroll
              for (int ks = 0; ks < 2; ++ks) { const bf16x8 kf = *(const LAS bf16x8*)(Ks + (kt * 16 + r16) * 72 + ks * 32 + quad * 8); s[kt] = MFMA16(kf, qf[0][ks], s[kt]); }
#pragma unroll
              for (int i = 0; i < 4; ++i) { const int n = kt * 16 + quad * 4 + i; const bool ok = (n < 127) && (16 * n + 31 <= tq); const float v = ok ? s[kt][i] * LOG2E : -1e30f; s[kt][i] = v; mx = fmaxf(mx, v); } }
          mx = fmaxf(mx, __shfl_xor(mx, 16)); mx = fmaxf(mx, __shfl_xor(mx, 32));
          float ps = 0.f;
#pragma unroll
          for (int kt = 0; kt < 8; ++kt)
#pragma unroll
              for (int i = 0; i < 4; ++i) { const float p = (s[kt][i] > -1e29f) ? __builtin_amdgcn_exp2f(s[kt][i] - mx) : 0.f; s[kt][i] = p; ps += p; }
          ps += __shfl_xor(ps, 16); ps += __shfl_xor(ps, 32);
          const float inv = ps > 0.f ? 1.0f / ps : 0.f;
          float so_prev = 0.f; const int src = (lane - 16) & 63;
#pragma unroll
          for (int kt = 0; kt < 8; ++kt) { s[kt] = s[kt] * inv;
              const float so = 0.5f * s[kt][3]; const float a1 = __shfl(so, src), a2 = __shfl(so_prev, src);
              const float v = (s[kt][0] + s[kt][1]) + (s[kt][2] + so) + (quad > 0 ? a1 : a2);
              impS[(hh * 32 + tok) * 32 + kt * 4 + quad] = v; so_prev = so; }
          f32x4 acc[4];
#pragma unroll
          for (int dt = 0; dt < 4; ++dt) acc[dt] = (f32x4){0.f, 0.f, 0.f, 0.f};
#pragma unroll
          for (int kk = 0; kk < 4; ++kk) { u32x4 w; w.x = cvt_pk_bf16(s[2 * kk][0], s[2 * kk][1]); w.y = cvt_pk_bf16(s[2 * kk][2], s[2 * kk][3]); w.z = cvt_pk_bf16(s[2 * kk + 1][0], s[2 * kk + 1][1]); w.w = cvt_pk_bf16(s[2 * kk + 1][2], s[2 * kk + 1][3]);
              const bf16x8 pf = __builtin_bit_cast(bf16x8, w);
#pragma unroll
              for (int dt = 0; dt < 4; ++dt) { const LAS bf16_t* vp = Vt + (dt * 16 + r16) * 136 + kk * 32 + quad * 4;
                  const s16x4 lo = *(const LAS s16x4*)vp, hi = *(const LAS s16x4*)(vp + 16);
                  acc[dt] = MFMA16(__builtin_shufflevector(lo, hi, 0, 1, 2, 3, 4, 5, 6, 7), pf, acc[dt]); } }
#pragma unroll
          for (int dt = 0; dt < 4; ++dt) outv[dt] = acc[dt] * gate[0];
      }
      __syncthreads();
#pragma unroll 1
      for (int pass = 0; pass < 2; ++pass) {
          const int tk = wave * 4 + pass * 2 + (lane >> 5), j = lane & 31;
          const float imp = (impS[tk * 32 + j] + impS[(32 + tk) * 32 + j]) + (impS[(64 + tk) * 32 + j] + impS[(96 + tk) * 32 + j]);
          const bool forced = (j == 0) || (j == cur) || (j == cur - 1);
          float v = forced ? 1e9f : (j <= cur ? imp : -1.0f);
          unsigned sel = 0u;
#pragma unroll 1
          for (int rnd = 0; rnd < 8; ++rnd) { float bv = v; int bj = j;
#pragma unroll
              for (int off = 16; off >= 1; off >>= 1) { const float ov = __shfl_xor(bv, off); const int oj = __shfl_xor(bj, off);
                  const bool take = (ov > bv) || (ov == bv && oj < bj); bv = take ? ov : bv; bj = take ? oj : bj; }
              sel |= 1u << bj; if (j == bj) v = -3.0e38f; }
          if (j == 0) { selS[tk] = sel; atomicOr((unsigned*)uniS, sel); } }
      __syncthreads();
    }
    const unsigned selm = selS[tok];
    unsigned todo = (unsigned)__builtin_amdgcn_readfirstlane((int)uniS[0]) & ((2u << cur) - 1u);
    f32x4 acc[1][4]; float mrun[1], lrun[1];
#define NSA_RESET() do { mrun[0] = -1e30f; lrun[0] = 0.f; _Pragma("unroll") for (int dt = 0; dt < 4; ++dt) acc[0][dt] = (f32x4){0.f, 0.f, 0.f, 0.f}; } while (0)
#define NSA_ACCUM(c) do { const float f = (lrun[0] > 0.f ? 1.0f / lrun[0] : 0.f) * gate[c]; _Pragma("unroll") for (int dt = 0; dt < 4; ++dt) outv[dt] = outv[dt] + acc[0][dt] * f; } while (0)
    NSA_RESET();
    const int jw0 = (cur > 4 ? cur - 4 : 0);
#pragma unroll 1
    while (todo) {
        const int j = __builtin_ctz(todo); todo &= todo - 1u;
        kv_store<64>(R, Ks, Vt, tid);
        __syncthreads();
        if (todo) { const int jn = __builtin_ctz(todo); kv_load<64>(R, Kslc + (size_t)jn * 64 * 768, 768, Vslc + jn * 64, 2048, tid); }
        else kv_load<64>(R, Kwin + (size_t)jw0 * 64 * 768, 768, Vwin + jw0 * 64, 2048, tid);
        auto mask = [=](int, int kl) { return (((selm >> j) & 1u) != 0u) && (j * 64 + kl <= tq); };
        flash_block<64, 1>(Ks, Vt, qf, acc, mrun, lrun, mask, lane);
        __syncthreads();
    }
    NSA_ACCUM(1);
    NSA_RESET();
#pragma unroll 1
    for (int j = jw0; j <= cur; ++j) {
        kv_store<64>(R, Ks, Vt, tid);
        __syncthreads();
        if (j < cur) kv_load<64>(R, Kwin + (size_t)(j + 1) * 64 * 768, 768, Vwin + (j + 1) * 64, 2048, tid);
        auto mask = [=](int, int kl) { const int kp = j * 64 + kl; return (kp <= tq) && (kp + 256 > tq); };
        flash_block<64, 1>(Ks, Vt, qf, acc, mrun, lrun, mask, lane);
        __syncthreads();
    }
    NSA_ACCUM(2);
#undef NSA_RESET
#undef NSA_ACCUM
#pragma unroll
    for (int dt = 0; dt < 4; ++dt) { u32x2 w; w.x = cvt_pk_bf16(outv[dt][0], outv[dt][1]); w.y = cvt_pk_bf16(outv[dt][2], outv[dt][3]);
        *(u32x2*)(O + row * 512 + h * 64 + dt * 16 + quad * 4) = w; }
}
__device__ __forceinline__ void cross_unit(int unit, const bf16_t* QX, const bf16_t* KM, const bf16_t* VTM, bf16_t* OX, LAS unsigned char* lds, int wave, int lane, int tid) {
    const int qblk = unit & 15, hd = (unit >> 4) & 3, b = unit >> 6;
    const int r16 = lane & 15, quad = lane >> 4;
    LAS bf16_t* Ks = (LAS bf16_t*)lds; LAS bf16_t* Vt = (LAS bf16_t*)(lds + 64 * 264 * 2);
    const size_t row = (size_t)b * SEQ + qblk * 128 + wave * 16 + r16;
    const bf16_t* Kg = KM + ((size_t)b * MEML) * 2048 + hd * 256; const bf16_t* Vg = VTM + (size_t)(b * 4 + hd) * 256 * 256;
    KVRegs<256> R;
    kv_load<256>(R, Kg, 2048, Vg, 256, tid);
    bf16x8 qf[1][8];
#pragma unroll
    for (int ks = 0; ks < 8; ++ks) qf[0][ks] = *(const bf16x8*)(QX + row * DM + hd * 256 + ks * 32 + quad * 8);
    f32x4 acc[1][16]; float mrun[1] = {-1e30f}, lrun[1] = {0.f};
#pragma unroll
    for (int dt = 0; dt < 16; ++dt) acc[0][dt] = (f32x4){0.f, 0.f, 0.f, 0.f};
#pragma unroll 1
    for (int j = 0; j < 4; ++j) {
        kv_store<256>(R, Ks, Vt, tid);
        __syncthreads();
        if (j < 3) kv_load<256>(R, Kg + (size_t)(j + 1) * 64 * 2048, 2048, Vg + (j + 1) * 64, 256, tid);
        auto mask = [](int, int) { return true; };
        flash_block<256, 1>(Ks, Vt, qf, acc, mrun, lrun, mask, lane);
        __syncthreads();
    }
    const float inv = 1.0f / lrun[0];
#pragma unroll
    for (int dt = 0; dt < 16; ++dt) { const f32x4 o = acc[0][dt] * inv; u32x2 w; w.x = cvt_pk_bf16(o[0], o[1]); w.y = cvt_pk_bf16(o[2], o[3]);
        *(u32x2*)(OX + row * DM + hd * 256 + dt * 16 + quad * 4) = w; }
}
template <class Epi> __device__ __forceinline__ void run_gemm(LAS unsigned char* lds, const bf16_t* A, const bf16_t* Bt, int M, int N, int K, int G, int c, const Epi& E) {
    asm volatile("" : "+s"(K), "+s"(N), "+s"(M));
    pg8::Gemm g{A, Bt, M, N, K}; pg8::StaticOrder S; S.init(M, N, G, c);
    pg8::gemm_phase<Epi, pg8::StaticOrder, true, true>(lds, g, S, E);
}
__global__ void __launch_bounds__(NTHREADS, 2) hybrid_fwd(Args args) {
    extern __shared__ __attribute__((aligned(16))) unsigned char lds_raw[];
    LAS unsigned char* lds = (LAS unsigned char*)lds_raw;
    bool rep_done = false; bool first = true;
    for (int ph = args.ph_lo; ph < args.ph_hi; ) {
        int G = gridDim.x, bid = blockIdx.x; asm volatile("" : "+s"(G), "+s"(bid));
        int tid = threadIdx.x; asm volatile("" : "+v"(tid));
        const int lane = tid & 63, wave = __builtin_amdgcn_readfirstlane(tid >> 6);
        const int gw = bid * NWAVES + wave, NGW = G * NWAVES, gt = bid * NTHREADS + tid, NGT = G * NTHREADS;
        karg_t kp = (karg_t)__builtin_amdgcn_kernarg_segment_ptr(); asm volatile("" : "+s"(kp));
        unsigned char* ws = *(unsigned char* const __attribute__((address_space(4)))*)(kp + 8 * (N_IN + 1));
        float* X = *(float* const __attribute__((address_space(4)))*)(kp + 8 * N_IN); bf16_t* XN = (bf16_t*)(ws + WS_XN);
        if (!first) { asm volatile("s_waitcnt vmcnt(0)" ::: "memory"); cg::this_grid().sync(); }
        first = false;
        const int l = ph == 0 ? 0 : (ph - 1) / PH_PER_LAYER, k = ph == 0 ? -1 : (ph - 1) % PH_PER_LAYER;
#define LP(idx, per) (AIN(idx) + (size_t)l * (per))
#ifndef PHM
#define PHM 0xFFFFFFFFu
#endif
#define EN(b) (((PHM) >> (b)) & 1u)
#ifndef REPEAT_MASK
#define REPEAT_MASK 0
#endif
#ifndef REPEAT_PREP
#define REPEAT_PREP 1
#endif
        if (EN(0) && k == -1) {
            for (int pr = 0; pr < REPEAT_PREP; ++pr) { prep_layer(kp, ws, 0, lds, gw, NGW, wave, lane, tid, G, bid); __syncthreads(); }
            row_pass(nullptr, nullptr, 0.f, AIN(I_X), X, AIN(I_FF1_PRE), XN, MT, gw, NGW, lane);
        } else if (EN(1) && (k == 0 || k == 14)) {
            pg8::EpiSwiGLU E{(bf16_t*)(ws + WS_H), DFF};
            run_gemm(lds, XN, (const bf16_t*)(ws + (k == 0 ? WS_W13A : WS_W13B)), MT, 2 * DFF, DM, G, bid, E);
        } else if (EN(2) && (k == 1 || k == 15 || k == 8 || k == 12)) {
            const bf16_t* A; const bf16_t* Bt; int K; float* Y;
            if (k == 1) { A = (const bf16_t*)(ws + WS_H); Bt = (const bf16_t*)(ws + WS_W2A); K = DFF; Y = (float*)(ws + WS_YF); }
            else if (k == 15) { A = (const bf16_t*)(ws + WS_H); Bt = (const bf16_t*)(ws + WS_W2B); K = DFF; Y = (float*)(ws + WS_YF); }
            else if (k == 8) { A = (const bf16_t*)(ws + WS_MRG); Bt = (const bf16_t*)(ws + WS_WMIX); K = DM; Y = (float*)(ws + WS_YM); }
            else { A = (const bf16_t*)(ws + WS_OX); Bt = (const bf16_t*)(ws + WS_WO); K = DM; Y = (float*)(ws + WS_YF); }
            pg8::EpiF32 E{Y, DM};
            run_gemm(lds, A, Bt, MT, DM, K, G, bid, E);
        } else if (EN(3) && (k == 2 || k == 9 || k == 13 || k == 16)) {
            const float *Y, *gpost, *gnext; float coef;
            if (k == 2) { Y = (const float*)(ws + WS_YF); gpost = LP(I_FF1_POST, DM); gnext = LP(I_MIX_PRE, DM); coef = 0.5f; }
            else if (k == 9) { Y = (const float*)(ws + WS_YM); gpost = LP(I_MIX_POST, DM); gnext = LP(I_MEM_PRE, DM); coef = 1.0f; }
            else if (k == 13) { Y = (const float*)(ws + WS_YF); gpost = LP(I_MEM_POST, DM); gnext = LP(I_FF2_PRE, DM); coef = 1.0f; }
            else { Y = (const float*)(ws + WS_YF); gpost = LP(I_FF2_POST, DM); gnext = (l + 1 < DEPTH) ? AIN(I_FF1_PRE) + (size_t)(l + 1) * DM : nullptr; coef = 0.5f; }
            row_pass(Y, gpost, coef, X, X, gnext, XN, MT, gw, NGW, lane);
            if (k == 16 && l + 1 < DEPTH) for (int pr = 0; pr < REPEAT_PREP; ++pr) { prep_layer(kp, ws, l + 1, lds, gw, NGW, wave, lane, tid, G, bid); __syncthreads(); }
        } else if (EN(4) && (k == 3 || k == 6)) {
            const bool gt6 = (k == 6);
            pg8::EpiZin E{gt6 ? LP(I_BIN, INC) + 2840 : (const float*)(ws + WS_BIASIN), (bf16_t*)(ws + (gt6 ? WS_G : WS_ZA)), (bf16_t*)(ws + WS_ZQ), (bf16_t*)(ws + WS_ZKV), (bf16_t*)(ws + WS_ZGM), (bf16_t*)(ws + WS_ZG), gt6 ? 1 : 0, (bf16_t*)(ws + WS_VTS), (bf16_t*)(ws + WS_VTW)};
            run_gemm(lds, XN, (const bf16_t*)(ws + (gt6 ? WS_WMG : WS_WIN)), MT, 3072, DM, G, bid, E);
        } else if (EN(5) && k == 4) {
            for (int u = bid; u < 256; u += G)
                compress_unit(u, (const bf16_t*)(ws + WS_ZKV), (const bf16_t*)(ws + WS_W1K), (const bf16_t*)(ws + WS_W1V), (const bf16_t*)(ws + WS_W2K), (const bf16_t*)(ws + WS_W2V),
                              LP(I_CPK, 2048), LP(I_CPV, 2048), (bf16_t*)(ws + WS_KC), (bf16_t*)(ws + WS_VC), lds, wave, lane);
            pool_pass((const bf16_t*)(ws + WS_ZA), (bf16_t*)(ws + WS_P), gt, NGT);
            for (int u = bid; u < 512; u += G)
                gmlp_unit(u, (const bf16_t*)(ws + WS_ZGM), (const bf16_t*)(ws + WS_GWS), LP(I_GLNG, 512), LP(I_GLNB, 512), LP(I_GBS, 512), (bf16_t*)(ws + WS_U), lds, wave, lane, tid);
        } else if (EN(6) && k == 5) {
            for (int u = bid; u < 1024; u += G) { const int uu = (u & ~63) | (63 - (u & 63));
                nsa_unit(uu, (const bf16_t*)(ws + WS_ZQ), (const bf16_t*)(ws + WS_ZKV), (const bf16_t*)(ws + WS_ZG), (const bf16_t*)(ws + WS_KC), (const bf16_t*)(ws + WS_VC), (const bf16_t*)(ws + WS_VTS), (const bf16_t*)(ws + WS_VTW), (bf16_t*)(ws + WS_O), lds, wave, lane, tid);
                __syncthreads(); }
        } else if (EN(8) && k == 7) {
#ifndef MERGE_MASK
#define MERGE_MASK 7
#endif
            int nacc = 0;
            for (int i = 0; i < 3; ++i) {
                if (!((MERGE_MASK >> i) & 1)) continue;
                const bf16_t* A = (const bf16_t*)(ws + (i == 0 ? WS_P : (i == 1 ? WS_O : WS_U)));
                const bf16_t* Bt = (const bf16_t*)(ws + (i == 0 ? WS_WCOMB : (i == 1 ? WS_WBRN : WS_WBRG)));
                pg8::EpiMerge E{(const bf16_t*)(ws + WS_G), i * 1024, (bf16_t*)(ws + WS_MRG), nacc}; nacc = 1;
#ifdef PROBE_BF16S
                { pg8::EpiBf16S E2{(bf16_t*)(ws + WS_MRG), DM, 1.0f, nullptr}; run_gemm(lds, A, Bt, MT, DM, 512, G, bid, E2); }
#else
                run_gemm(lds, A, Bt, MT, DM, 512, G, bid, E);
#endif
                asm volatile("s_waitcnt vmcnt(0)" ::: "memory"); __builtin_amdgcn_fence(__ATOMIC_RELEASE, "agent"); __syncthreads(); __builtin_amdgcn_fence(__ATOMIC_ACQUIRE, "agent");
            }
        } else if (k == 10) {
        } else if (EN(9) && k == 11) {
            for (int u = bid; u < 512; u += G) { cross_unit(u, (const bf16_t*)(ws + WS_QX), (const bf16_t*)(ws + WS_KVM), (const bf16_t*)(ws + WS_VTM), (bf16_t*)(ws + WS_OX), lds, wave, lane, tid); __syncthreads(); }
        }
        if (EN(10) && (k == 0 || k == 10)) {
            const bool kv = (k == 0);
            pg8::EpiBf16S E{(bf16_t*)(ws + (kv ? WS_KVM : WS_QX)), kv ? 2048 : DM, kv ? 1.0f : 0.0625f, kv ? (bf16_t*)(ws + WS_VTM) : (bf16_t*)nullptr};
            run_gemm(lds, kv ? (const bf16_t*)(ws + WS_MEMN) : XN, (const bf16_t*)(ws + (kv ? WS_WKV : WS_WQ)), kv ? MM : MT, kv ? 2048 : DM, DM, G, kv ? (bid + G / 2) % G : bid, E);
        }
#undef LP
        if (((REPEAT_MASK >> (k + 1)) & 1) && !rep_done) { rep_done = true; } else { rep_done = false; ++ph; }
    }
}

__global__ void dump_kernel(const unsigned short* src, float* out, size_t n, size_t ld_src, size_t cols) {
    for (size_t i = (size_t)blockIdx.x * blockDim.x + threadIdx.x; i < n; i += (size_t)gridDim.x * blockDim.x) { const size_t r = i / cols, c = i % cols; out[i] = ld_src == 0 ? ((const float*)src)[i] : __uint_as_float((unsigned)src[r * ld_src + c] << 16); }
}
#ifndef MK_SPLIT
#define MK_SPLIT 0
#endif
extern "C" void kernel_launch(void* const* d_in, const int* in_sizes, int n_in, void* d_out, int out_size, void* d_ws, size_t ws_size, hipStream_t stream) {
    static int grid = 0;
    if (grid == 0) {
        if (n_in != N_IN || out_size != MT * DM || ws_size < WS_END) { fprintf(stderr, "kernel_launch: unexpected shapes (n_in %d out %d ws %zu)\n", n_in, out_size, ws_size); grid = -1; return; }
        int dev = 0, cus = 0, per_cu = 0;
        hipGetDevice(&dev); hipDeviceGetAttribute(&cus, hipDeviceAttributeMultiprocessorCount, dev);
        hipFuncSetAttribute((const void*)hybrid_fwd, hipFuncAttributeMaxDynamicSharedMemorySize, LDS_BYTES);
        hipOccupancyMaxActiveBlocksPerMultiprocessor(&per_cu, (const void*)hybrid_fwd, NTHREADS, LDS_BYTES);
        (void)hipGetLastError();
        if (per_cu < 1) per_cu = 1;
        grid = cus;
        if (grid <= 0) grid = 256;
    }
    if (grid < 0) return;
    Args a{};
    for (int i = 0; i < N_IN; ++i) a.in[i] = (const float*)d_in[i];
    a.out = (float*)d_out; a.ws = (unsigned char*)d_ws;
#if MK_SPLIT
#ifndef PH_LIMIT
#define PH_LIMIT NPHASES
#endif
    for (int ph = 0; ph < PH_LIMIT; ++ph) { a.ph_lo = ph; a.ph_hi = ph + 1; hipLaunchKernelGGL(hybrid_fwd, dim3(grid), dim3(NTHREADS), LDS_BYTES, stream, a); }
#ifdef DUMP_OFF
    hipLaunchKernelGGL(dump_kernel, dim3(2048), dim3(256), 0, stream, (const unsigned short*)((unsigned char*)d_ws + (DUMP_OFF)), (float*)d_out, (size_t)MT * DUMP_COLS, (size_t)DUMP_LD, (size_t)DUMP_COLS);
#endif
#else
    a.ph_lo = 0; a.ph_hi = NPHASES;
    void* kargs[] = {&a};
    hipError_t e = hipLaunchCooperativeKernel((const void*)hybrid_fwd, dim3(grid), dim3(NTHREADS), kargs, LDS_BYTES, stream);
    if (e != hipSuccess) fprintf(stderr, "cooperative launch failed: %s (grid %d)\n", hipGetErrorString(e), grid);
#endif
}
```

```cpp
#include <hip/hip_runtime.h>
#include <hip/hip_cooperative_groups.h>
#include <cstdio>
#include <cstdint>
namespace cg = cooperative_groups;
namespace pg8 {
#define PG8_LAS __attribute__((address_space(3)))
typedef unsigned short bf16_t;
typedef short bf16x8 __attribute__((ext_vector_type(8)));
typedef float f32x4 __attribute__((ext_vector_type(4)));
typedef unsigned u32x4 __attribute__((ext_vector_type(4)));
constexpr int BM = 256, BK = 64, HALF = 128, HTB = HALF * BK * 2  , STAGE_BYTES = 8 * HTB, NXCD = 8, WGM = 8;

__host__ __device__ __forceinline__ int lds_byte(int r, int c) { const int st = (r >> 4) * 2 + (c >> 5), rr = r & 15, cc = c & 31, ob = rr * 64 + cc * 2; return st * 1024 + (ob ^ (((ob >> 9) & 1) << 5)); }
__host__ __device__ __forceinline__ void stage_rc(int b, int& R, int& C) { const int st = b / 1024, sb = b % 1024, swz = sb ^ (((sb >> 9) & 1) << 5); R = (st >> 1) * 16 + swz / 64; C = (st & 1) * 32 + (swz % 64) / 2; }
__host__ __device__ __forceinline__ int perm32(int rho) { const int n = rho >> 4, i = rho & 15; return 8 * (i >> 2) + 4 * n + (i & 3); }

struct Unit { int pm, pn; };
struct Gemm { const bf16_t* A; const bf16_t* Bt; int M, N, K; };

struct StaticOrder {
    int nM, nN, nwg, G, c;
    __host__ __device__ void init(int M, int N, int G_, int c_) { nM = M / BM; nN = N / BM; nwg = nM * nN; G = G_; c = c_; }
    __host__ __device__ bool next(int i, Unit& u) const {
        const long L = (long)i * G + c; if (L >= nwg) return false;
        int wgid = (int)L; { const int q = nwg / NXCD, r = nwg % NXCD, xcd = wgid % NXCD, off = wgid / NXCD; wgid = (xcd < r ? xcd * (q + 1) : r * (q + 1) + (xcd - r) * q) + off; }
        const int nig = WGM * nN, gid = wgid / nig, fm = gid * WGM, gsz = (nM - fm) < WGM ? (nM - fm) : WGM;
        u.pm = fm + ((wgid % nig) % gsz); u.pn = (wgid % nig) / gsz; return true;
    }
    __device__ __forceinline__ void a_ready(const Unit&) const {}
    __device__ __forceinline__ void done(const Unit&) const {}
};

typedef float f32x2_cv __attribute__((ext_vector_type(2))); typedef __bf16 bf16x2_cv __attribute__((ext_vector_type(2)));
__device__ __forceinline__ unsigned cvt_pk_bf16(float lo, float hi) { const f32x2_cv v = {lo, hi}; const bf16x2_cv b = __builtin_convertvector(v, bf16x2_cv); return __builtin_bit_cast(unsigned, b); }
typedef float f32x2 __attribute__((ext_vector_type(2)));
typedef unsigned u32x2 __attribute__((ext_vector_type(2)));
__device__ __forceinline__ float fsigmoid(float v) { return __builtin_amdgcn_rcpf(1.0f + __expf(-v)); }
__device__ __forceinline__ float fgelu_tanh(float v) { const float z = 1.5957691216f * (v + 0.044715f * v * v * v); return v * fsigmoid(z); }
__device__ __forceinline__ float bflo(unsigned w) { return __uint_as_float(w << 16); }
__device__ __forceinline__ float bfhi(unsigned w) { return __uint_as_float(w & 0xffff0000u); }

struct EpiF32 {
    static constexpr bool PERM = false, AFTER_DRAIN = false;
    float* C; int ldc;
    __device__ __forceinline__ void operator()(const f32x4 (&acc)[2][2][4][2], const Unit& u, int wr, int wc, int fr, int fq) const {
        const int row0 = u.pm * BM + wr * 64 + fr, col0 = u.pn * BM + wc * 32 + 4 * fq;
#pragma unroll
        for (int ai = 0; ai < 2; ++ai)
#pragma unroll
            for (int m = 0; m < 4; ++m) { float* rowp = C + (size_t)(row0 + ai * HALF + m * 16) * ldc + col0;
#pragma unroll
                for (int bj = 0; bj < 2; ++bj)
#pragma unroll
                    for (int n = 0; n < 2; ++n) *(f32x4*)(rowp + bj * HALF + n * 16) = acc[ai][bj][m][n]; }
    }
};
struct EpiBf16S {
    static constexpr bool PERM = true, AFTER_DRAIN = false;
    bf16_t* O; int ldc; float scale; bf16_t* vt;
    __device__ __forceinline__ void operator()(const f32x4 (&acc)[2][2][4][2], const Unit& u, int wr, int wc, int fr, int fq) const {
        const int row0 = u.pm * BM + wr * 64 + fr, col0 = u.pn * BM + wc * 32 + 8 * fq;
        const bool tr = (vt != nullptr) && (u.pn >= 4);
#pragma unroll
        for (int ai = 0; ai < 2; ++ai)
#pragma unroll
            for (int m = 0; m < 4; ++m) { const int row = row0 + ai * HALF + m * 16; bf16_t* rowp = O + (size_t)row * ldc + col0;
#pragma unroll
                for (int bj = 0; bj < 2; ++bj) { const f32x4 v0 = acc[ai][bj][m][0] * scale, v1 = acc[ai][bj][m][1] * scale;
                    u32x4 w; w.x = cvt_pk_bf16(v0[0], v0[1]); w.y = cvt_pk_bf16(v0[2], v0[3]); w.z = cvt_pk_bf16(v1[0], v1[1]); w.w = cvt_pk_bf16(v1[2], v1[3]);
                    if (tr) { bf16_t* p = vt + ((size_t)(((row >> 8) * 4 + (u.pn - 4)) * 256 + bj * HALF + wc * 32 + 8 * fq)) * 256 + (row & 255);
                        p[0 * 256] = (bf16_t)(w.x & 0xffffu); p[1 * 256] = (bf16_t)(w.x >> 16); p[2 * 256] = (bf16_t)(w.y & 0xffffu); p[3 * 256] = (bf16_t)(w.y >> 16);
                        p[4 * 256] = (bf16_t)(w.z & 0xffffu); p[5 * 256] = (bf16_t)(w.z >> 16); p[6 * 256] = (bf16_t)(w.w & 0xffffu); p[7 * 256] = (bf16_t)(w.w >> 16); }
                    else *(u32x4*)(rowp + bj * HALF) = w; }
                asm volatile("" ::: "memory"); }
    }
};
struct EpiSwiGLU {
    static constexpr bool PERM = true, AFTER_DRAIN = false;
    bf16_t* H; int ldh;
    __device__ __forceinline__ void operator()(const f32x4 (&acc)[2][2][4][2], const Unit& u, int wr, int wc, int fr, int fq) const {
        const int row0 = u.pm * BM + wr * 64 + fr, col0 = u.pn * HALF + wc * 32 + 8 * fq;
#pragma unroll
        for (int ai = 0; ai < 2; ++ai)
#pragma unroll
            for (int m = 0; m < 4; ++m) { bf16_t* p = H + (size_t)(row0 + ai * HALF + m * 16) * ldh + col0;
                f32x4 h0, h1;
#pragma unroll
                for (int i = 0; i < 4; ++i) { const float g0 = acc[ai][0][m][0][i], g1 = acc[ai][0][m][1][i];
                    h0[i] = g0 * fsigmoid(g0) * acc[ai][1][m][0][i]; h1[i] = g1 * fsigmoid(g1) * acc[ai][1][m][1][i]; }
                u32x4 w; w.x = cvt_pk_bf16(h0[0], h0[1]); w.y = cvt_pk_bf16(h0[2], h0[3]); w.z = cvt_pk_bf16(h1[0], h1[1]); w.w = cvt_pk_bf16(h1[2], h1[3]);
                *(u32x4*)p = w; }
    }
};
struct EpiZin {
    static constexpr bool PERM = true, AFTER_DRAIN = false;
    const float* bias; bf16_t *ZA, *ZQ, *ZKV, *ZGM, *ZG; int mode; bf16_t *VTS, *VTW;
    __device__ __forceinline__ void operator()(const f32x4 (&acc)[2][2][4][2], const Unit& u, int wr, int wc, int fr, int fq) const {
        const int pn = u.pn; const int row0 = u.pm * BM + wr * 64 + fr;
        bf16_t* base; int ld, cb; int act = 0; float sc = 1.f; bool only0 = false;
        if (mode == 1) { base = ZA; ld = 3072; cb = pn * 256; act = 2; }
        else if (pn < 2) { base = ZA; ld = 512; cb = pn * 256; }
        else if (pn < 4) { base = ZQ; ld = 512; cb = (pn - 2) * 256; sc = 0.125f; }
        else if (pn < 7) { base = ZKV; ld = 768; cb = (pn - 4) * 256; }
        else if (pn < 11) { base = ZGM; ld = 1024; cb = (pn - 7) * 256; act = 1; }
        else { base = ZG; ld = 32; cb = 0; only0 = true; }
        const int ct = wc * 32 + 8 * fq;
        bf16_t* bp = base + (size_t)row0 * ld + cb + ct;
        f32x4 bv[2][2];
#pragma unroll
        for (int bj = 0; bj < 2; ++bj)
#pragma unroll
            for (int n = 0; n < 2; ++n) bv[bj][n] = *(const f32x4*)(bias + pn * 256 + bj * HALF + ct + 4 * n);
#pragma unroll
        for (int ai = 0; ai < 2; ++ai)
#pragma unroll
            for (int m = 0; m < 4; ++m) {
#pragma unroll
                for (int bj = 0; bj < 2; ++bj) {
                    f32x4 v0 = (acc[ai][bj][m][0] + bv[bj][0]) * sc, v1 = (acc[ai][bj][m][1] + bv[bj][1]) * sc;
                    if (act == 1) {
#pragma unroll
                        for (int i = 0; i < 4; ++i) { v0[i] = fgelu_tanh(v0[i]); v1[i] = fgelu_tanh(v1[i]); } }
                    else if (act == 2) {
#pragma unroll
                        for (int i = 0; i < 4; ++i) { v0[i] = fsigmoid(v0[i]); v1[i] = fsigmoid(v1[i]); } }
                    u32x4 w; w.x = cvt_pk_bf16(v0[0], v0[1]); w.y = cvt_pk_bf16(v0[2], v0[3]); w.z = cvt_pk_bf16(v1[0], v1[1]); w.w = cvt_pk_bf16(v1[2], v1[3]);
                    if (mode == 0 && bj == 1 && (pn == 5 || pn == 6)) {
                        const int row = row0 + ai * HALF + m * 16, bb = row >> 11, t = row & 2047;
                        bf16_t* vt = (pn == 5 ? VTS : VTW) + ((size_t)((bb * 2 + (wc >> 1)) * 64 + (wc & 1) * 32 + 8 * fq)) * 2048 + t;
                        vt[0 * 2048] = (bf16_t)(w.x & 0xffffu); vt[1 * 2048] = (bf16_t)(w.x >> 16); vt[2 * 2048] = (bf16_t)(w.y & 0xffffu); vt[3 * 2048] = (bf16_t)(w.y >> 16);
                        vt[4 * 2048] = (bf16_t)(w.z & 0xffffu); vt[5 * 2048] = (bf16_t)(w.z >> 16); vt[6 * 2048] = (bf16_t)(w.w & 0xffffu); vt[7 * 2048] = (bf16_t)(w.w >> 16);
                    } else if (!only0 || (wc == 0 && bj == 0)) *(u32x4*)(bp + (ai * HALF + m * 16) * ld + bj * HALF) = w; }
                asm volatile("" ::: "memory"); }
    }
};
struct EpiMerge {
    static constexpr bool PERM = true, AFTER_DRAIN = false;
    const bf16_t* G; int goff; bf16_t* MRG; int accum;
    __device__ __forceinline__ void operator()(const f32x4 (&acc)[2][2][4][2], const Unit& u, int wr, int wc, int fr, int fq) const {
        const int row0 = u.pm * BM + wr * 64 + fr, col0 = u.pn * BM + wc * 32 + 8 * fq;
#pragma unroll
        for (int ai = 0; ai < 2; ++ai)
#pragma unroll
            for (int m = 0; m < 4; ++m) { const size_t r = (size_t)(row0 + ai * HALF + m * 16);
#pragma unroll
                for (int bj = 0; bj < 2; ++bj) {
#ifdef MERGE_NOGATE
                    const u32x4 g = (u32x4){0x3f803f80u, 0x3f803f80u, 0x3f803f80u, 0x3f803f80u};
#else
                    const u32x4 g = *(const u32x4*)(G + r * 3072 + goff + col0 + bj * HALF);
#endif
                    bf16_t* p = MRG + r * 1024 + col0 + bj * HALF;
                    f32x4 v0 = acc[ai][bj][m][0], v1 = acc[ai][bj][m][1];
                    v0[0] *= bflo(g.x); v0[1] *= bfhi(g.x); v0[2] *= bflo(g.y); v0[3] *= bfhi(g.y);
                    v1[0] *= bflo(g.z); v1[1] *= bfhi(g.z); v1[2] *= bflo(g.w); v1[3] *= bfhi(g.w);
                    if (accum) { const u32x4 o = *(const u32x4*)p;
                        v0[0] += bflo(o.x); v0[1] += bfhi(o.x); v0[2] += bflo(o.y); v0[3] += bfhi(o.y);
                        v1[0] += bflo(o.z); v1[1] += bfhi(o.z); v1[2] += bflo(o.w); v1[3] += bfhi(o.w); }
                    u32x4 w; w.x = cvt_pk_bf16(v0[0], v0[1]); w.y = cvt_pk_bf16(v0[2], v0[3]); w.z = cvt_pk_bf16(v1[0], v1[1]); w.w = cvt_pk_bf16(v1[2], v1[3]);
                    *(u32x4*)p = w; } }
    }
};
template <class Epi, class Sched, bool ALIGN_EPI = false, bool SP2 = false>
__device__ __forceinline__ void gemm_phase(PG8_LAS unsigned char* lds, const Gemm g, const Sched& S, const Epi& E) {
    int tid_o = threadIdx.x; asm volatile("" : "+v"(tid_o));
    const int tid = tid_o, wid = __builtin_amdgcn_readfirstlane(tid >> 6), lane = tid & 63, wr = wid >> 2, wc = wid & 3, fr = lane & 15, fq = lane >> 4;
    const int K = g.K, nt = K / BK;
    unsigned voffA[2], voffB[2];
#pragma unroll
    for (int i = 0; i < 2; ++i) { int R, C; stage_rc(tid * 16 + i * 8192, R, C); const int Rb = Epi::PERM ? ((R & ~31) + perm32(R & 31)) : R;
        voffA[i] = (unsigned)(R * K + C) * 2u; voffB[i] = (unsigned)(Rb * K + C) * 2u; }
    const size_t kstep = (size_t)(BK * 2);
    const size_t hstep = (size_t)HALF * K * 2;
    const size_t tstep = 2 * hstep;
    const unsigned ldsw = (unsigned)wid * 1024u;
    const int aoff = lds_byte(wr * 64 + fr, fq * 8), boff = lds_byte(wc * 32 + fr, fq * 8);
#define PG8_SA(b, h) (((b) * 2 + (h)) * HTB)
#define PG8_SB(b, h) ((4 + (b) * 2 + (h)) * HTB)
#define PG8_STAGE(bufoff, gbase, voff) do { _Pragma("unroll") for (int _i = 0; _i < 2; ++_i) \
        __builtin_amdgcn_global_load_lds((const unsigned*)((const char*)(gbase) + (voff)[_i]), (PG8_LAS unsigned*)(lds + (bufoff) + ldsw + _i * 8192), 16, 0, 0); } while (0)
#define PG8_LDA(dst, b, h) do { _Pragma("unroll") for (int m = 0; m < 4; ++m) _Pragma("unroll") for (int k = 0; k < 2; ++k) dst[m][k] = *(const PG8_LAS bf16x8*)(lds + PG8_SA(b, h) + aoff + m * 2048 + k * 1024); } while (0)
#define PG8_LDB(dst, b, h) do { _Pragma("unroll") for (int n = 0; n < 2; ++n) _Pragma("unroll") for (int k = 0; k < 2; ++k) dst[n][k] = *(const PG8_LAS bf16x8*)(lds + PG8_SB(b, h) + boff + n * 2048 + k * 1024); } while (0)
#define PG8_MMA(ai, bj, At, Bt) do { __builtin_amdgcn_s_setprio(1); _Pragma("unroll") for (int m = 0; m < 4; ++m) _Pragma("unroll") for (int n = 0; n < 2; ++n) _Pragma("unroll") for (int k = 0; k < 2; ++k) \
        acc[ai][bj][m][n] = __builtin_amdgcn_mfma_f32_16x16x32_bf16(Bt[n][k], At[m][k], acc[ai][bj][m][n], 0, 0, 0); __builtin_amdgcn_s_setprio(0); } while (0)
#define PG8_WAIT_V(n) asm volatile("s_waitcnt vmcnt(" #n ")" ::: "memory")
#define PG8_WAIT_L(n) asm volatile("s_waitcnt lgkmcnt(" #n ")" ::: "memory")
#define PG8_BAR __builtin_amdgcn_s_barrier()
#define PG8_SCHED __builtin_amdgcn_sched_barrier(0)
    Unit cur, nxt; int ui = 0;
    if (!S.next(0, cur)) return;
    f32x4 acc[2][2][4][2];
#pragma unroll
    for (int a = 0; a < 2; ++a)
#pragma unroll
        for (int b = 0; b < 2; ++b)
#pragma unroll
            for (int m = 0; m < 4; ++m)
#pragma unroll
                for (int n = 0; n < 2; ++n) acc[a][b][m][n] = (f32x4){0.f, 0.f, 0.f, 0.f};
    bf16x8 At[4][2], B0[2][2], B1[2][2];
    const char* cA = (const char*)g.A + (size_t)cur.pm * tstep; const char* cB = (const char*)g.Bt + (size_t)cur.pn * tstep;
    S.a_ready(cur);
    if constexpr (SP2) {
        PG8_STAGE(PG8_SB(0, 0), cB, voffB); PG8_STAGE(PG8_SB(0, 1), cB + hstep, voffB); PG8_STAGE(PG8_SA(0, 0), cA, voffA); PG8_STAGE(PG8_SA(0, 1), cA + hstep, voffA);
        if (wr == 1) PG8_BAR;
        PG8_WAIT_V(2); PG8_BAR;
        PG8_STAGE(PG8_SB(1, 0), cB + kstep, voffB); PG8_STAGE(PG8_SA(1, 0), cA + kstep, voffA); PG8_STAGE(PG8_SB(1, 1), cB + hstep + kstep, voffB);
        PG8_WAIT_V(6); PG8_BAR;
    } else {
        PG8_STAGE(PG8_SB(0, 0), cB, voffB); PG8_STAGE(PG8_SA(0, 0), cA, voffA); PG8_STAGE(PG8_SB(0, 1), cB + hstep, voffB); PG8_STAGE(PG8_SA(0, 1), cA + hstep, voffA);
        if (wr == 1) PG8_BAR;
        PG8_WAIT_V(4); PG8_BAR;
        PG8_STAGE(PG8_SB(1, 0), cB + kstep, voffB); PG8_STAGE(PG8_SA(1, 0), cA + kstep, voffA); PG8_STAGE(PG8_SB(1, 1), cB + hstep + kstep, voffB);
        PG8_WAIT_V(6); PG8_BAR;
    }
    for (;;) {
        const bool has_next = S.next(ui + 1, nxt);
        const char* nA = has_next ? (const char*)g.A + (size_t)nxt.pm * tstep : cA; const char* nB = has_next ? (const char*)g.Bt + (size_t)nxt.pn * tstep : cB;
        for (int t = 0; t < nt; t += 2) {
            const bool last = (t == nt - 2);
            const char* a1 = cA + (size_t)(t + 1) * kstep;
            const char* a2 = last ? nA : cA + (size_t)(t + 2) * kstep; const char* b2 = last ? nB : cB + (size_t)(t + 2) * kstep;
            const char* a3 = a2 + kstep; const char* b3 = b2 + kstep;
            if (last && has_next) S.a_ready(nxt);
            if constexpr (SP2) {
            PG8_LDB(B0, 0, 0); PG8_LDB(B1, 0, 1); PG8_SCHED; PG8_LDA(At, 0, 0); PG8_STAGE(PG8_SA(1, 1), a1 + hstep, voffA);
            PG8_WAIT_V(8); PG8_WAIT_L(0); PG8_BAR; PG8_MMA(0, 0, At, B0); PG8_MMA(0, 1, At, B1); PG8_BAR; PG8_SCHED;
            PG8_LDA(At, 0, 1); PG8_STAGE(PG8_SB(0, 0), b2, voffB); PG8_STAGE(PG8_SB(0, 1), b2 + hstep, voffB); PG8_STAGE(PG8_SA(0, 0), a2, voffA);
            PG8_WAIT_V(8); PG8_WAIT_L(0); PG8_BAR; PG8_MMA(1, 0, At, B0); PG8_MMA(1, 1, At, B1); PG8_BAR; PG8_SCHED;
            PG8_LDB(B0, 1, 0); PG8_LDB(B1, 1, 1); PG8_SCHED; PG8_LDA(At, 1, 0); PG8_STAGE(PG8_SA(0, 1), a2 + hstep, voffA);
            PG8_WAIT_V(8); PG8_WAIT_L(0); PG8_BAR; PG8_MMA(0, 0, At, B0); PG8_MMA(0, 1, At, B1); PG8_BAR; PG8_SCHED;
            PG8_LDA(At, 1, 1); PG8_STAGE(PG8_SB(1, 0), b3, voffB); PG8_STAGE(PG8_SB(1, 1), b3 + hstep, voffB); PG8_STAGE(PG8_SA(1, 0), a3, voffA);
            PG8_WAIT_V(8); PG8_WAIT_L(0); PG8_BAR; PG8_MMA(1, 0, At, B0); PG8_MMA(1, 1, At, B1); PG8_BAR; PG8_SCHED;
            } else {
            PG8_LDB(B0, 0, 0); PG8_SCHED; PG8_LDA(At, 0, 0); PG8_STAGE(PG8_SA(1, 1), a1 + hstep, voffA);
            PG8_WAIT_L(8); PG8_BAR; PG8_WAIT_L(0); PG8_MMA(0, 0, At, B0); PG8_BAR; PG8_SCHED;
            PG8_LDB(B1, 0, 1); PG8_STAGE(PG8_SB(0, 0), b2, voffB);
            PG8_BAR; PG8_WAIT_L(0); PG8_MMA(0, 1, At, B1); PG8_BAR;
            PG8_LDA(At, 0, 1); PG8_STAGE(PG8_SA(0, 0), a2, voffA);
            PG8_BAR; PG8_WAIT_L(0); PG8_MMA(1, 0, At, B0); PG8_BAR; PG8_SCHED;
            PG8_STAGE(PG8_SB(0, 1), b2 + hstep, voffB);
            PG8_WAIT_V(6); PG8_BAR; PG8_MMA(1, 1, At, B1); PG8_BAR;
            PG8_LDB(B0, 1, 0); PG8_SCHED; PG8_LDA(At, 1, 0); PG8_STAGE(PG8_SA(0, 1), a2 + hstep, voffA);
            PG8_WAIT_L(8); PG8_BAR; PG8_WAIT_L(0); PG8_MMA(0, 0, At, B0); PG8_BAR; PG8_SCHED;
            PG8_LDB(B1, 1, 1); PG8_STAGE(PG8_SB(1, 0), b3, voffB);
            PG8_BAR; PG8_WAIT_L(0); PG8_MMA(0, 1, At, B1); PG8_BAR;
            PG8_LDA(At, 1, 1); PG8_STAGE(PG8_SA(1, 0), a3, voffA);
            PG8_BAR; PG8_WAIT_L(0); PG8_MMA(1, 0, At, B0); PG8_BAR; PG8_SCHED;
            PG8_STAGE(PG8_SB(1, 1), b3 + hstep, voffB);
            PG8_WAIT_V(6); PG8_BAR; PG8_MMA(1, 1, At, B1); PG8_BAR;
            }
        }
        if constexpr (ALIGN_EPI) { if (wr == 0) PG8_BAR; }
        if constexpr (!Epi::AFTER_DRAIN) { E(acc, cur, wr, wc, fr, fq); S.done(cur); }
        if (!has_next) break;
#pragma unroll
        for (int a = 0; a < 2; ++a)
#pragma unroll
            for (int b = 0; b < 2; ++b)
#pragma unroll
                for (int m = 0; m < 4; ++m)
#pragma unroll
                    for (int n = 0; n < 2; ++n) acc[a][b][m][n] = (f32x4){0.f, 0.f, 0.f, 0.f};
        cur = nxt; cA = nA; cB = nB; ++ui;
        if constexpr (ALIGN_EPI) { if (wr == 1) PG8_BAR; }
    }
    PG8_WAIT_V(0);
    if constexpr (!ALIGN_EPI) { if (wr == 0) PG8_BAR; }
    PG8_BAR;
    if constexpr (Epi::AFTER_DRAIN) { E.fused(acc, cur, wr, wc, fr, fq, lds, wid, lane); S.done(cur); }
#undef PG8_SA
#undef PG8_SB
#undef PG8_STAGE
#undef PG8_LDA
#undef PG8_LDB
#undef PG8_MMA
#undef PG8_WAIT_V
#undef PG8_WAIT_L
#undef PG8_BAR
#undef PG8_SCHED
}
}
#define LAS __attribute__((address_space(3)))
typedef unsigned short bf16_t;
typedef short bf16x8 __attribute__((ext_vector_type(8)));
typedef short s16x4 __attribute__((ext_vector_type(4)));
typedef float f32x4 __attribute__((ext_vector_type(4)));
typedef unsigned u32x4 __attribute__((ext_vector_type(4)));
typedef unsigned u32x2 __attribute__((ext_vector_type(2)));
using pg8::cvt_pk_bf16; using pg8::fsigmoid; using pg8::bflo; using pg8::bfhi;
#define MFMA16(a, b, c) __builtin_amdgcn_mfma_f32_16x16x32_bf16((a), (b), (c), 0, 0, 0)

constexpr int DM = 1024, NBATCH = 8, SEQ = 2048, MT = NBATCH * SEQ, DFF = 2816, MEML = 256, MM = NBATCH * MEML, DEPTH = 2, INC = 5912;
constexpr int NWAVES = 8, NTHREADS = 512;
constexpr float EPS = 1e-6f, LOG2E = 1.4426950408889634f;
constexpr int PH_PER_LAYER = 17, NPHASES = 1 + DEPTH * PH_PER_LAYER;

enum { I_X = 0, I_MEM, I_FF1_PRE, I_FF1_W1, I_FF1_W3, I_FF1_W2, I_FF1_POST, I_MIX_PRE, I_WIN, I_BIN, I_POOLW, I_POOLS, I_CPK, I_CW1K, I_CW2K, I_CPV, I_CW1V, I_CW2V,
       I_GLNG, I_GLNB, I_GWS, I_GBS, I_WBRP, I_WBRN, I_WBRG, I_WMIX, I_MIX_POST, I_MEM_PRE, I_MEM_KVG, I_WQ, I_WK, I_WV, I_WO, I_MEM_POST, I_FF2_PRE, I_FF2_W1, I_FF2_W3, I_FF2_W2, I_FF2_POST, N_IN };

constexpr size_t MiB = 1u << 20, KiB = 1024;
constexpr size_t WS_W13A = 1 * MiB, WS_W2A = 12 * MiB, WS_W13B = 17 * MiB + 512 * KiB, WS_W2B = 28 * MiB + 512 * KiB, WS_WIN = 34 * MiB, WS_WMG = 40 * MiB,
                 WS_WCOMB = 46 * MiB, WS_WBRN = 47 * MiB, WS_WBRG = 48 * MiB, WS_WMIX = 49 * MiB, WS_WQ = 51 * MiB, WS_WKV = 53 * MiB, WS_WO = 57 * MiB,
                 WS_W1K = 59 * MiB, WS_W1V = 60 * MiB, WS_W2K = 61 * MiB, WS_W2V = 61 * MiB + 32 * KiB, WS_GWS = 61 * MiB + 64 * KiB, WS_BIASIN = 61 * MiB + 192 * KiB,
                 WS_POSB = 61 * MiB + 208 * KiB;
constexpr size_t WS_XN = 62 * MiB, WS_MEMN = 94 * MiB, WS_KVM = 98 * MiB, WS_KC = 106 * MiB, WS_VC = 106 * MiB + 512 * KiB, WS_BIG = 107 * MiB;
constexpr size_t WS_H = WS_BIG, WS_YF = WS_BIG + 88 * MiB;
constexpr size_t WS_ZA = WS_BIG, WS_ZQ = WS_BIG + 16 * MiB, WS_ZKV = WS_BIG + 32 * MiB, WS_ZGM = WS_BIG + 56 * MiB, WS_ZG = WS_BIG + 88 * MiB;
constexpr size_t WS_G = WS_BIG, WS_P = WS_BIG + 96 * MiB, WS_O = WS_BIG + 112 * MiB, WS_U = WS_BIG + 128 * MiB, WS_MRG = WS_BIG + 144 * MiB, WS_YM = WS_BIG;
constexpr size_t WS_QX = WS_BIG, WS_OX = WS_BIG + 32 * MiB;
constexpr size_t WS_VTS = WS_BIG + 176 * MiB, WS_VTW = WS_VTS + 4 * MiB, WS_VTM = WS_VTW + 4 * MiB;
constexpr size_t WS_END = WS_VTM + 4 * MiB;

constexpr int LDS_BYTES = 147456;

struct Args { const float* in[N_IN]; float* out; unsigned char* ws; int ph_lo, ph_hi; };
typedef const unsigned char __attribute__((address_space(4)))* karg_t;
#define AIN(i) (*(const float* const __attribute__((address_space(4)))*)(kp + 8 * (i)))

__device__ __forceinline__ float wave_sum(float v) {
#pragma unroll
    for (int o = 1; o < 64; o <<= 1) v += __shfl_xor(v, o);
    return v;
}
#define LDS_WAIT() asm volatile("s_waitcnt lgkmcnt(0)" ::: "memory")

struct TSeg { const float* W; int K, N, col0, ncols, nvalid; bf16_t* WT; int mode, row0; };
__device__ __forceinline__ void transpose_item(const TSeg& s, LAS float* scr, int item, int lane) {
    const int nblk = s.ncols / 32, kb = item / nblk, nb = item % nblk, k0 = 64 * kb, n0 = 32 * nb;
    const int c4 = (lane & 7) * 4, nl = n0 + c4;
    f32x4 v[8];
#pragma unroll
    for (int i = 0; i < 8; ++i) { const int kk = i * 8 + (lane >> 3);
        v[i] = (nl < s.nvalid) ? *(const f32x4*)(s.W + (size_t)(k0 + kk) * s.N + s.col0 + nl) : (f32x4){0.f, 0.f, 0.f, 0.f}; }
#pragma unroll
    for (int i = 0; i < 8; ++i) { const int kk = i * 8 + (lane >> 3); *(LAS f32x4*)(scr + kk * 36 + c4) = v[i]; }
    LDS_WAIT(); asm volatile("" ::: "memory");
    const int c = lane & 7;
#pragma unroll
    for (int j = 0; j < 4; ++j) { const int nloc = (lane >> 3) + 8 * j, n = n0 + nloc; const LAS float* sp = scr + (8 * c) * 36 + nloc;
        const int drow = s.mode == 0 ? s.row0 + n : (n >> 7) * 256 + (n & 127) + s.row0;
        u32x4 o; o.x = cvt_pk_bf16(sp[0 * 36], sp[1 * 36]); o.y = cvt_pk_bf16(sp[2 * 36], sp[3 * 36]); o.z = cvt_pk_bf16(sp[4 * 36], sp[5 * 36]); o.w = cvt_pk_bf16(sp[6 * 36], sp[7 * 36]);
        *(u32x4*)(s.WT + (size_t)drow * s.K + k0 + 8 * c) = o; }
    LDS_WAIT(); asm volatile("" ::: "memory");
}
constexpr int NSEG = 21;
__device__ __forceinline__ TSeg get_seg(karg_t kp, unsigned char* ws, int l, int seg) {
    TSeg s; s.col0 = 0; s.mode = 0; s.row0 = 0;
#define W(idx, per) (AIN(idx) + (size_t)l * (per))
    switch (seg) {
    case 0: s.W = W(I_FF1_W1, (size_t)DM * DFF); s.K = DM; s.N = DFF; s.ncols = DFF; s.WT = (bf16_t*)(ws + WS_W13A); s.mode = 1; s.row0 = 0; break;
    case 1: s.W = W(I_FF1_W3, (size_t)DM * DFF); s.K = DM; s.N = DFF; s.ncols = DFF; s.WT = (bf16_t*)(ws + WS_W13A); s.mode = 1; s.row0 = 128; break;
    case 2: s.W = W(I_FF1_W2, (size_t)DM * DFF); s.K = DFF; s.N = DM; s.ncols = DM; s.WT = (bf16_t*)(ws + WS_W2A); break;
    case 3: s.W = W(I_FF2_W1, (size_t)DM * DFF); s.K = DM; s.N = DFF; s.ncols = DFF; s.WT = (bf16_t*)(ws + WS_W13B); s.mode = 1; s.row0 = 0; break;
    case 4: s.W = W(I_FF2_W3, (size_t)DM * DFF); s.K = DM; s.N = DFF; s.ncols = DFF; s.WT = (bf16_t*)(ws + WS_W13B); s.mode = 1; s.row0 = 128; break;
    case 5: s.W = W(I_FF2_W2, (size_t)DM * DFF); s.K = DFF; s.N = DM; s.ncols = DM; s.WT = (bf16_t*)(ws + WS_W2B); break;
    case 6: s.W = W(I_WIN, (size_t)DM * INC); s.K = DM; s.N = INC; s.col0 = 0; s.ncols = 1792; s.WT = (bf16_t*)(ws + WS_WIN); s.row0 = 0; break;
    case 7: s.W = W(I_WIN, (size_t)DM * INC); s.K = DM; s.N = INC; s.col0 = 1816; s.ncols = 1024; s.WT = (bf16_t*)(ws + WS_WIN); s.row0 = 1792; break;
    case 8: s.W = W(I_WIN, (size_t)DM * INC); s.K = DM; s.N = INC; s.col0 = 1792; s.ncols = 256; s.WT = (bf16_t*)(ws + WS_WIN); s.row0 = 2816; break;
    case 9: s.W = W(I_WIN, (size_t)DM * INC); s.K = DM; s.N = INC; s.col0 = 2840; s.ncols = 3072; s.WT = (bf16_t*)(ws + WS_WMG); break;
    case 10: s.W = W(I_WBRN, (size_t)512 * DM); s.K = 512; s.N = DM; s.ncols = DM; s.WT = (bf16_t*)(ws + WS_WBRN); break;
    case 11: s.W = W(I_WBRG, (size_t)512 * DM); s.K = 512; s.N = DM; s.ncols = DM; s.WT = (bf16_t*)(ws + WS_WBRG); break;
    case 12: s.W = W(I_WMIX, (size_t)DM * DM); s.K = DM; s.N = DM; s.ncols = DM; s.WT = (bf16_t*)(ws + WS_WMIX); break;
    case 13: s.W = W(I_WQ, (size_t)DM * DM); s.K = DM; s.N = DM; s.ncols = DM; s.WT = (bf16_t*)(ws + WS_WQ); break;
    case 14: s.W = W(I_WK, (size_t)DM * DM); s.K = DM; s.N = DM; s.ncols = DM; s.WT = (bf16_t*)(ws + WS_WKV); s.row0 = 0; break;
    case 15: s.W = W(I_WV, (size_t)DM * DM); s.K = DM; s.N = DM; s.ncols = DM; s.WT = (bf16_t*)(ws + WS_WKV); s.row0 = 1024; break;
    case 16: s.W = W(I_WO, (size_t)DM * DM); s.K = DM; s.N = DM; s.ncols = DM; s.WT = (bf16_t*)(ws + WS_WO); break;
    case 17: s.W = W(I_CW1K, (size_t)2048 * 256); s.K = 2048; s.N = 256; s.ncols = 256; s.WT = (bf16_t*)(ws + WS_W1K); break;
    case 18: s.W = W(I_CW1V, (size_t)2048 * 256); s.K = 2048; s.N = 256; s.ncols = 256; s.WT = (bf16_t*)(ws + WS_W1V); break;
    case 19: s.W = W(I_CW2K, (size_t)256 * 64); s.K = 256; s.N = 64; s.ncols = 64; s.WT = (bf16_t*)(ws + WS_W2K); break;
    default: s.W = W(I_CW2V, (size_t)256 * 64); s.K = 256; s.N = 64; s.ncols = 64; s.WT = (bf16_t*)(ws + WS_W2V); break;
    }
#undef W
    s.nvalid = (seg == 8) ? 24 : s.ncols;
    return s;
}
__device__ __forceinline__ void row_pass(const float* Y, const float* gpost, float coef, const float* xin, float* xout, const float* gnext, bf16_t* XN, int nrows, int gw, int NGW, int lane) {
    for (int m = gw; m < nrows; m += NGW) {
        f32x4 xv[4];
#pragma unroll
        for (int j = 0; j < 4; ++j) xv[j] = *((const f32x4*)(xin + (size_t)m * DM) + lane + 64 * j);
        if (Y) {
            f32x4 yv[4]; float ss = 0.f;
#pragma unroll
            for (int j = 0; j < 4; ++j) { yv[j] = *((const f32x4*)(Y + (size_t)m * DM) + lane + 64 * j); ss += (yv[j].x * yv[j].x + yv[j].y * yv[j].y) + (yv[j].z * yv[j].z + yv[j].w * yv[j].w); }
            const float r = coef / sqrtf(wave_sum(ss) * (1.0f / DM) + EPS);
#pragma unroll
            for (int j = 0; j < 4; ++j) { const f32x4 g = *((const f32x4*)gpost + lane + 64 * j); xv[j] = xv[j] + yv[j] * g * r; }
        }
        if (xout) {
#pragma unroll
            for (int j = 0; j < 4; ++j) *((f32x4*)(xout + (size_t)m * DM) + lane + 64 * j) = xv[j];
        }
        if (gnext) {
            float ss = 0.f;
#pragma unroll
            for (int j = 0; j < 4; ++j) ss += (xv[j].x * xv[j].x + xv[j].y * xv[j].y) + (xv[j].z * xv[j].z + xv[j].w * xv[j].w);
            const float r = 1.0f / sqrtf(wave_sum(ss) * (1.0f / DM) + EPS);
#pragma unroll
            for (int j = 0; j < 4; ++j) { const f32x4 g = *((const f32x4*)gnext + lane + 64 * j); const f32x4 o = xv[j] * g * r;
                u32x2 w; w.x = cvt_pk_bf16(o.x, o.y); w.y = cvt_pk_bf16(o.z, o.w);
                *((u32x2*)(XN + (size_t)m * DM) + lane + 64 * j) = w; }
        }
    }
}
__device__ __forceinline__ void prep_layer(karg_t kp, unsigned char* ws, int l, LAS unsigned char* lds, int gw, int NGW, int wave, int lane, int tid, int G, int bid) {
    LAS float* scr = (LAS float*)(lds + wave * 16384);
#pragma unroll
    for (int seg = 0; seg < NSEG; ++seg) {
        karg_t kq = kp; asm volatile("" : "+s"(kq) :: "memory");
        const TSeg s = get_seg(kq, ws, l, seg);
        const int nitems = (s.K / 64) * (s.ncols / 32);
        for (int it = gw; it < nitems; it += NGW) transpose_item(s, scr, it, lane);
    }
    const int gt = bid * NTHREADS + tid, NGT = G * NTHREADS;
    { const float* pw = AIN(I_POOLW) + (size_t)l * 4 * 128 * 128; const float* psc = AIN(I_POOLS) + (size_t)l * 512; const float* wb = AIN(I_WBRP) + (size_t)l * 512 * DM;
      bf16_t* out = (bf16_t*)(ws + WS_WCOMB);
      for (int o = gt; o < 128 * DM; o += NGT) { const int n = o & (DM - 1), c = o >> 10; float s0 = 0.f, s1 = 0.f, s2 = 0.f, s3 = 0.f;
          const float* pr = pw + (size_t)c * 128;
#pragma unroll 8
          for (int d = 0; d < 128; ++d) {
              s0 += pr[d] * psc[d] * wb[(size_t)d * DM + n];
              s1 += pr[16384 + d] * psc[128 + d] * wb[(size_t)(128 + d) * DM + n];
              s2 += pr[32768 + d] * psc[256 + d] * wb[(size_t)(256 + d) * DM + n];
              s3 += pr[49152 + d] * psc[384 + d] * wb[(size_t)(384 + d) * DM + n]; }
          bf16_t* op = out + (size_t)n * 512 + c;
          op[0] = (bf16_t)(cvt_pk_bf16(s0, 0.f) & 0xffffu); op[128] = (bf16_t)(cvt_pk_bf16(s1, 0.f) & 0xffffu); op[256] = (bf16_t)(cvt_pk_bf16(s2, 0.f) & 0xffffu); op[384] = (bf16_t)(cvt_pk_bf16(s3, 0.f) & 0xffffu); } }
    { const float* gws = AIN(I_GWS) + (size_t)l * 4 * 128 * 128; bf16_t* out = (bf16_t*)(ws + WS_GWS);
      for (int o = gt; o < 4 * 128 * 128; o += NGT) { const int s2 = o & 127, t = (o >> 7) & 127; const float v = (s2 <= t) ? gws[o] : 0.f; out[o] = (bf16_t)(cvt_pk_bf16(v, 0.f) & 0xffffu); } }
    { const float* b = AIN(I_BIN) + (size_t)l * INC; float* out = (float*)(ws + WS_BIASIN);
      for (int o = gt; o < 3072; o += NGT) out[o] = o < 1792 ? b[o] : (o < 2816 ? b[o + 24] : (o < 2840 ? b[1792 + o - 2816] : 0.f)); }
    row_pass(nullptr, nullptr, 0.f, AIN(I_MEM), nullptr, AIN(I_MEM_KVG) + (size_t)l * DM, (bf16_t*)(ws + WS_MEMN), MM, gw, NGW, lane);
}
__device__ __forceinline__ void pool_pass(const bf16_t* ZA, bf16_t* P, int gt, int NGT) {
    for (int o = gt; o < MT * 64; o += NGT) {
        const int cc = o & 63, m = o >> 6, t = m & (SEQ - 1), w = 2 << (cc >> 4), cnt = (t + 1 < w) ? t + 1 : w;
        float s[8];
#pragma unroll
        for (int i = 0; i < 8; ++i) s[i] = 0.f;
        u32x4 self = (u32x4){0u, 0u, 0u, 0u};
        for (int i = 0; i < cnt; ++i) { const u32x4 v = *(const u32x4*)(ZA + (size_t)(m - i) * 512 + cc * 8);
            if (i == 0) self = v;
            s[0] += bflo(v.x); s[1] += bfhi(v.x); s[2] += bflo(v.y); s[3] += bfhi(v.y); s[4] += bflo(v.z); s[5] += bfhi(v.z); s[6] += bflo(v.w); s[7] += bfhi(v.w); }
        const float inv = 1.0f / (float)cnt;
        u32x4 r; r.x = cvt_pk_bf16(s[0] * inv - bflo(self.x), s[1] * inv - bfhi(self.x)); r.y = cvt_pk_bf16(s[2] * inv - bflo(self.y), s[3] * inv - bfhi(self.y));
        r.z = cvt_pk_bf16(s[4] * inv - bflo(self.z), s[5] * inv - bfhi(self.z)); r.w = cvt_pk_bf16(s[6] * inv - bflo(self.w), s[7] * inv - bfhi(self.w));
        *(u32x4*)(P + (size_t)m * 512 + cc * 8) = r;
    }
}
__device__ __forceinline__ void compress_unit(int unit, const bf16_t* ZKV, const bf16_t* W1t_k, const bf16_t* W1t_v, const bf16_t* W2t_k, const bf16_t* W2t_v, const float* pos_k, const float* pos_v,
                                              bf16_t* KC, bf16_t* VC, LAS unsigned char* lds, int wave, int lane) {
    const int which = unit & 1, nc = (unit >> 1) & 7, g = (unit >> 4) & 1, b = unit >> 5;
    const int r16 = lane & 15, quad = lane >> 4;
    const bf16_t* W1t = which ? W1t_v : W1t_k; const bf16_t* W2t = which ? W2t_v : W2t_k;
    const int n = nc * 16 + r16, ne = n < 127 ? n : 126;
    const bf16_t* arow = ZKV + ((size_t)b * SEQ + 16 * ne) * 768 + which * 128 + g * 64 + quad * 8;
    const bf16_t* b0 = W1t + (size_t)(wave * 32 + r16) * 2048 + quad * 8; const bf16_t* b1 = b0 + (size_t)16 * 2048;
    f32x4 acc0 = (f32x4){0.f, 0.f, 0.f, 0.f}, acc1 = acc0;
    const float* pos = (which ? pos_v : pos_k) + quad * 8;
#pragma unroll 8
    for (int ks = 0; ks < 64; ++ks) {
        const u32x4 ar = *(const u32x4*)(arow + (size_t)(ks >> 1) * 768 + (ks & 1) * 32);
        const f32x4 p0 = *(const f32x4*)(pos + ks * 32), p1 = *(const f32x4*)(pos + ks * 32 + 4);
        const bf16x8 bf0 = *(const bf16x8*)(b0 + ks * 32), bf1 = *(const bf16x8*)(b1 + ks * 32);
        u32x4 aw; aw.x = cvt_pk_bf16(bflo(ar.x) + p0.x, bfhi(ar.x) + p0.y); aw.y = cvt_pk_bf16(bflo(ar.y) + p0.z, bfhi(ar.y) + p0.w);
        aw.z = cvt_pk_bf16(bflo(ar.z) + p1.x, bfhi(ar.z) + p1.y); aw.w = cvt_pk_bf16(bflo(ar.w) + p1.z, bfhi(ar.w) + p1.w);
        const bf16x8 af = __builtin_bit_cast(bf16x8, aw);
        acc0 = MFMA16(af, bf0, acc0); acc1 = MFMA16(af, bf1, acc1);
    }
    LAS bf16_t* Hs = (LAS bf16_t*)lds;
    {
#pragma unroll
      for (int i = 0; i < 4; ++i) { const int row = quad * 4 + i;
          Hs[row * 264 + wave * 32 + r16] = (bf16_t)(cvt_pk_bf16(pg8::fgelu_tanh(acc0[i]), 0.f) & 0xffffu);
          Hs[row * 264 + wave * 32 + 16 + r16] = (bf16_t)(cvt_pk_bf16(pg8::fgelu_tanh(acc1[i]), 0.f) & 0xffffu); } }
    __syncthreads();
    if (wave < 4) {
        f32x4 acc = (f32x4){0.f, 0.f, 0.f, 0.f};
#pragma unroll
        for (int ks = 0; ks < 8; ++ks) {
            const bf16x8 af = *(const LAS bf16x8*)(Hs + r16 * 264 + ks * 32 + quad * 8);
            const bf16x8 bfr = *(const bf16x8*)(W2t + (size_t)(wave * 16 + r16) * 256 + ks * 32 + quad * 8);
            acc = MFMA16(af, bfr, acc);
        }
        f32x4 v = acc;
#pragma unroll
        for (int i = 0; i < 4; ++i) if (nc * 16 + quad * 4 + i >= 127) v[i] = 0.f;
        if (which) {
            u32x2 w; w.x = cvt_pk_bf16(v[0], v[1]); w.y = cvt_pk_bf16(v[2], v[3]);
            *(u32x2*)(VC + ((size_t)(b * 2 + g) * 64 + wave * 16 + r16) * 128 + nc * 16 + quad * 4) = w;
        } else {
            bf16_t* out = KC + ((size_t)(b * 2 + g) * 128 + nc * 16) * 64 + wave * 16 + r16;
#pragma unroll
            for (int i = 0; i < 4; ++i) out[(size_t)(quad * 4 + i) * 64] = (bf16_t)(cvt_pk_bf16(v[i], 0.f) & 0xffffu);
        }
    }
    __syncthreads();
}
__device__ __forceinline__ void gmlp_unit(int unit, const bf16_t* ZGM, const bf16_t* Wg, const float* lng, const float* lnb, const float* bs, bf16_t* U, LAS unsigned char* lds, int wave, int lane, int tid) {
    const int gq = unit & 3, c = unit >> 2, m0 = c * 128;
    LAS bf16_t* Vt = (LAS bf16_t*)lds;
    LAS float* st = (LAS float*)(lds + 128 * 136 * 2);
#pragma unroll
    for (int i = 0; i < 16; ++i) { const int tok = wave * 16 + i;
        const u32x4 v = *(const u32x4*)(ZGM + (size_t)(m0 + tok) * 1024 + 512 + lane * 8);
        float f[8] = {bflo(v.x), bfhi(v.x), bflo(v.y), bfhi(v.y), bflo(v.z), bfhi(v.z), bflo(v.w), bfhi(v.w)};
        float s = 0.f;
#pragma unroll
        for (int j = 0; j < 8; ++j) s += f[j];
        const float mean = wave_sum(s) * (1.0f / 512.f); float q = 0.f;
#pragma unroll
        for (int j = 0; j < 8; ++j) { const float d = f[j] - mean; q += d * d; }
        const float rstd = 1.0f / sqrtf(wave_sum(q) * (1.0f / 512.f) + EPS);
        if (lane == 0) { st[tok * 2] = mean; st[tok * 2 + 1] = rstd; } }
    __syncthreads();
    { const int tok = tid >> 2, part = tid & 3; const float mean = st[tok * 2], rstd = st[tok * 2 + 1];
#pragma unroll
      for (int q4 = 0; q4 < 4; ++q4) { const int d0 = part * 32 + q4 * 8, ch = gq * 128 + d0;
          const u32x4 v = *(const u32x4*)(ZGM + (size_t)(m0 + tok) * 1024 + 512 + ch);
          const f32x4 g0 = *(const f32x4*)(lng + ch), g1 = *(const f32x4*)(lng + ch + 4), b0 = *(const f32x4*)(lnb + ch), b1 = *(const f32x4*)(lnb + ch + 4);
          float f[8] = {bflo(v.x), bfhi(v.x), bflo(v.y), bfhi(v.y), bflo(v.z), bfhi(v.z), bflo(v.w), bfhi(v.w)};
          float gg[8] = {g0.x, g0.y, g0.z, g0.w, g1.x, g1.y, g1.z, g1.w}, bb[8] = {b0.x, b0.y, b0.z, b0.w, b1.x, b1.y, b1.z, b1.w};
#pragma unroll
          for (int j = 0; j < 8; ++j) Vt[(d0 + j) * 136 + tok] = (bf16_t)(cvt_pk_bf16((f[j] - mean) * rstd * gg[j] + bb[j], 0.f) & 0xffffu); } }
    __syncthreads();
    { const int r16 = lane & 15, quad = lane >> 4, t = wave * 16 + r16;
      f32x4 acc[8];
#pragma unroll
      for (int dt = 0; dt < 8; ++dt) acc[dt] = (f32x4){0.f, 0.f, 0.f, 0.f};
      const int nks = (wave * 16 + 15) / 32 + 1;
      for (int ks = 0; ks < nks; ++ks) {
          const bf16x8 bfr = *(const bf16x8*)(Wg + ((size_t)gq * 128 + t) * 128 + ks * 32 + quad * 8);
#pragma unroll
          for (int dt = 0; dt < 8; ++dt) { const bf16x8 af = *(const LAS bf16x8*)(Vt + (dt * 16 + r16) * 136 + ks * 32 + quad * 8); acc[dt] = MFMA16(af, bfr, acc[dt]); }
      }
      const float bias = bs[gq * 128 + t];
#pragma unroll
      for (int dt = 0; dt < 8; ++dt) { const int d = gq * 128 + dt * 16 + quad * 4;
          const u32x2 uu = *(const u32x2*)(ZGM + (size_t)(m0 + t) * 1024 + d);
          u32x2 w; w.x = cvt_pk_bf16(bflo(uu.x) * (acc[dt][0] + bias), bfhi(uu.x) * (acc[dt][1] + bias)); w.y = cvt_pk_bf16(bflo(uu.y) * (acc[dt][2] + bias), bfhi(uu.y) * (acc[dt][3] + bias));
          *(u32x2*)(U + (size_t)(m0 + t) * 512 + d) = w; } }
    __syncthreads();
}
template <int D> struct KVRegs { u32x4 k[D / 64], v[D / 64]; };
template <int D> __device__ __forceinline__ void kv_load(KVRegs<D>& R, const bf16_t* Kg, int ldk, const bf16_t* Vg, int ldv, int tid) {
#pragma unroll
    for (int i = 0; i < D / 64; ++i) { const int c = tid + i * NTHREADS;
        { const int r = c / (D / 8), cc = c % (D / 8); R.k[i] = *(const u32x4*)(Kg + (size_t)r * ldk + cc * 8); }
        { const int d = c >> 3, cc = c & 7; R.v[i] = *(const u32x4*)(Vg + (size_t)d * ldv + cc * 8); } }
}
template <int D> __device__ __forceinline__ void kv_store(const KVRegs<D>& R, LAS bf16_t* Ks, LAS bf16_t* Vt, int tid) {
#pragma unroll
    for (int i = 0; i < D / 64; ++i) { const int c = tid + i * NTHREADS;
        { const int r = c / (D / 8), cc = c % (D / 8); *(LAS u32x4*)(Ks + r * (D + 8) + cc * 8) = R.k[i]; }
        { const int d = c >> 3, cc = c & 7; *(LAS u32x4*)(Vt + d * 72 + cc * 8) = R.v[i]; } }
}
template <int D, int QS, class MaskF>
__device__ __forceinline__ void flash_block(const LAS bf16_t* Ks, const LAS bf16_t* Vt, const bf16x8 (&qf)[QS][D / 32], f32x4 (&acc)[QS][D / 16], float (&mrun)[QS], float (&lrun)[QS], const MaskF& allowed, int lane) {
    const int r16 = lane & 15, quad = lane >> 4;
#pragma unroll
    for (int qs = 0; qs < QS; ++qs) {
        f32x4 s[4];
#pragma unroll
        for (int kt = 0; kt < 4; ++kt) { s[kt] = (f32x4){0.f, 0.f, 0.f, 0.f};
#pragma unroll
            for (int ks = 0; ks < D / 32; ++ks) { const bf16x8 kf = *(const LAS bf16x8*)(Ks + (kt * 16 + r16) * (D + 8) + ks * 32 + quad * 8); s[kt] = MFMA16(kf, qf[qs][ks], s[kt]); } }
        float mx = -1e30f;
#pragma unroll
        for (int kt = 0; kt < 4; ++kt)
#pragma unroll
            for (int i = 0; i < 4; ++i) { const bool ok = allowed(qs, kt * 16 + quad * 4 + i); const float v = ok ? s[kt][i] * LOG2E : -1e30f; s[kt][i] = v; mx = fmaxf(mx, v); }
        mx = fmaxf(mx, __shfl_xor(mx, 16)); mx = fmaxf(mx, __shfl_xor(mx, 32));
        const float mnew = fmaxf(mrun[qs], mx), alpha = __builtin_amdgcn_exp2f(mrun[qs] - mnew); mrun[qs] = mnew;
        float ps = 0.f;
#pragma unroll
        for (int kt = 0; kt < 4; ++kt)
#pragma unroll
            for (int i = 0; i < 4; ++i) { const float p = (s[kt][i] > -1e29f) ? __builtin_amdgcn_exp2f(s[kt][i] - mnew) : 0.f; s[kt][i] = p; ps += p; }
        ps += __shfl_xor(ps, 16); ps += __shfl_xor(ps, 32);
        lrun[qs] = lrun[qs] * alpha + ps;
        bf16x8 pf[2];
#pragma unroll
        for (int kk = 0; kk < 2; ++kk) { u32x4 w; w.x = cvt_pk_bf16(s[2 * kk][0], s[2 * kk][1]); w.y = cvt_pk_bf16(s[2 * kk][2], s[2 * kk][3]); w.z = cvt_pk_bf16(s[2 * kk + 1][0], s[2 * kk + 1][1]); w.w = cvt_pk_bf16(s[2 * kk + 1][2], s[2 * kk + 1][3]);
            pf[kk] = __builtin_bit_cast(bf16x8, w); }
#pragma unroll
        for (int dt = 0; dt < D / 16; ++dt) { acc[qs][dt] = acc[qs][dt] * alpha;
#pragma unroll
            for (int kk = 0; kk < 2; ++kk) { const LAS bf16_t* vp = Vt + (dt * 16 + r16) * 72 + kk * 32 + quad * 4;
                const s16x4 lo = *(const LAS s16x4*)vp, hi = *(const LAS s16x4*)(vp + 16);
                const bf16x8 vf = __builtin_shufflevector(lo, hi, 0, 1, 2, 3, 4, 5, 6, 7);
                acc[qs][dt] = MFMA16(vf, pf[kk], acc[qs][dt]); } }
    }
}
constexpr int NSA_KS = 0, NSA_VT = 18432, NSA_IMP = NSA_VT + 17408, NSA_SEL = NSA_IMP + 32768, NSA_UNI = NSA_SEL + 256;
__device__ __forceinline__ void nsa_unit(int unit, const bf16_t* ZQ, const bf16_t* ZKV, const bf16_t* ZG, const bf16_t* KC, const bf16_t* VCT, const bf16_t* VTS, const bf16_t* VTW, bf16_t* O,
                                         LAS unsigned char* lds, int wave, int lane, int tid) {
    const int qb = unit & 63, g = (unit >> 6) & 1, b = unit >> 7, cur = qb >> 1;
    const int r16 = lane & 15, quad = lane >> 4, hh = wave & 3, h = g * 4 + hh, t0 = qb * 32;
    LAS bf16_t* Ks = (LAS bf16_t*)(lds + NSA_KS); LAS bf16_t* Vt = (LAS bf16_t*)(lds + NSA_VT);
    LAS float* impS = (LAS float*)(lds + NSA_IMP); LAS unsigned* selS = (LAS unsigned*)(lds + NSA_SEL); LAS unsigned* uniS = (LAS unsigned*)(lds + NSA_UNI);
    const int tok = (wave >> 2) * 16 + r16, tq = t0 + tok;
    const size_t row = (size_t)b * SEQ + tq;
    bf16x8 qf[1][2]; float gate[3];
#pragma unroll
    for (int ks = 0; ks < 2; ++ks) qf[0][ks] = *(const bf16x8*)(ZQ + row * 512 + h * 64 + ks * 32 + quad * 8);
#pragma unroll
    for (int c = 0; c < 3; ++c) gate[c] = fsigmoid(__uint_as_float((unsigned)ZG[row * 32 + h * 3 + c] << 16));
    const bf16_t* Kslc = ZKV + ((size_t)b * SEQ) * 768 + 2 * 128 + g * 64; const bf16_t* Kwin = Kslc + 2 * 128;
    const bf16_t* Vslc = VTS + (size_t)(b * 2 + g) * 64 * 2048; const bf16_t* Vwin = VTW + (size_t)(b * 2 + g) * 64 * 2048;
    KVRegs<64> R, R1;
    kv_load<64>(R, Kslc, 768, Vslc, 2048, tid);
    f32x4 outv[4];
    { const bf16_t* Kg = KC + (size_t)(b * 2 + g) * 128 * 64; const bf16_t* Vg = VCT + (size_t)(b * 2 + g) * 64 * 128;
#pragma unroll
      for (int i = 0; i < 2; ++i) { const int c = tid + i * NTHREADS;
          { const int r = c >> 3, cc = c & 7; *(LAS u32x4*)(Ks + r * 72 + cc * 8) = *(const u32x4*)(Kg + r * 64 + cc * 8); }
          { const int d = c >> 4, cc = c & 15; *(LAS u32x4*)(Vt + d * 136 + cc * 8) = *(const u32x4*)(Vg + d * 128 + cc * 8); } }
      if (tid == 0) uniS[0] = 0u;
      __syncthreads();
      {
          f32x4 s[8]; float mx = -1e30f;
#pragma unroll
          for (int kt = 0; kt < 8; ++kt) { s[kt] = (f32x4){0.f, 0.f, 0.f, 0.f};
#pragma unroll
              for (int ks = 0; ks < 2; ++ks) { const bf16x8 kf = *(const LAS bf16x8*)(Ks + (kt * 16 + r16) * 72 + ks * 32 + quad * 8); s[kt] = MFMA16(kf, qf[0][ks], s[kt]); }
#pragma unroll
              for (int i = 0; i < 4; ++i) { const int n = kt * 16 + quad * 4 + i; const bool ok = (n < 127) && (16 * n + 31 <= tq); const float v = ok ? s[kt][i] * LOG2E : -1e30f; s[kt][i] = v; mx = fmaxf(mx, v); } }
          mx = fmaxf(mx, __shfl_xor(mx, 16)); mx = fmaxf(mx, __shfl_xor(mx, 32));
          float ps = 0.f;
#pragma unroll
          for (int kt = 0; kt < 8; ++kt)
#pragma unroll
              for (int i = 0; i < 4; ++i) { const float p = (s[kt][i] > -1e29f) ? __builtin_amdgcn_exp2f(s[kt][i] - mx) : 0.f; s[kt][i] = p; ps += p; }
          ps += __shfl_xor(ps, 16); ps += __shfl_xor(ps, 32);
          const float inv = ps > 0.f ? 1.0f / ps : 0.f;
          float so_prev = 0.f; const int src = (lane - 16) & 63;
#pragma unroll
          for (int kt = 0; kt < 8; ++kt) { s[kt] = s[kt] * inv;
              const float so = 0.5f * s[kt][3]; const float a1 = __shfl(so, src), a2 = __shfl(so_prev, src);
              const float v = (s[kt][0] + s[kt][1]) + (s[kt][2] + so) + (quad > 0 ? a1 : a2);
              impS[(hh * 32 + tok) * 32 + kt * 4 + quad] = v; so_prev = so; }
          f32x4 acc[4];
#pragma unroll
          for (int dt = 0; dt < 4; ++dt) acc[dt] = (f32x4){0.f, 0.f, 0.f, 0.f};
#pragma unroll
          for (int kk = 0; kk < 4; ++kk) { u32x4 w; w.x = cvt_pk_bf16(s[2 * kk][0], s[2 * kk][1]); w.y = cvt_pk_bf16(s[2 * kk][2], s[2 * kk][3]); w.z = cvt_pk_bf16(s[2 * kk + 1][0], s[2 * kk + 1][1]); w.w = cvt_pk_bf16(s[2 * kk + 1][2], s[2 * kk + 1][3]);
              const bf16x8 pf = __builtin_bit_cast(bf16x8, w);
#pragma unroll
              for (int dt = 0; dt < 4; ++dt) { const LAS bf16_t* vp = Vt + (dt * 16 + r16) * 136 + kk * 32 + quad * 4;
                  const s16x4 lo = *(const LAS s16x4*)vp, hi = *(const LAS s16x4*)(vp + 16);
                  acc[dt] = MFMA16(__builtin_shufflevector(lo, hi, 0, 1, 2, 3, 4, 5, 6, 7), pf, acc[dt]); } }
#pragma unroll
          for (int dt = 0; dt < 4; ++dt) outv[dt] = acc[dt] * gate[0];
      }
      __syncthreads();
#pragma unroll 1
      for (int pass = 0; pass < 2; ++pass) {
          const int tk = wave * 4 + pass * 2 + (lane >> 5), j = lane & 31;
          const float imp = (impS[tk * 32 + j] + impS[(32 + tk) * 32 + j]) + (impS[(64 + tk) * 32 + j] + impS[(96 + tk) * 32 + j]);
          const bool forced = (j == 0) || (j == cur) || (j == cur - 1);
          unsigned sel = 1u | (1u << cur) | (cur > 0 ? (1u << (cur - 1)) : 0u);
          unsigned key = forced ? 0u : ((j <= cur ? (0x80000000u | (__float_as_uint(imp) & 0x7fffffe0u)) : 0u) | (unsigned)(31 - j));
          const int nr = 8 - __builtin_popcount(sel);
#pragma unroll 1
          for (int rnd = 0; rnd < nr; ++rnd) { unsigned bk = key;
#pragma unroll
              for (int off = 16; off >= 1; off >>= 1) { const unsigned ok = (unsigned)__shfl_xor((int)bk, off); bk = ok > bk ? ok : bk; }
              const int bj = 31 - (int)(bk & 31u);
              sel |= 1u << bj; if (j == bj) key = 0u; }
          if (j == 0) { selS[tk] = sel; atomicOr((unsigned*)uniS, sel); } }
      __syncthreads();
    }
    const unsigned selm = selS[tok];
    unsigned todo = (unsigned)__builtin_amdgcn_readfirstlane((int)uniS[0]) & ((2u << cur) - 1u) & ~1u;
    int jwn = (cur > 4 ? cur - 4 : 0);
    f32x4 acc[1][4]; float mrun[1], lrun[1];
#define NSA_RESET() do { mrun[0] = -1e30f; lrun[0] = 0.f; _Pragma("unroll") for (int dt = 0; dt < 4; ++dt) acc[0][dt] = (f32x4){0.f, 0.f, 0.f, 0.f}; } while (0)
#define NSA_ACCUM(c) do { const float f = (lrun[0] > 0.f ? 1.0f / lrun[0] : 0.f) * gate[c]; _Pragma("unroll") for (int dt = 0; dt < 4; ++dt) outv[dt] = outv[dt] + acc[0][dt] * f; } while (0)
#define NSA_NEXT(jv, wv) do { if (todo) { jv = __builtin_ctz(todo); todo &= todo - 1u; wv = 0; } else if (jwn <= cur) { jv = jwn++; wv = 1; } else { jv = -1; wv = 1; } } while (0)
#define NSA_LOAD(RR, jv, wv) kv_load<64>(RR, ((wv) ? Kwin : Kslc) + (size_t)(jv) * 64 * 768, 768, ((wv) ? Vwin : Vslc) + (jv) * 64, 2048, tid)
    int j0 = 0, w0 = 0, j1, w1;
    NSA_NEXT(j1, w1); NSA_LOAD(R1, j1, w1);
    NSA_RESET(); bool in_win = false;
#define NSA_STEP(RS) do { \
        if (w0 && !in_win) { NSA_ACCUM(1); NSA_RESET(); in_win = true; } \
        kv_store<64>(RS, Ks, Vt, tid); \
        __syncthreads(); \
        int j2, w2; NSA_NEXT(j2, w2); \
        if (j2 >= 0) NSA_LOAD(RS, j2, w2); \
        { const int jj = j0; const bool ww = (w0 != 0); \
          auto mask = [=](int, int kl) { const int kp = jj * 64 + kl; return (kp <= tq) && (ww ? (kp + 256 > tq) : (((selm >> jj) & 1u) != 0u)); }; \
          flash_block<64, 1>(Ks, Vt, qf, acc, mrun, lrun, mask, lane); } \
        __syncthreads(); \
        j0 = j1; w0 = w1; j1 = j2; w1 = w2; } while (0)
#pragma unroll 1
    for (;;) { NSA_STEP(R); if (j0 < 0) break; NSA_STEP(R1); if (j0 < 0) break; }
#undef NSA_STEP
    NSA_ACCUM(2);
#undef NSA_RESET
#undef NSA_ACCUM
#undef NSA_NEXT
#undef NSA_LOAD
#pragma unroll
    for (int dt = 0; dt < 4; ++dt) { u32x2 w; w.x = cvt_pk_bf16(outv[dt][0], outv[dt][1]); w.y = cvt_pk_bf16(outv[dt][2], outv[dt][3]);
        *(u32x2*)(O + row * 512 + h * 64 + dt * 16 + quad * 4) = w; }
}
__device__ __forceinline__ void cross_unit(int unit, const bf16_t* QX, const bf16_t* KM, const bf16_t* VTM, bf16_t* OX, LAS unsigned char* lds, int wave, int lane, int tid) {
    const int qblk = unit & 15, hd = (unit >> 4) & 3, b = unit >> 6;
    const int r16 = lane & 15, quad = lane >> 4;
    LAS bf16_t* Ks = (LAS bf16_t*)lds; LAS bf16_t* Vt = (LAS bf16_t*)(lds + 64 * 264 * 2);
    const size_t row = (size_t)b * SEQ + qblk * 128 + wave * 16 + r16;
    const bf16_t* Kg = KM + ((size_t)b * MEML) * 2048 + hd * 256; const bf16_t* Vg = VTM + (size_t)(b * 4 + hd) * 256 * 256;
    KVRegs<256> R;
    kv_load<256>(R, Kg, 2048, Vg, 256, tid);
    bf16x8 qf[1][8];
#pragma unroll
    for (int ks = 0; ks < 8; ++ks) qf[0][ks] = *(const bf16x8*)(QX + row * DM + hd * 256 + ks * 32 + quad * 8);
    f32x4 acc[1][16]; float mrun[1] = {-1e30f}, lrun[1] = {0.f};
#pragma unroll
    for (int dt = 0; dt < 16; ++dt) acc[0][dt] = (f32x4){0.f, 0.f, 0.f, 0.f};
#pragma unroll 1
    for (int j = 0; j < 4; ++j) {
        kv_store<256>(R, Ks, Vt, tid);
        __syncthreads();
        if (j < 3) kv_load<256>(R, Kg + (size_t)(j + 1) * 64 * 2048, 2048, Vg + (j + 1) * 64, 256, tid);
        auto mask = [](int, int) { return true; };
        flash_block<256, 1>(Ks, Vt, qf, acc, mrun, lrun, mask, lane);
        __syncthreads();
    }
    const float inv = 1.0f / lrun[0];
#pragma unroll
    for (int dt = 0; dt < 16; ++dt) { const f32x4 o = acc[0][dt] * inv; u32x2 w; w.x = cvt_pk_bf16(o[0], o[1]); w.y = cvt_pk_bf16(o[2], o[3]);
        *(u32x2*)(OX + row * DM + hd * 256 + dt * 16 + quad * 4) = w; }
}
template <class Epi> __device__ __forceinline__ void run_gemm(LAS unsigned char* lds, const bf16_t* A, const bf16_t* Bt, int M, int N, int K, int G, int c, const Epi& E) {
    asm volatile("" : "+s"(K), "+s"(N), "+s"(M));
    pg8::Gemm g{A, Bt, M, N, K}; pg8::StaticOrder S; S.init(M, N, G, c);
    pg8::gemm_phase<Epi, pg8::StaticOrder, true, true>(lds, g, S, E);
}
__global__ void __launch_bounds__(NTHREADS, 2) hybrid_fwd(Args args) {
    extern __shared__ __attribute__((aligned(16))) unsigned char lds_raw[];
    LAS unsigned char* lds = (LAS unsigned char*)lds_raw;
    bool rep_done = false; bool first = true;
    for (int ph = args.ph_lo; ph < args.ph_hi; ) {
        int G = gridDim.x, bid = blockIdx.x; asm volatile("" : "+s"(G), "+s"(bid));
        int tid = threadIdx.x; asm volatile("" : "+v"(tid));
        const int lane = tid & 63, wave = __builtin_amdgcn_readfirstlane(tid >> 6);
        const int gw = bid * NWAVES + wave, NGW = G * NWAVES, gt = bid * NTHREADS + tid, NGT = G * NTHREADS;
        karg_t kp = (karg_t)__builtin_amdgcn_kernarg_segment_ptr(); asm volatile("" : "+s"(kp));
        unsigned char* ws = *(unsigned char* const __attribute__((address_space(4)))*)(kp + 8 * (N_IN + 1));
        float* X = *(float* const __attribute__((address_space(4)))*)(kp + 8 * N_IN); bf16_t* XN = (bf16_t*)(ws + WS_XN);
        if (!first) { asm volatile("s_waitcnt vmcnt(0)" ::: "memory"); cg::this_grid().sync(); }
        first = false;
        const int l = ph == 0 ? 0 : (ph - 1) / PH_PER_LAYER, k = ph == 0 ? -1 : (ph - 1) % PH_PER_LAYER;
#define LP(idx, per) (AIN(idx) + (size_t)l * (per))
#ifndef PHM
#define PHM 0xFFFFFFFFu
#endif
#define EN(b) (((PHM) >> (b)) & 1u)
#ifndef REPEAT_MASK
#define REPEAT_MASK 0
#endif
#ifndef REPEAT_PREP
#define REPEAT_PREP 1
#endif
        if (EN(0) && k == -1) {
            for (int pr = 0; pr < REPEAT_PREP; ++pr) { prep_layer(kp, ws, 0, lds, gw, NGW, wave, lane, tid, G, bid); __syncthreads(); }
            row_pass(nullptr, nullptr, 0.f, AIN(I_X), X, AIN(I_FF1_PRE), XN, MT, gw, NGW, lane);
        } else if (EN(1) && (k == 0 || k == 14)) {
            pg8::EpiSwiGLU E{(bf16_t*)(ws + WS_H), DFF};
            run_gemm(lds, XN, (const bf16_t*)(ws + (k == 0 ? WS_W13A : WS_W13B)), MT, 2 * DFF, DM, G, bid, E);
        } else if (EN(2) && (k == 1 || k == 15 || k == 8 || k == 12)) {
            const bf16_t* A; const bf16_t* Bt; int K; float* Y;
            if (k == 1) { A = (const bf16_t*)(ws + WS_H); Bt = (const bf16_t*)(ws + WS_W2A); K = DFF; Y = (float*)(ws + WS_YF); }
            else if (k == 15) { A = (const bf16_t*)(ws + WS_H); Bt = (const bf16_t*)(ws + WS_W2B); K = DFF; Y = (float*)(ws + WS_YF); }
            else if (k == 8) { A = (const bf16_t*)(ws + WS_MRG); Bt = (const bf16_t*)(ws + WS_WMIX); K = DM; Y = (float*)(ws + WS_YM); }
            else { A = (const bf16_t*)(ws + WS_OX); Bt = (const bf16_t*)(ws + WS_WO); K = DM; Y = (float*)(ws + WS_YF); }
            pg8::EpiF32 E{Y, DM};
            run_gemm(lds, A, Bt, MT, DM, K, G, bid, E);
        } else if (EN(3) && (k == 2 || k == 9 || k == 13 || k == 16)) {
            const float *Y, *gpost, *gnext; float coef;
            if (k == 2) { Y = (const float*)(ws + WS_YF); gpost = LP(I_FF1_POST, DM); gnext = LP(I_MIX_PRE, DM); coef = 0.5f; }
            else if (k == 9) { Y = (const float*)(ws + WS_YM); gpost = LP(I_MIX_POST, DM); gnext = LP(I_MEM_PRE, DM); coef = 1.0f; }
            else if (k == 13) { Y = (const float*)(ws + WS_YF); gpost = LP(I_MEM_POST, DM); gnext = LP(I_FF2_PRE, DM); coef = 1.0f; }
            else { Y = (const float*)(ws + WS_YF); gpost = LP(I_FF2_POST, DM); gnext = (l + 1 < DEPTH) ? AIN(I_FF1_PRE) + (size_t)(l + 1) * DM : nullptr; coef = 0.5f; }
            row_pass(Y, gpost, coef, X, X, gnext, XN, MT, gw, NGW, lane);
            if (k == 16 && l + 1 < DEPTH) for (int pr = 0; pr < REPEAT_PREP; ++pr) { prep_layer(kp, ws, l + 1, lds, gw, NGW, wave, lane, tid, G, bid); __syncthreads(); }
        } else if (EN(4) && (k == 3 || k == 6)) {
            const bool gt6 = (k == 6);
            pg8::EpiZin E{gt6 ? LP(I_BIN, INC) + 2840 : (const float*)(ws + WS_BIASIN), (bf16_t*)(ws + (gt6 ? WS_G : WS_ZA)), (bf16_t*)(ws + WS_ZQ), (bf16_t*)(ws + WS_ZKV), (bf16_t*)(ws + WS_ZGM), (bf16_t*)(ws + WS_ZG), gt6 ? 1 : 0, (bf16_t*)(ws + WS_VTS), (bf16_t*)(ws + WS_VTW)};
            run_gemm(lds, XN, (const bf16_t*)(ws + (gt6 ? WS_WMG : WS_WIN)), MT, 3072, DM, G, bid, E);
        } else if (EN(5) && k == 4) {
            for (int u = bid; u < 256; u += G)
                compress_unit(u, (const bf16_t*)(ws + WS_ZKV), (const bf16_t*)(ws + WS_W1K), (const bf16_t*)(ws + WS_W1V), (const bf16_t*)(ws + WS_W2K), (const bf16_t*)(ws + WS_W2V),
                              LP(I_CPK, 2048), LP(I_CPV, 2048), (bf16_t*)(ws + WS_KC), (bf16_t*)(ws + WS_VC), lds, wave, lane);
            pool_pass((const bf16_t*)(ws + WS_ZA), (bf16_t*)(ws + WS_P), gt, NGT);
            for (int u = bid; u < 512; u += G)
                gmlp_unit(u, (const bf16_t*)(ws + WS_ZGM), (const bf16_t*)(ws + WS_GWS), LP(I_GLNG, 512), LP(I_GLNB, 512), LP(I_GBS, 512), (bf16_t*)(ws + WS_U), lds, wave, lane, tid);
        } else if (EN(6) && k == 5) {
            for (int u = bid, it = 0; u < 1024; u += G, ++it) { const int uu = (u & ~63) | ((it & 1) ? (u & 63) : 63 - (u & 63));
                nsa_unit(uu, (const bf16_t*)(ws + WS_ZQ), (const bf16_t*)(ws + WS_ZKV), (const bf16_t*)(ws + WS_ZG), (const bf16_t*)(ws + WS_KC), (const bf16_t*)(ws + WS_VC), (const bf16_t*)(ws + WS_VTS), (const bf16_t*)(ws + WS_VTW), (bf16_t*)(ws + WS_O), lds, wave, lane, tid);
                __syncthreads(); }
        } else if (EN(8) && k == 7) {
#ifndef MERGE_MASK
#define MERGE_MASK 7
#endif
            int nacc = 0;
            for (int i = 0; i < 3; ++i) {
                if (!((MERGE_MASK >> i) & 1)) continue;
                const bf16_t* A = (const bf16_t*)(ws + (i == 0 ? WS_P : (i == 1 ? WS_O : WS_U)));
                const bf16_t* Bt = (const bf16_t*)(ws + (i == 0 ? WS_WCOMB : (i == 1 ? WS_WBRN : WS_WBRG)));
                pg8::EpiMerge E{(const bf16_t*)(ws + WS_G), i * 1024, (bf16_t*)(ws + WS_MRG), nacc}; nacc = 1;
#ifdef PROBE_BF16S
                { pg8::EpiBf16S E2{(bf16_t*)(ws + WS_MRG), DM, 1.0f, nullptr}; run_gemm(lds, A, Bt, MT, DM, 512, G, bid, E2); }
#else
                run_gemm(lds, A, Bt, MT, DM, 512, G, bid, E);
#endif
                asm volatile("s_waitcnt vmcnt(0)" ::: "memory"); __builtin_amdgcn_fence(__ATOMIC_RELEASE, "agent"); __syncthreads(); __builtin_amdgcn_fence(__ATOMIC_ACQUIRE, "agent");
            }
        } else if (k == 10) {
        } else if (EN(9) && k == 11) {
            for (int u = bid; u < 512; u += G) { cross_unit(u, (const bf16_t*)(ws + WS_QX), (const bf16_t*)(ws + WS_KVM), (const bf16_t*)(ws + WS_VTM), (bf16_t*)(ws + WS_OX), lds, wave, lane, tid); __syncthreads(); }
        }
        if (EN(10) && (k == 0 || k == 10)) {
            const bool kv = (k == 0);
            pg8::EpiBf16S E{(bf16_t*)(ws + (kv ? WS_KVM : WS_QX)), kv ? 2048 : DM, kv ? 1.0f : 0.0625f, kv ? (bf16_t*)(ws + WS_VTM) : (bf16_t*)nullptr};
            run_gemm(lds, kv ? (const bf16_t*)(ws + WS_MEMN) : XN, (const bf16_t*)(ws + (kv ? WS_WKV : WS_WQ)), kv ? MM : MT, kv ? 2048 : DM, DM, G, kv ? (bid + G / 2) % G : bid, E);
        }
#undef LP
        if (((REPEAT_MASK >> (k + 1)) & 1) && !rep_done) { rep_done = true; } else { rep_done = false; ++ph; }
    }
}

__global__ void dump_kernel(const unsigned short* src, float* out, size_t n, size_t ld_src, size_t cols) {
    for (size_t i = (size_t)blockIdx.x * blockDim.x + threadIdx.x; i < n; i += (size_t)gridDim.x * blockDim.x) { const size_t r = i / cols, c = i % cols; out[i] = ld_src == 0 ? ((const float*)src)[i] : __uint_as_float((unsigned)src[r * ld_src + c] << 16); }
}
#ifndef MK_SPLIT
#define MK_SPLIT 0
#endif
extern "C" void kernel_launch(void* const* d_in, const int* in_sizes, int n_in, void* d_out, int out_size, void* d_ws, size_t ws_size, hipStream_t stream) {
    static int grid = 0;
    if (grid == 0) {
        if (n_in != N_IN || out_size != MT * DM || ws_size < WS_END) { fprintf(stderr, "kernel_launch: unexpected shapes (n_in %d out %d ws %zu)\n", n_in, out_size, ws_size); grid = -1; return; }
        int dev = 0, cus = 0, per_cu = 0;
        hipGetDevice(&dev); hipDeviceGetAttribute(&cus, hipDeviceAttributeMultiprocessorCount, dev);
        hipFuncSetAttribute((const void*)hybrid_fwd, hipFuncAttributeMaxDynamicSharedMemorySize, LDS_BYTES);
        hipOccupancyMaxActiveBlocksPerMultiprocessor(&per_cu, (const void*)hybrid_fwd, NTHREADS, LDS_BYTES);
        (void)hipGetLastError();
        if (per_cu < 1) per_cu = 1;
        grid = cus;
        if (grid <= 0) grid = 256;
    }
    if (grid < 0) return;
    Args a{};
    for (int i = 0; i < N_IN; ++i) a.in[i] = (const float*)d_in[i];
    a.out = (float*)d_out; a.ws = (unsigned char*)d_ws;
#if MK_SPLIT
#ifndef PH_LIMIT
#define PH_LIMIT NPHASES
#endif
    for (int ph = 0; ph < PH_LIMIT; ++ph) { a.ph_lo = ph; a.ph_hi = ph + 1; hipLaunchKernelGGL(hybrid_fwd, dim3(grid), dim3(NTHREADS), LDS_BYTES, stream, a); }
#ifdef DUMP_OFF
    hipLaunchKernelGGL(dump_kernel, dim3(2048), dim3(256), 0, stream, (const unsigned short*)((unsigned char*)d_ws + (DUMP_OFF)), (float*)d_out, (size_t)MT * DUMP_COLS, (size_t)DUMP_LD, (size_t)DUMP_COLS);
#endif
#else
    a.ph_lo = 0; a.ph_hi = NPHASES;
    void* kargs[] = {&a};
    hipError_t e = hipLaunchCooperativeKernel((const void*)hybrid_fwd, dim3(grid), dim3(NTHREADS), kargs, LDS_BYTES, stream);
    if (e != hipSuccess) fprintf(stderr, "cooperative launch failed: %s (grid %d)\n", hipGetErrorString(e), grid);
#endif
}
```

```cpp
#include <hip/hip_runtime.h>
#include <hip/hip_cooperative_groups.h>
#include <cstdio>
#include <cstdint>
namespace cg = cooperative_groups;
namespace pg8 {
#define PG8_LAS __attribute__((address_space(3)))
typedef unsigned short bf16_t;
typedef short bf16x8 __attribute__((ext_vector_type(8)));
typedef float f32x4 __attribute__((ext_vector_type(4)));
typedef unsigned u32x4 __attribute__((ext_vector_type(4)));
constexpr int BM = 256, BK = 64, HALF = 128, HTB = HALF * BK * 2  , STAGE_BYTES = 8 * HTB, NXCD = 8, WGM = 8;

__host__ __device__ __forceinline__ int lds_byte(int r, int c) { const int st = (r >> 4) * 2 + (c >> 5), rr = r & 15, cc = c & 31, ob = rr * 64 + cc * 2; return st * 1024 + (ob ^ (((ob >> 9) & 1) << 5)); }
__host__ __device__ __forceinline__ void stage_rc(int b, int& R, int& C) { const int st = b / 1024, sb = b % 1024, swz = sb ^ (((sb >> 9) & 1) << 5); R = (st >> 1) * 16 + swz / 64; C = (st & 1) * 32 + (swz % 64) / 2; }
__host__ __device__ __forceinline__ int perm32(int rho) { const int n = rho >> 4, i = rho & 15; return 8 * (i >> 2) + 4 * n + (i & 3); }

struct Unit { int pm, pn; };
struct Gemm { const bf16_t* A; const bf16_t* Bt; int M, N, K; };

struct StaticOrder {
    int nM, nN, nwg, G, c;
    __host__ __device__ void init(int M, int N, int G_, int c_) { nM = M / BM; nN = N / BM; nwg = nM * nN; G = G_; c = c_; }
    __host__ __device__ bool next(int i, Unit& u) const {
        const long L = (long)i * G + c; if (L >= nwg) return false;
        int wgid = (int)L; { const int q = nwg / NXCD, r = nwg % NXCD, xcd = wgid % NXCD, off = wgid / NXCD; wgid = (xcd < r ? xcd * (q + 1) : r * (q + 1) + (xcd - r) * q) + off; }
        const int nig = WGM * nN, gid = wgid / nig, fm = gid * WGM, gsz = (nM - fm) < WGM ? (nM - fm) : WGM;
        u.pm = fm + ((wgid % nig) % gsz); u.pn = (wgid % nig) / gsz; return true;
    }
    __device__ __forceinline__ void a_ready(const Unit&) const {}
    __device__ __forceinline__ void done(const Unit&) const {}
};

typedef float f32x2_cv __attribute__((ext_vector_type(2))); typedef __bf16 bf16x2_cv __attribute__((ext_vector_type(2)));
__device__ __forceinline__ unsigned cvt_pk_bf16(float lo, float hi) { const f32x2_cv v = {lo, hi}; const bf16x2_cv b = __builtin_convertvector(v, bf16x2_cv); return __builtin_bit_cast(unsigned, b); }
typedef float f32x2 __attribute__((ext_vector_type(2)));
typedef unsigned u32x2 __attribute__((ext_vector_type(2)));
__device__ __forceinline__ float fsigmoid(float v) { return __builtin_amdgcn_rcpf(1.0f + __expf(-v)); }
__device__ __forceinline__ float fgelu_tanh(float v) { const float z = 1.5957691216f * (v + 0.044715f * v * v * v); return v * fsigmoid(z); }
__device__ __forceinline__ float bflo(unsigned w) { return __uint_as_float(w << 16); }
__device__ __forceinline__ float bfhi(unsigned w) { return __uint_as_float(w & 0xffff0000u); }

struct EpiF32 {
    static constexpr bool PERM = false, AFTER_DRAIN = false;
    float* C; int ldc;
    __device__ __forceinline__ void operator()(const f32x4 (&acc)[2][2][4][2], const Unit& u, int wr, int wc, int fr, int fq) const {
        const int row0 = u.pm * BM + wr * 64 + fr, col0 = u.pn * BM + wc * 32 + 4 * fq;
#pragma unroll
        for (int ai = 0; ai < 2; ++ai)
#pragma unroll
            for (int m = 0; m < 4; ++m) { float* rowp = C + (size_t)(row0 + ai * HALF + m * 16) * ldc + col0;
#pragma unroll
                for (int bj = 0; bj < 2; ++bj)
#pragma unroll
                    for (int n = 0; n < 2; ++n) *(f32x4*)(rowp + bj * HALF + n * 16) = acc[ai][bj][m][n]; }
    }
};
struct EpiBf16S {
    static constexpr bool PERM = true, AFTER_DRAIN = false;
    bf16_t* O; int ldc; float scale; bf16_t* vt;
    __device__ __forceinline__ void operator()(const f32x4 (&acc)[2][2][4][2], const Unit& u, int wr, int wc, int fr, int fq) const {
        const int row0 = u.pm * BM + wr * 64 + fr, col0 = u.pn * BM + wc * 32 + 8 * fq;
        const bool tr = (vt != nullptr) && (u.pn >= 4);
#pragma unroll
        for (int ai = 0; ai < 2; ++ai)
#pragma unroll
            for (int m = 0; m < 4; ++m) { const int row = row0 + ai * HALF + m * 16; bf16_t* rowp = O + (size_t)row * ldc + col0;
#pragma unroll
                for (int bj = 0; bj < 2; ++bj) { const f32x4 v0 = acc[ai][bj][m][0] * scale, v1 = acc[ai][bj][m][1] * scale;
                    u32x4 w; w.x = cvt_pk_bf16(v0[0], v0[1]); w.y = cvt_pk_bf16(v0[2], v0[3]); w.z = cvt_pk_bf16(v1[0], v1[1]); w.w = cvt_pk_bf16(v1[2], v1[3]);
                    if (tr) { bf16_t* p = vt + ((size_t)(((row >> 8) * 4 + (u.pn - 4)) * 256 + bj * HALF + wc * 32 + 8 * fq)) * 256 + (row & 255);
                        p[0 * 256] = (bf16_t)(w.x & 0xffffu); p[1 * 256] = (bf16_t)(w.x >> 16); p[2 * 256] = (bf16_t)(w.y & 0xffffu); p[3 * 256] = (bf16_t)(w.y >> 16);
                        p[4 * 256] = (bf16_t)(w.z & 0xffffu); p[5 * 256] = (bf16_t)(w.z >> 16); p[6 * 256] = (bf16_t)(w.w & 0xffffu); p[7 * 256] = (bf16_t)(w.w >> 16); }
                    else *(u32x4*)(rowp + bj * HALF) = w; }
                asm volatile("" ::: "memory"); }
    }
};
struct EpiSwiGLU {
    static constexpr bool PERM = true, AFTER_DRAIN = false;
    bf16_t* H; int ldh;
    __device__ __forceinline__ void operator()(const f32x4 (&acc)[2][2][4][2], const Unit& u, int wr, int wc, int fr, int fq) const {
        const int row0 = u.pm * BM + wr * 64 + fr, col0 = u.pn * HALF + wc * 32 + 8 * fq;
#pragma unroll
        for (int ai = 0; ai < 2; ++ai)
#pragma unroll
            for (int m = 0; m < 4; ++m) { bf16_t* p = H + (size_t)(row0 + ai * HALF + m * 16) * ldh + col0;
                f32x4 h0, h1;
#pragma unroll
                for (int i = 0; i < 4; ++i) { const float g0 = acc[ai][0][m][0][i], g1 = acc[ai][0][m][1][i];
                    h0[i] = g0 * fsigmoid(g0) * acc[ai][1][m][0][i]; h1[i] = g1 * fsigmoid(g1) * acc[ai][1][m][1][i]; }
                u32x4 w; w.x = cvt_pk_bf16(h0[0], h0[1]); w.y = cvt_pk_bf16(h0[2], h0[3]); w.z = cvt_pk_bf16(h1[0], h1[1]); w.w = cvt_pk_bf16(h1[2], h1[3]);
                *(u32x4*)p = w; }
    }
};
struct EpiZin {
    static constexpr bool PERM = true, AFTER_DRAIN = false;
    const float* bias; bf16_t *ZA, *ZQ, *ZKV, *ZGM, *ZG; int mode; bf16_t *VTS, *VTW;
    __device__ __forceinline__ void operator()(const f32x4 (&acc)[2][2][4][2], const Unit& u, int wr, int wc, int fr, int fq) const {
        const int pn = u.pn; const int row0 = u.pm * BM + wr * 64 + fr;
        bf16_t* base; int ld, cb; int act = 0; float sc = 1.f; bool only0 = false;
        if (mode == 1) { base = ZA; ld = 3072; cb = pn * 256; act = 2; }
        else if (pn < 2) { base = ZA; ld = 512; cb = pn * 256; }
        else if (pn < 4) { base = ZQ; ld = 512; cb = (pn - 2) * 256; sc = 0.125f; }
        else if (pn < 7) { base = ZKV; ld = 768; cb = (pn - 4) * 256; }
        else if (pn < 11) { base = ZGM; ld = 1024; cb = (pn - 7) * 256; act = 1; }
        else { base = ZG; ld = 32; cb = 0; only0 = true; }
        const int ct = wc * 32 + 8 * fq;
        bf16_t* bp = base + (size_t)row0 * ld + cb + ct;
        f32x4 bv[2][2];
#pragma unroll
        for (int bj = 0; bj < 2; ++bj)
#pragma unroll
            for (int n = 0; n < 2; ++n) bv[bj][n] = *(const f32x4*)(bias + pn * 256 + bj * HALF + ct + 4 * n);
#pragma unroll
        for (int ai = 0; ai < 2; ++ai)
#pragma unroll
            for (int m = 0; m < 4; ++m) {
#pragma unroll
                for (int bj = 0; bj < 2; ++bj) {
                    f32x4 v0 = (acc[ai][bj][m][0] + bv[bj][0]) * sc, v1 = (acc[ai][bj][m][1] + bv[bj][1]) * sc;
                    if (act == 1) {
#pragma unroll
                        for (int i = 0; i < 4; ++i) { v0[i] = fgelu_tanh(v0[i]); v1[i] = fgelu_tanh(v1[i]); } }
                    else if (act == 2) {
#pragma unroll
                        for (int i = 0; i < 4; ++i) { v0[i] = fsigmoid(v0[i]); v1[i] = fsigmoid(v1[i]); } }
                    u32x4 w; w.x = cvt_pk_bf16(v0[0], v0[1]); w.y = cvt_pk_bf16(v0[2], v0[3]); w.z = cvt_pk_bf16(v1[0], v1[1]); w.w = cvt_pk_bf16(v1[2], v1[3]);
                    if (mode == 0 && bj == 1 && (pn == 5 || pn == 6)) {
                        const int row = row0 + ai * HALF + m * 16, bb = row >> 11, t = row & 2047;
                        bf16_t* vt = (pn == 5 ? VTS : VTW) + ((size_t)((bb * 2 + (wc >> 1)) * 64 + (wc & 1) * 32 + 8 * fq)) * 2048 + t;
                        vt[0 * 2048] = (bf16_t)(w.x & 0xffffu); vt[1 * 2048] = (bf16_t)(w.x >> 16); vt[2 * 2048] = (bf16_t)(w.y & 0xffffu); vt[3 * 2048] = (bf16_t)(w.y >> 16);
                        vt[4 * 2048] = (bf16_t)(w.z & 0xffffu); vt[5 * 2048] = (bf16_t)(w.z >> 16); vt[6 * 2048] = (bf16_t)(w.w & 0xffffu); vt[7 * 2048] = (bf16_t)(w.w >> 16);
                    } else if (!only0 || (wc == 0 && bj == 0)) *(u32x4*)(bp + (ai * HALF + m * 16) * ld + bj * HALF) = w; }
                asm volatile("" ::: "memory"); }
    }
};
struct EpiMerge {
    static constexpr bool PERM = true, AFTER_DRAIN = false;
    const bf16_t* G; int goff; bf16_t* MRG; int accum;
    __device__ __forceinline__ void operator()(const f32x4 (&acc)[2][2][4][2], const Unit& u, int wr, int wc, int fr, int fq) const {
        const int row0 = u.pm * BM + wr * 64 + fr, col0 = u.pn * BM + wc * 32 + 8 * fq;
#pragma unroll
        for (int ai = 0; ai < 2; ++ai)
#pragma unroll
            for (int m = 0; m < 4; ++m) { const size_t r = (size_t)(row0 + ai * HALF + m * 16);
#pragma unroll
                for (int bj = 0; bj < 2; ++bj) {
#ifdef MERGE_NOGATE
                    const u32x4 g = (u32x4){0x3f803f80u, 0x3f803f80u, 0x3f803f80u, 0x3f803f80u};
#else
                    const u32x4 g = *(const u32x4*)(G + r * 3072 + goff + col0 + bj * HALF);
#endif
                    bf16_t* p = MRG + r * 1024 + col0 + bj * HALF;
                    f32x4 v0 = acc[ai][bj][m][0], v1 = acc[ai][bj][m][1];
                    v0[0] *= bflo(g.x); v0[1] *= bfhi(g.x); v0[2] *= bflo(g.y); v0[3] *= bfhi(g.y);
                    v1[0] *= bflo(g.z); v1[1] *= bfhi(g.z); v1[2] *= bflo(g.w); v1[3] *= bfhi(g.w);
                    if (accum) { const u32x4 o = *(const u32x4*)p;
                        v0[0] += bflo(o.x); v0[1] += bfhi(o.x); v0[2] += bflo(o.y); v0[3] += bfhi(o.y);
                        v1[0] += bflo(o.z); v1[1] += bfhi(o.z); v1[2] += bflo(o.w); v1[3] += bfhi(o.w); }
                    u32x4 w; w.x = cvt_pk_bf16(v0[0], v0[1]); w.y = cvt_pk_bf16(v0[2], v0[3]); w.z = cvt_pk_bf16(v1[0], v1[1]); w.w = cvt_pk_bf16(v1[2], v1[3]);
                    *(u32x4*)p = w; } }
    }
};
template <class Epi, class Sched, bool ALIGN_EPI = false, bool SP2 = false>
__device__ __forceinline__ void gemm_phase(PG8_LAS unsigned char* lds, const Gemm g, const Sched& S, const Epi& E) {
    int tid_o = threadIdx.x; asm volatile("" : "+v"(tid_o));
    const int tid = tid_o, wid = __builtin_amdgcn_readfirstlane(tid >> 6), lane = tid & 63, wr = wid >> 2, wc = wid & 3, fr = lane & 15, fq = lane >> 4;
    const int K = g.K, nt = K / BK;
    unsigned voffA[2], voffB[2];
#pragma unroll
    for (int i = 0; i < 2; ++i) { int R, C; stage_rc(tid * 16 + i * 8192, R, C); const int Rb = Epi::PERM ? ((R & ~31) + perm32(R & 31)) : R;
        voffA[i] = (unsigned)(R * K + C) * 2u; voffB[i] = (unsigned)(Rb * K + C) * 2u; }
    const size_t kstep = (size_t)(BK * 2);
    const size_t hstep = (size_t)HALF * K * 2;
    const size_t tstep = 2 * hstep;
    const unsigned ldsw = (unsigned)wid * 1024u;
    const int aoff = lds_byte(wr * 64 + fr, fq * 8), boff = lds_byte(wc * 32 + fr, fq * 8);
#define PG8_SA(b, h) (((b) * 2 + (h)) * HTB)
#define PG8_SB(b, h) ((4 + (b) * 2 + (h)) * HTB)
#define PG8_STAGE(bufoff, gbase, voff) do { _Pragma("unroll") for (int _i = 0; _i < 2; ++_i) \
        __builtin_amdgcn_global_load_lds((const unsigned*)((const char*)(gbase) + (voff)[_i]), (PG8_LAS unsigned*)(lds + (bufoff) + ldsw + _i * 8192), 16, 0, 0); } while (0)
#define PG8_LDA(dst, b, h) do { _Pragma("unroll") for (int m = 0; m < 4; ++m) _Pragma("unroll") for (int k = 0; k < 2; ++k) dst[m][k] = *(const PG8_LAS bf16x8*)(lds + PG8_SA(b, h) + aoff + m * 2048 + k * 1024); } while (0)
#define PG8_LDB(dst, b, h) do { _Pragma("unroll") for (int n = 0; n < 2; ++n) _Pragma("unroll") for (int k = 0; k < 2; ++k) dst[n][k] = *(const PG8_LAS bf16x8*)(lds + PG8_SB(b, h) + boff + n * 2048 + k * 1024); } while (0)
#define PG8_MMA(ai, bj, At, Bt) do { __builtin_amdgcn_s_setprio(1); _Pragma("unroll") for (int m = 0; m < 4; ++m) _Pragma("unroll") for (int n = 0; n < 2; ++n) _Pragma("unroll") for (int k = 0; k < 2; ++k) \
        acc[ai][bj][m][n] = __builtin_amdgcn_mfma_f32_16x16x32_bf16(Bt[n][k], At[m][k], acc[ai][bj][m][n], 0, 0, 0); __builtin_amdgcn_s_setprio(0); } while (0)
#define PG8_WAIT_V(n) asm volatile("s_waitcnt vmcnt(" #n ")" ::: "memory")
#define PG8_WAIT_L(n) asm volatile("s_waitcnt lgkmcnt(" #n ")" ::: "memory")
#define PG8_BAR __builtin_amdgcn_s_barrier()
#define PG8_SCHED __builtin_amdgcn_sched_barrier(0)
    Unit cur, nxt; int ui = 0;
    if (!S.next(0, cur)) return;
    f32x4 acc[2][2][4][2];
#pragma unroll
    for (int a = 0; a < 2; ++a)
#pragma unroll
        for (int b = 0; b < 2; ++b)
#pragma unroll
            for (int m = 0; m < 4; ++m)
#pragma unroll
                for (int n = 0; n < 2; ++n) acc[a][b][m][n] = (f32x4){0.f, 0.f, 0.f, 0.f};
    bf16x8 At[4][2], B0[2][2], B1[2][2];
    const char* cA = (const char*)g.A + (size_t)cur.pm * tstep; const char* cB = (const char*)g.Bt + (size_t)cur.pn * tstep;
    S.a_ready(cur);
    if constexpr (SP2) {
        PG8_STAGE(PG8_SB(0, 0), cB, voffB); PG8_STAGE(PG8_SB(0, 1), cB + hstep, voffB); PG8_STAGE(PG8_SA(0, 0), cA, voffA); PG8_STAGE(PG8_SA(0, 1), cA + hstep, voffA);
        if (wr == 1) PG8_BAR;
        PG8_WAIT_V(2); PG8_BAR;
        PG8_STAGE(PG8_SB(1, 0), cB + kstep, voffB); PG8_STAGE(PG8_SA(1, 0), cA + kstep, voffA); PG8_STAGE(PG8_SB(1, 1), cB + hstep + kstep, voffB);
        PG8_WAIT_V(6); PG8_BAR;
    } else {
        PG8_STAGE(PG8_SB(0, 0), cB, voffB); PG8_STAGE(PG8_SA(0, 0), cA, voffA); PG8_STAGE(PG8_SB(0, 1), cB + hstep, voffB); PG8_STAGE(PG8_SA(0, 1), cA + hstep, voffA);
        if (wr == 1) PG8_BAR;
        PG8_WAIT_V(4); PG8_BAR;
        PG8_STAGE(PG8_SB(1, 0), cB + kstep, voffB); PG8_STAGE(PG8_SA(1, 0), cA + kstep, voffA); PG8_STAGE(PG8_SB(1, 1), cB + hstep + kstep, voffB);
        PG8_WAIT_V(6); PG8_BAR;
    }
    for (;;) {
        const bool has_next = S.next(ui + 1, nxt);
        const char* nA = has_next ? (const char*)g.A + (size_t)nxt.pm * tstep : cA; const char* nB = has_next ? (const char*)g.Bt + (size_t)nxt.pn * tstep : cB;
        for (int t = 0; t < nt; t += 2) {
            const bool last = (t == nt - 2);
            const char* a1 = cA + (size_t)(t + 1) * kstep;
            const char* a2 = last ? nA : cA + (size_t)(t + 2) * kstep; const char* b2 = last ? nB : cB + (size_t)(t + 2) * kstep;
            const char* a3 = a2 + kstep; const char* b3 = b2 + kstep;
            if (last && has_next) S.a_ready(nxt);
            if constexpr (SP2) {
            PG8_LDB(B0, 0, 0); PG8_LDB(B1, 0, 1); PG8_SCHED; PG8_LDA(At, 0, 0); PG8_STAGE(PG8_SA(1, 1), a1 + hstep, voffA);
            PG8_WAIT_V(8); PG8_WAIT_L(0); PG8_BAR; PG8_MMA(0, 0, At, B0); PG8_MMA(0, 1, At, B1); PG8_BAR; PG8_SCHED;
            PG8_LDA(At, 0, 1); PG8_STAGE(PG8_SB(0, 0), b2, voffB); PG8_STAGE(PG8_SB(0, 1), b2 + hstep, voffB); PG8_STAGE(PG8_SA(0, 0), a2, voffA);
            PG8_WAIT_V(8); PG8_WAIT_L(0); PG8_BAR; PG8_MMA(1, 0, At, B0); PG8_MMA(1, 1, At, B1); PG8_BAR; PG8_SCHED;
            PG8_LDB(B0, 1, 0); PG8_LDB(B1, 1, 1); PG8_SCHED; PG8_LDA(At, 1, 0); PG8_STAGE(PG8_SA(0, 1), a2 + hstep, voffA);
            PG8_WAIT_V(8); PG8_WAIT_L(0); PG8_BAR; PG8_MMA(0, 0, At, B0); PG8_MMA(0, 1, At, B1); PG8_BAR; PG8_SCHED;
            PG8_LDA(At, 1, 1); PG8_STAGE(PG8_SB(1, 0), b3, voffB); PG8_STAGE(PG8_SB(1, 1), b3 + hstep, voffB); PG8_STAGE(PG8_SA(1, 0), a3, voffA);
            PG8_WAIT_V(8); PG8_WAIT_L(0); PG8_BAR; PG8_MMA(1, 0, At, B0); PG8_MMA(1, 1, At, B1); PG8_BAR; PG8_SCHED;
            } else {
            PG8_LDB(B0, 0, 0); PG8_SCHED; PG8_LDA(At, 0, 0); PG8_STAGE(PG8_SA(1, 1), a1 + hstep, voffA);
            PG8_WAIT_L(8); PG8_BAR; PG8_WAIT_L(0); PG8_MMA(0, 0, At, B0); PG8_BAR; PG8_SCHED;
            PG8_LDB(B1, 0, 1); PG8_STAGE(PG8_SB(0, 0), b2, voffB);
            PG8_BAR; PG8_WAIT_L(0); PG8_MMA(0, 1, At, B1); PG8_BAR;
            PG8_LDA(At, 0, 1); PG8_STAGE(PG8_SA(0, 0), a2, voffA);
            PG8_BAR; PG8_WAIT_L(0); PG8_MMA(1, 0, At, B0); PG8_BAR; PG8_SCHED;
            PG8_STAGE(PG8_SB(0, 1), b2 + hstep, voffB);
            PG8_WAIT_V(6); PG8_BAR; PG8_MMA(1, 1, At, B1); PG8_BAR;
            PG8_LDB(B0, 1, 0); PG8_SCHED; PG8_LDA(At, 1, 0); PG8_STAGE(PG8_SA(0, 1), a2 + hstep, voffA);
            PG8_WAIT_L(8); PG8_BAR; PG8_WAIT_L(0); PG8_MMA(0, 0, At, B0); PG8_BAR; PG8_SCHED;
            PG8_LDB(B1, 1, 1); PG8_STAGE(PG8_SB(1, 0), b3, voffB);
            PG8_BAR; PG8_WAIT_L(0); PG8_MMA(0, 1, At, B1); PG8_BAR;
            PG8_LDA(At, 1, 1); PG8_STAGE(PG8_SA(1, 0), a3, voffA);
            PG8_BAR; PG8_WAIT_L(0); PG8_MMA(1, 0, At, B0); PG8_BAR; PG8_SCHED;
            PG8_STAGE(PG8_SB(1, 1), b3 + hstep, voffB);
            PG8_WAIT_V(6); PG8_BAR; PG8_MMA(1, 1, At, B1); PG8_BAR;
            }
        }
        if constexpr (ALIGN_EPI) { if (wr == 0) PG8_BAR; }
        if constexpr (!Epi::AFTER_DRAIN) { E(acc, cur, wr, wc, fr, fq); S.done(cur); }
        if (!has_next) break;
#pragma unroll
        for (int a = 0; a < 2; ++a)
#pragma unroll
            for (int b = 0; b < 2; ++b)
#pragma unroll
                for (int m = 0; m < 4; ++m)
#pragma unroll
                    for (int n = 0; n < 2; ++n) acc[a][b][m][n] = (f32x4){0.f, 0.f, 0.f, 0.f};
        cur = nxt; cA = nA; cB = nB; ++ui;
        if constexpr (ALIGN_EPI) { if (wr == 1) PG8_BAR; }
    }
    PG8_WAIT_V(0);
    if constexpr (!ALIGN_EPI) { if (wr == 0) PG8_BAR; }
    PG8_BAR;
    if constexpr (Epi::AFTER_DRAIN) { E.fused(acc, cur, wr, wc, fr, fq, lds, wid, lane); S.done(cur); }
#undef PG8_SA
#undef PG8_SB
#undef PG8_STAGE
#undef PG8_LDA
#undef PG8_LDB
#undef PG8_MMA
#undef PG8_WAIT_V
#undef PG8_WAIT_L
#undef PG8_BAR
#undef PG8_SCHED
}
}
#define LAS __attribute__((address_space(3)))
typedef unsigned short bf16_t;
typedef short bf16x8 __attribute__((ext_vector_type(8)));
typedef short s16x4 __attribute__((ext_vector_type(4)));
typedef float f32x4 __attribute__((ext_vector_type(4)));
typedef unsigned u32x4 __attribute__((ext_vector_type(4)));
typedef unsigned u32x2 __attribute__((ext_vector_type(2)));
using pg8::cvt_pk_bf16; using pg8::fsigmoid; using pg8::bflo; using pg8::bfhi;
#define MFMA16(a, b, c) __builtin_amdgcn_mfma_f32_16x16x32_bf16((a), (b), (c), 0, 0, 0)

constexpr int DM = 1024, NBATCH = 8, SEQ = 2048, MT = NBATCH * SEQ, DFF = 2816, MEML = 256, MM = NBATCH * MEML, DEPTH = 2, INC = 5912;
constexpr int NWAVES = 8, NTHREADS = 512;
constexpr float EPS = 1e-6f, LOG2E = 1.4426950408889634f;
constexpr int PH_PER_LAYER = 17, NPHASES = 1 + DEPTH * PH_PER_LAYER;

enum { I_X = 0, I_MEM, I_FF1_PRE, I_FF1_W1, I_FF1_W3, I_FF1_W2, I_FF1_POST, I_MIX_PRE, I_WIN, I_BIN, I_POOLW, I_POOLS, I_CPK, I_CW1K, I_CW2K, I_CPV, I_CW1V, I_CW2V,
       I_GLNG, I_GLNB, I_GWS, I_GBS, I_WBRP, I_WBRN, I_WBRG, I_WMIX, I_MIX_POST, I_MEM_PRE, I_MEM_KVG, I_WQ, I_WK, I_WV, I_WO, I_MEM_POST, I_FF2_PRE, I_FF2_W1, I_FF2_W3, I_FF2_W2, I_FF2_POST, N_IN };

constexpr size_t MiB = 1u << 20, KiB = 1024;
constexpr size_t WS_W13A = 1 * MiB, WS_W2A = 12 * MiB, WS_W13B = 17 * MiB + 512 * KiB, WS_W2B = 28 * MiB + 512 * KiB, WS_WIN = 34 * MiB, WS_WMG = 40 * MiB,
                 WS_WCOMB = 46 * MiB, WS_WBRN = 47 * MiB, WS_WBRG = 48 * MiB, WS_WMIX = 49 * MiB, WS_WQ = 51 * MiB, WS_WKV = 53 * MiB, WS_WO = 57 * MiB,
                 WS_W1K = 59 * MiB, WS_W1V = 60 * MiB, WS_W2K = 61 * MiB, WS_W2V = 61 * MiB + 32 * KiB, WS_GWS = 61 * MiB + 64 * KiB, WS_BIASIN = 61 * MiB + 192 * KiB,
                 WS_POSB = 61 * MiB + 208 * KiB;
constexpr size_t WS_XN = 62 * MiB, WS_MEMN = 94 * MiB, WS_KVM = 98 * MiB, WS_KC = 106 * MiB, WS_VC = 106 * MiB + 512 * KiB, WS_BIG = 107 * MiB;
constexpr size_t WS_H = WS_BIG, WS_YF = WS_BIG + 88 * MiB;
constexpr size_t WS_ZA = WS_BIG, WS_ZQ = WS_BIG + 16 * MiB, WS_ZKV = WS_BIG + 32 * MiB, WS_ZGM = WS_BIG + 56 * MiB, WS_ZG = WS_BIG + 88 * MiB;
constexpr size_t WS_G = WS_BIG, WS_P = WS_BIG + 96 * MiB, WS_O = WS_BIG + 112 * MiB, WS_U = WS_BIG + 128 * MiB, WS_MRG = WS_BIG + 144 * MiB, WS_YM = WS_BIG;
constexpr size_t WS_QX = WS_BIG, WS_OX = WS_BIG + 32 * MiB;
constexpr size_t WS_VTS = WS_BIG + 176 * MiB, WS_VTW = WS_VTS + 4 * MiB, WS_VTM = WS_VTW + 4 * MiB;
constexpr size_t WS_END = WS_VTM + 4 * MiB;

constexpr int LDS_BYTES = 147456;

struct Args { const float* in[N_IN]; float* out; unsigned char* ws; int ph_lo, ph_hi; };
typedef const unsigned char __attribute__((address_space(4)))* karg_t;
#define AIN(i) (*(const float* const __attribute__((address_space(4)))*)(kp + 8 * (i)))

__device__ __forceinline__ float wave_sum(float v) {
#pragma unroll
    for (int o = 1; o < 64; o <<= 1) v += __shfl_xor(v, o);
    return v;
}
#define LDS_WAIT() asm volatile("s_waitcnt lgkmcnt(0)" ::: "memory")

struct TSeg { const float* W; int K, N, col0, ncols, nvalid; bf16_t* WT; int mode, row0; };
__device__ __forceinline__ void transpose_item(const TSeg& s, LAS float* scr, int item, int lane) {
    const int nblk = s.ncols / 32, kb = item / nblk, nb = item % nblk, k0 = 64 * kb, n0 = 32 * nb;
    const int c4 = (lane & 7) * 4, nl = n0 + c4;
    f32x4 v[8];
#pragma unroll
    for (int i = 0; i < 8; ++i) { const int kk = i * 8 + (lane >> 3);
        v[i] = (nl < s.nvalid) ? *(const f32x4*)(s.W + (size_t)(k0 + kk) * s.N + s.col0 + nl) : (f32x4){0.f, 0.f, 0.f, 0.f}; }
#pragma unroll
    for (int i = 0; i < 8; ++i) { const int kk = i * 8 + (lane >> 3); *(LAS f32x4*)(scr + kk * 36 + c4) = v[i]; }
    LDS_WAIT(); asm volatile("" ::: "memory");
    const int c = lane & 7;
#pragma unroll
    for (int j = 0; j < 4; ++j) { const int nloc = (lane >> 3) + 8 * j, n = n0 + nloc; const LAS float* sp = scr + (8 * c) * 36 + nloc;
        const int drow = s.mode == 0 ? s.row0 + n : (n >> 7) * 256 + (n & 127) + s.row0;
        u32x4 o; o.x = cvt_pk_bf16(sp[0 * 36], sp[1 * 36]); o.y = cvt_pk_bf16(sp[2 * 36], sp[3 * 36]); o.z = cvt_pk_bf16(sp[4 * 36], sp[5 * 36]); o.w = cvt_pk_bf16(sp[6 * 36], sp[7 * 36]);
        *(u32x4*)(s.WT + (size_t)drow * s.K + k0 + 8 * c) = o; }
    LDS_WAIT(); asm volatile("" ::: "memory");
}
constexpr int NSEG = 21;
__device__ __forceinline__ TSeg get_seg(karg_t kp, unsigned char* ws, int l, int seg) {
    TSeg s; s.col0 = 0; s.mode = 0; s.row0 = 0;
#define W(idx, per) (AIN(idx) + (size_t)l * (per))
    switch (seg) {
    case 0: s.W = W(I_FF1_W1, (size_t)DM * DFF); s.K = DM; s.N = DFF; s.ncols = DFF; s.WT = (bf16_t*)(ws + WS_W13A); s.mode = 1; s.row0 = 0; break;
    case 1: s.W = W(I_FF1_W3, (size_t)DM * DFF); s.K = DM; s.N = DFF; s.ncols = DFF; s.WT = (bf16_t*)(ws + WS_W13A); s.mode = 1; s.row0 = 128; break;
    case 2: s.W = W(I_FF1_W2, (size_t)DM * DFF); s.K = DFF; s.N = DM; s.ncols = DM; s.WT = (bf16_t*)(ws + WS_W2A); break;
    case 3: s.W = W(I_FF2_W1, (size_t)DM * DFF); s.K = DM; s.N = DFF; s.ncols = DFF; s.WT = (bf16_t*)(ws + WS_W13B); s.mode = 1; s.row0 = 0; break;
    case 4: s.W = W(I_FF2_W3, (size_t)DM * DFF); s.K = DM; s.N = DFF; s.ncols = DFF; s.WT = (bf16_t*)(ws + WS_W13B); s.mode = 1; s.row0 = 128; break;
    case 5: s.W = W(I_FF2_W2, (size_t)DM * DFF); s.K = DFF; s.N = DM; s.ncols = DM; s.WT = (bf16_t*)(ws + WS_W2B); break;
    case 6: s.W = W(I_WIN, (size_t)DM * INC); s.K = DM; s.N = INC; s.col0 = 0; s.ncols = 1792; s.WT = (bf16_t*)(ws + WS_WIN); s.row0 = 0; break;
    case 7: s.W = W(I_WIN, (size_t)DM * INC); s.K = DM; s.N = INC; s.col0 = 1816; s.ncols = 1024; s.WT = (bf16_t*)(ws + WS_WIN); s.row0 = 1792; break;
    case 8: s.W = W(I_WIN, (size_t)DM * INC); s.K = DM; s.N = INC; s.col0 = 1792; s.ncols = 256; s.WT = (bf16_t*)(ws + WS_WIN); s.row0 = 2816; break;
    case 9: s.W = W(I_WIN, (size_t)DM * INC); s.K = DM; s.N = INC; s.col0 = 2840; s.ncols = 3072; s.WT = (bf16_t*)(ws + WS_WMG); break;
    case 10: s.W = W(I_WBRN, (size_t)512 * DM); s.K = 512; s.N = DM; s.ncols = DM; s.WT = (bf16_t*)(ws + WS_WBRN); break;
    case 11: s.W = W(I_WBRG, (size_t)512 * DM); s.K = 512; s.N = DM; s.ncols = DM; s.WT = (bf16_t*)(ws + WS_WBRG); break;
    case 12: s.W = W(I_WMIX, (size_t)DM * DM); s.K = DM; s.N = DM; s.ncols = DM; s.WT = (bf16_t*)(ws + WS_WMIX); break;
    case 13: s.W = W(I_WQ, (size_t)DM * DM); s.K = DM; s.N = DM; s.ncols = DM; s.WT = (bf16_t*)(ws + WS_WQ); break;
    case 14: s.W = W(I_WK, (size_t)DM * DM); s.K = DM; s.N = DM; s.ncols = DM; s.WT = (bf16_t*)(ws + WS_WKV); s.row0 = 0; break;
    case 15: s.W = W(I_WV, (size_t)DM * DM); s.K = DM; s.N = DM; s.ncols = DM; s.WT = (bf16_t*)(ws + WS_WKV); s.row0 = 1024; break;
    case 16: s.W = W(I_WO, (size_t)DM * DM); s.K = DM; s.N = DM; s.ncols = DM; s.WT = (bf16_t*)(ws + WS_WO); break;
    case 17: s.W = W(I_CW1K, (size_t)2048 * 256); s.K = 2048; s.N = 256; s.ncols = 256; s.WT = (bf16_t*)(ws + WS_W1K); break;
    case 18: s.W = W(I_CW1V, (size_t)2048 * 256); s.K = 2048; s.N = 256; s.ncols = 256; s.WT = (bf16_t*)(ws + WS_W1V); break;
    case 19: s.W = W(I_CW2K, (size_t)256 * 64); s.K = 256; s.N = 64; s.ncols = 64; s.WT = (bf16_t*)(ws + WS_W2K); break;
    default: s.W = W(I_CW2V, (size_t)256 * 64); s.K = 256; s.N = 64; s.ncols = 64; s.WT = (bf16_t*)(ws + WS_W2V); break;
    }
#undef W
    s.nvalid = (seg == 8) ? 24 : s.ncols;
    return s;
}
__device__ __forceinline__ void row_pass(const float* Y, const float* gpost, float coef, const float* xin, float* xout, const float* gnext, bf16_t* XN, int nrows, int gw, int NGW, int lane) {
    for (int m = gw; m < nrows; m += NGW) {
        f32x4 xv[4];
#pragma unroll
        for (int j = 0; j < 4; ++j) xv[j] = *((const f32x4*)(xin + (size_t)m * DM) + lane + 64 * j);
        if (Y) {
            f32x4 yv[4]; float ss = 0.f;
#pragma unroll
            for (int j = 0; j < 4; ++j) { yv[j] = *((const f32x4*)(Y + (size_t)m * DM) + lane + 64 * j); ss += (yv[j].x * yv[j].x + yv[j].y * yv[j].y) + (yv[j].z * yv[j].z + yv[j].w * yv[j].w); }
            const float r = coef / sqrtf(wave_sum(ss) * (1.0f / DM) + EPS);
#pragma unroll
            for (int j = 0; j < 4; ++j) { const f32x4 g = *((const f32x4*)gpost + lane + 64 * j); xv[j] = xv[j] + yv[j] * g * r; }
        }
        if (xout) {
#pragma unroll
            for (int j = 0; j < 4; ++j) *((f32x4*)(xout + (size_t)m * DM) + lane + 64 * j) = xv[j];
        }
        if (gnext) {
            float ss = 0.f;
#pragma unroll
            for (int j = 0; j < 4; ++j) ss += (xv[j].x * xv[j].x + xv[j].y * xv[j].y) + (xv[j].z * xv[j].z + xv[j].w * xv[j].w);
            const float r = 1.0f / sqrtf(wave_sum(ss) * (1.0f / DM) + EPS);
#pragma unroll
            for (int j = 0; j < 4; ++j) { const f32x4 g = *((const f32x4*)gnext + lane + 64 * j); const f32x4 o = xv[j] * g * r;
                u32x2 w; w.x = cvt_pk_bf16(o.x, o.y); w.y = cvt_pk_bf16(o.z, o.w);
                *((u32x2*)(XN + (size_t)m * DM) + lane + 64 * j) = w; }
        }
    }
}
__device__ __forceinline__ void prep_layer(karg_t kp, unsigned char* ws, int l, LAS unsigned char* lds, int gw, int NGW, int wave, int lane, int tid, int G, int bid) {
    LAS float* scr = (LAS float*)(lds + wave * 16384);
#pragma unroll
    for (int seg = 0; seg < NSEG; ++seg) {
        karg_t kq = kp; asm volatile("" : "+s"(kq) :: "memory");
        const TSeg s = get_seg(kq, ws, l, seg);
        const int nitems = (s.K / 64) * (s.ncols / 32);
        for (int it = gw; it < nitems; it += NGW) transpose_item(s, scr, it, lane);
    }
    const int gt = bid * NTHREADS + tid, NGT = G * NTHREADS;
    { const float* pw = AIN(I_POOLW) + (size_t)l * 4 * 128 * 128; const float* psc = AIN(I_POOLS) + (size_t)l * 512; const float* wb = AIN(I_WBRP) + (size_t)l * 512 * DM;
      bf16_t* out = (bf16_t*)(ws + WS_WCOMB);
      for (int o = gt; o < 128 * DM; o += NGT) { const int n = o & (DM - 1), c = o >> 10; float s0 = 0.f, s1 = 0.f, s2 = 0.f, s3 = 0.f;
          const float* pr = pw + (size_t)c * 128;
#pragma unroll 8
          for (int d = 0; d < 128; ++d) {
              s0 += pr[d] * psc[d] * wb[(size_t)d * DM + n];
              s1 += pr[16384 + d] * psc[128 + d] * wb[(size_t)(128 + d) * DM + n];
              s2 += pr[32768 + d] * psc[256 + d] * wb[(size_t)(256 + d) * DM + n];
              s3 += pr[49152 + d] * psc[384 + d] * wb[(size_t)(384 + d) * DM + n]; }
          bf16_t* op = out + (size_t)n * 512 + c;
          op[0] = (bf16_t)(cvt_pk_bf16(s0, 0.f) & 0xffffu); op[128] = (bf16_t)(cvt_pk_bf16(s1, 0.f) & 0xffffu); op[256] = (bf16_t)(cvt_pk_bf16(s2, 0.f) & 0xffffu); op[384] = (bf16_t)(cvt_pk_bf16(s3, 0.f) & 0xffffu); } }
    { const float* gws = AIN(I_GWS) + (size_t)l * 4 * 128 * 128; bf16_t* out = (bf16_t*)(ws + WS_GWS);
      for (int o = gt; o < 4 * 128 * 128; o += NGT) { const int s2 = o & 127, t = (o >> 7) & 127; const float v = (s2 <= t) ? gws[o] : 0.f; out[o] = (bf16_t)(cvt_pk_bf16(v, 0.f) & 0xffffu); } }
    { const float* b = AIN(I_BIN) + (size_t)l * INC; float* out = (float*)(ws + WS_BIASIN);
      for (int o = gt; o < 3072; o += NGT) out[o] = o < 1792 ? b[o] : (o < 2816 ? b[o + 24] : (o < 2840 ? b[1792 + o - 2816] : 0.f)); }
    row_pass(nullptr, nullptr, 0.f, AIN(I_MEM), nullptr, AIN(I_MEM_KVG) + (size_t)l * DM, (bf16_t*)(ws + WS_MEMN), MM, gw, NGW, lane);
}
template <int W> __device__ __forceinline__ void pool_group(const bf16_t* ZA, bf16_t* P, int gi, int gt, int NGT) {
    for (int o = gt; o < MT * 16; o += NGT) {
        const int cc = gi * 16 + (o & 15), m = o >> 4, t = m & (SEQ - 1), cnt = (t + 1 < W) ? t + 1 : W;
        u32x4 v[W];
#pragma unroll
        for (int i = 0; i < W; ++i) v[i] = (i < cnt) ? *(const u32x4*)(ZA + (size_t)(m - i) * 512 + cc * 8) : (u32x4){0u, 0u, 0u, 0u};
        float s[8];
#pragma unroll
        for (int e = 0; e < 8; ++e) s[e] = 0.f;
#pragma unroll
        for (int i = 0; i < W; ++i) { s[0] += bflo(v[i].x); s[1] += bfhi(v[i].x); s[2] += bflo(v[i].y); s[3] += bfhi(v[i].y); s[4] += bflo(v[i].z); s[5] += bfhi(v[i].z); s[6] += bflo(v[i].w); s[7] += bfhi(v[i].w); }
        const float inv = 1.0f / (float)cnt; const u32x4 self = v[0];
        u32x4 r; r.x = cvt_pk_bf16(s[0] * inv - bflo(self.x), s[1] * inv - bfhi(self.x)); r.y = cvt_pk_bf16(s[2] * inv - bflo(self.y), s[3] * inv - bfhi(self.y));
        r.z = cvt_pk_bf16(s[4] * inv - bflo(self.z), s[5] * inv - bfhi(self.z)); r.w = cvt_pk_bf16(s[6] * inv - bflo(self.w), s[7] * inv - bfhi(self.w));
        *(u32x4*)(P + (size_t)m * 512 + cc * 8) = r;
    }
}
__device__ __forceinline__ void pool_pass(const bf16_t* ZA, bf16_t* P, int gt, int NGT) {
    pool_group<2>(ZA, P, 0, gt, NGT); pool_group<4>(ZA, P, 1, gt, NGT); pool_group<8>(ZA, P, 2, gt, NGT); pool_group<16>(ZA, P, 3, gt, NGT);
}
__device__ __forceinline__ void compress_unit(int unit, const bf16_t* ZKV, const bf16_t* W1t_k, const bf16_t* W1t_v, const bf16_t* W2t_k, const bf16_t* W2t_v, const float* pos_k, const float* pos_v,
                                              bf16_t* KC, bf16_t* VC, LAS unsigned char* lds, int wave, int lane) {
    const int which = unit & 1, nc = (unit >> 1) & 7, g = (unit >> 4) & 1, b = unit >> 5;
    const int r16 = lane & 15, quad = lane >> 4;
    const bf16_t* W1t = which ? W1t_v : W1t_k; const bf16_t* W2t = which ? W2t_v : W2t_k;
    const int n = nc * 16 + r16, ne = n < 127 ? n : 126;
    const bf16_t* arow = ZKV + ((size_t)b * SEQ + 16 * ne) * 768 + which * 128 + g * 64 + quad * 8;
    const bf16_t* b0 = W1t + (size_t)(wave * 32 + r16) * 2048 + quad * 8; const bf16_t* b1 = b0 + (size_t)16 * 2048;
    f32x4 acc0 = (f32x4){0.f, 0.f, 0.f, 0.f}, acc1 = acc0;
    const float* pos = (which ? pos_v : pos_k) + quad * 8;
#pragma unroll 8
    for (int ks = 0; ks < 64; ++ks) {
        const u32x4 ar = *(const u32x4*)(arow + (size_t)(ks >> 1) * 768 + (ks & 1) * 32);
        const f32x4 p0 = *(const f32x4*)(pos + ks * 32), p1 = *(const f32x4*)(pos + ks * 32 + 4);
        const bf16x8 bf0 = *(const bf16x8*)(b0 + ks * 32), bf1 = *(const bf16x8*)(b1 + ks * 32);
        u32x4 aw; aw.x = cvt_pk_bf16(bflo(ar.x) + p0.x, bfhi(ar.x) + p0.y); aw.y = cvt_pk_bf16(bflo(ar.y) + p0.z, bfhi(ar.y) + p0.w);
        aw.z = cvt_pk_bf16(bflo(ar.z) + p1.x, bfhi(ar.z) + p1.y); aw.w = cvt_pk_bf16(bflo(ar.w) + p1.z, bfhi(ar.w) + p1.w);
        const bf16x8 af = __builtin_bit_cast(bf16x8, aw);
        acc0 = MFMA16(af, bf0, acc0); acc1 = MFMA16(af, bf1, acc1);
    }
    LAS bf16_t* Hs = (LAS bf16_t*)lds;
    {
#pragma unroll
      for (int i = 0; i < 4; ++i) { const int row = quad * 4 + i;
          Hs[row * 264 + wave * 32 + r16] = (bf16_t)(cvt_pk_bf16(pg8::fgelu_tanh(acc0[i]), 0.f) & 0xffffu);
          Hs[row * 264 + wave * 32 + 16 + r16] = (bf16_t)(cvt_pk_bf16(pg8::fgelu_tanh(acc1[i]), 0.f) & 0xffffu); } }
    __syncthreads();
    if (wave < 4) {
        f32x4 acc = (f32x4){0.f, 0.f, 0.f, 0.f};
#pragma unroll
        for (int ks = 0; ks < 8; ++ks) {
            const bf16x8 af = *(const LAS bf16x8*)(Hs + r16 * 264 + ks * 32 + quad * 8);
            const bf16x8 bfr = *(const bf16x8*)(W2t + (size_t)(wave * 16 + r16) * 256 + ks * 32 + quad * 8);
            acc = MFMA16(af, bfr, acc);
        }
        f32x4 v = acc;
#pragma unroll
        for (int i = 0; i < 4; ++i) if (nc * 16 + quad * 4 + i >= 127) v[i] = 0.f;
        if (which) {
            u32x2 w; w.x = cvt_pk_bf16(v[0], v[1]); w.y = cvt_pk_bf16(v[2], v[3]);
            *(u32x2*)(VC + ((size_t)(b * 2 + g) * 64 + wave * 16 + r16) * 128 + nc * 16 + quad * 4) = w;
        } else {
            bf16_t* out = KC + ((size_t)(b * 2 + g) * 128 + nc * 16) * 64 + wave * 16 + r16;
#pragma unroll
            for (int i = 0; i < 4; ++i) out[(size_t)(quad * 4 + i) * 64] = (bf16_t)(cvt_pk_bf16(v[i], 0.f) & 0xffffu);
        }
    }
    __syncthreads();
}
__device__ __forceinline__ void gmlp_unit(int unit, const bf16_t* ZGM, const bf16_t* Wg, const float* lng, const float* lnb, const float* bs, bf16_t* U, LAS unsigned char* lds, int wave, int lane, int tid) {
    const int gq = unit & 3, c = unit >> 2, m0 = c * 128;
    LAS bf16_t* Vt = (LAS bf16_t*)lds;
    LAS float* st = (LAS float*)(lds + 128 * 136 * 2);
#pragma unroll
    for (int i = 0; i < 16; ++i) { const int tok = wave * 16 + i;
        const u32x4 v = *(const u32x4*)(ZGM + (size_t)(m0 + tok) * 1024 + 512 + lane * 8);
        float f[8] = {bflo(v.x), bfhi(v.x), bflo(v.y), bfhi(v.y), bflo(v.z), bfhi(v.z), bflo(v.w), bfhi(v.w)};
        float s = 0.f;
#pragma unroll
        for (int j = 0; j < 8; ++j) s += f[j];
        const float mean = wave_sum(s) * (1.0f / 512.f); float q = 0.f;
#pragma unroll
        for (int j = 0; j < 8; ++j) { const float d = f[j] - mean; q += d * d; }
        const float rstd = 1.0f / sqrtf(wave_sum(q) * (1.0f / 512.f) + EPS);
        if (lane == 0) { st[tok * 2] = mean; st[tok * 2 + 1] = rstd; } }
    __syncthreads();
    { const int tok = tid >> 2, part = tid & 3; const float mean = st[tok * 2], rstd = st[tok * 2 + 1];
#pragma unroll
      for (int q4 = 0; q4 < 4; ++q4) { const int d0 = part * 32 + q4 * 8, ch = gq * 128 + d0;
          const u32x4 v = *(const u32x4*)(ZGM + (size_t)(m0 + tok) * 1024 + 512 + ch);
          const f32x4 g0 = *(const f32x4*)(lng + ch), g1 = *(const f32x4*)(lng + ch + 4), b0 = *(const f32x4*)(lnb + ch), b1 = *(const f32x4*)(lnb + ch + 4);
          float f[8] = {bflo(v.x), bfhi(v.x), bflo(v.y), bfhi(v.y), bflo(v.z), bfhi(v.z), bflo(v.w), bfhi(v.w)};
          float gg[8] = {g0.x, g0.y, g0.z, g0.w, g1.x, g1.y, g1.z, g1.w}, bb[8] = {b0.x, b0.y, b0.z, b0.w, b1.x, b1.y, b1.z, b1.w};
#pragma unroll
          for (int j = 0; j < 8; ++j) Vt[(d0 + j) * 136 + tok] = (bf16_t)(cvt_pk_bf16((f[j] - mean) * rstd * gg[j] + bb[j], 0.f) & 0xffffu); } }
    __syncthreads();
    { const int r16 = lane & 15, quad = lane >> 4, t = wave * 16 + r16;
      f32x4 acc[8];
#pragma unroll
      for (int dt = 0; dt < 8; ++dt) acc[dt] = (f32x4){0.f, 0.f, 0.f, 0.f};
      const int nks = (wave * 16 + 15) / 32 + 1;
      for (int ks = 0; ks < nks; ++ks) {
          const bf16x8 bfr = *(const bf16x8*)(Wg + ((size_t)gq * 128 + t) * 128 + ks * 32 + quad * 8);
#pragma unroll
          for (int dt = 0; dt < 8; ++dt) { const bf16x8 af = *(const LAS bf16x8*)(Vt + (dt * 16 + r16) * 136 + ks * 32 + quad * 8); acc[dt] = MFMA16(af, bfr, acc[dt]); }
      }
      const float bias = bs[gq * 128 + t];
#pragma unroll
      for (int dt = 0; dt < 8; ++dt) { const int d = gq * 128 + dt * 16 + quad * 4;
          const u32x2 uu = *(const u32x2*)(ZGM + (size_t)(m0 + t) * 1024 + d);
          u32x2 w; w.x = cvt_pk_bf16(bflo(uu.x) * (acc[dt][0] + bias), bfhi(uu.x) * (acc[dt][1] + bias)); w.y = cvt_pk_bf16(bflo(uu.y) * (acc[dt][2] + bias), bfhi(uu.y) * (acc[dt][3] + bias));
          *(u32x2*)(U + (size_t)(m0 + t) * 512 + d) = w; } }
    __syncthreads();
}
template <int D> struct KVRegs { u32x4 k[D / 64], v[D / 64]; };
template <int D> __device__ __forceinline__ void kv_load(KVRegs<D>& R, const bf16_t* Kg, int ldk, const bf16_t* Vg, int ldv, int tid) {
#pragma unroll
    for (int i = 0; i < D / 64; ++i) { const int c = tid + i * NTHREADS;
        { const int r = c / (D / 8), cc = c % (D / 8); R.k[i] = *(const u32x4*)(Kg + (size_t)r * ldk + cc * 8); }
        { const int d = c >> 3, cc = c & 7; R.v[i] = *(const u32x4*)(Vg + (size_t)d * ldv + cc * 8); } }
}
template <int D> __device__ __forceinline__ void kv_store(const KVRegs<D>& R, LAS bf16_t* Ks, LAS bf16_t* Vt, int tid) {
#pragma unroll
    for (int i = 0; i < D / 64; ++i) { const int c = tid + i * NTHREADS;
        { const int r = c / (D / 8), cc = c % (D / 8); *(LAS u32x4*)(Ks + r * (D + 8) + cc * 8) = R.k[i]; }
        { const int d = c >> 3, cc = c & 7; *(LAS u32x4*)(Vt + d * 72 + cc * 8) = R.v[i]; } }
}
template <int D, int QS, class MaskF>
__device__ __forceinline__ void flash_block(const LAS bf16_t* Ks, const LAS bf16_t* Vt, const bf16x8 (&qf)[QS][D / 32], f32x4 (&acc)[QS][D / 16], float (&mrun)[QS], float (&lrun)[QS], const MaskF& allowed, int lane) {
    const int r16 = lane & 15, quad = lane >> 4;
#pragma unroll
    for (int qs = 0; qs < QS; ++qs) {
        f32x4 s[4];
#pragma unroll
        for (int kt = 0; kt < 4; ++kt) { s[kt] = (f32x4){0.f, 0.f, 0.f, 0.f};
#pragma unroll
            for (int ks = 0; ks < D / 32; ++ks) { const bf16x8 kf = *(const LAS bf16x8*)(Ks + (kt * 16 + r16) * (D + 8) + ks * 32 + quad * 8); s[kt] = MFMA16(kf, qf[qs][ks], s[kt]); } }
        float mx = -1e30f;
#pragma unroll
        for (int kt = 0; kt < 4; ++kt)
#pragma unroll
            for (int i = 0; i < 4; ++i) { const bool ok = allowed(qs, kt * 16 + quad * 4 + i); const float v = ok ? s[kt][i] * LOG2E : -1e30f; s[kt][i] = v; mx = fmaxf(mx, v); }
        mx = fmaxf(mx, __shfl_xor(mx, 16)); mx = fmaxf(mx, __shfl_xor(mx, 32));
        const float mnew = fmaxf(mrun[qs], mx), alpha = __builtin_amdgcn_exp2f(mrun[qs] - mnew); mrun[qs] = mnew;
        float ps = 0.f;
#pragma unroll
        for (int kt = 0; kt < 4; ++kt)
#pragma unroll
            for (int i = 0; i < 4; ++i) { const float p = (s[kt][i] > -1e29f) ? __builtin_amdgcn_exp2f(s[kt][i] - mnew) : 0.f; s[kt][i] = p; ps += p; }
        ps += __shfl_xor(ps, 16); ps += __shfl_xor(ps, 32);
        lrun[qs] = lrun[qs] * alpha + ps;
        bf16x8 pf[2];
#pragma unroll
        for (int kk = 0; kk < 2; ++kk) { u32x4 w; w.x = cvt_pk_bf16(s[2 * kk][0], s[2 * kk][1]); w.y = cvt_pk_bf16(s[2 * kk][2], s[2 * kk][3]); w.z = cvt_pk_bf16(s[2 * kk + 1][0], s[2 * kk + 1][1]); w.w = cvt_pk_bf16(s[2 * kk + 1][2], s[2 * kk + 1][3]);
            pf[kk] = __builtin_bit_cast(bf16x8, w); }
#pragma unroll
        for (int dt = 0; dt < D / 16; ++dt) { acc[qs][dt] = acc[qs][dt] * alpha;
#pragma unroll
            for (int kk = 0; kk < 2; ++kk) { const LAS bf16_t* vp = Vt + (dt * 16 + r16) * 72 + kk * 32 + quad * 4;
                const s16x4 lo = *(const LAS s16x4*)vp, hi = *(const LAS s16x4*)(vp + 16);
                const bf16x8 vf = __builtin_shufflevector(lo, hi, 0, 1, 2, 3, 4, 5, 6, 7);
                acc[qs][dt] = MFMA16(vf, pf[kk], acc[qs][dt]); } }
    }
}
constexpr int NSA_KS = 0, NSA_VT = 18432, NSA_IMP = NSA_VT + 17408, NSA_SEL = NSA_IMP + 32768, NSA_UNI = NSA_SEL + 256;
__device__ __forceinline__ void nsa_unit(int unit, const bf16_t* ZQ, const bf16_t* ZKV, const bf16_t* ZG, const bf16_t* KC, const bf16_t* VCT, const bf16_t* VTS, const bf16_t* VTW, bf16_t* O,
                                         LAS unsigned char* lds, int wave, int lane, int tid) {
    const int qb = unit & 63, g = (unit >> 6) & 1, b = unit >> 7, cur = qb >> 1;
    const int r16 = lane & 15, quad = lane >> 4, hh = wave & 3, h = g * 4 + hh, t0 = qb * 32;
    LAS bf16_t* Ks = (LAS bf16_t*)(lds + NSA_KS); LAS bf16_t* Vt = (LAS bf16_t*)(lds + NSA_VT);
    LAS float* impS = (LAS float*)(lds + NSA_IMP); LAS unsigned* selS = (LAS unsigned*)(lds + NSA_SEL); LAS unsigned* uniS = (LAS unsigned*)(lds + NSA_UNI);
    const int tok = (wave >> 2) * 16 + r16, tq = t0 + tok;
    const size_t row = (size_t)b * SEQ + tq;
    bf16x8 qf[1][2]; float gate[3];
#pragma unroll
    for (int ks = 0; ks < 2; ++ks) qf[0][ks] = *(const bf16x8*)(ZQ + row * 512 + h * 64 + ks * 32 + quad * 8);
#pragma unroll
    for (int c = 0; c < 3; ++c) gate[c] = fsigmoid(__uint_as_float((unsigned)ZG[row * 32 + h * 3 + c] << 16));
    const bf16_t* Kslc = ZKV + ((size_t)b * SEQ) * 768 + 2 * 128 + g * 64; const bf16_t* Kwin = Kslc + 2 * 128;
    const bf16_t* Vslc = VTS + (size_t)(b * 2 + g) * 64 * 2048; const bf16_t* Vwin = VTW + (size_t)(b * 2 + g) * 64 * 2048;
    KVRegs<64> R, R1;
    kv_load<64>(R, Kslc, 768, Vslc, 2048, tid);
    f32x4 outv[4];
    { const bf16_t* Kg = KC + (size_t)(b * 2 + g) * 128 * 64; const bf16_t* Vg = VCT + (size_t)(b * 2 + g) * 64 * 128;
#pragma unroll
      for (int i = 0; i < 2; ++i) { const int c = tid + i * NTHREADS;
          { const int r = c >> 3, cc = c & 7; *(LAS u32x4*)(Ks + r * 72 + cc * 8) = *(const u32x4*)(Kg + r * 64 + cc * 8); }
          { const int d = c >> 4, cc = c & 15; *(LAS u32x4*)(Vt + d * 136 + cc * 8) = *(const u32x4*)(Vg + d * 128 + cc * 8); } }
      if (tid == 0) uniS[0] = 0u;
      __syncthreads();
      {
          f32x4 s[8]; float mx = -1e30f;
#pragma unroll
          for (int kt = 0; kt < 8; ++kt) { s[kt] = (f32x4){0.f, 0.f, 0.f, 0.f};
#pragma unroll
              for (int ks = 0; ks < 2; ++ks) { const bf16x8 kf = *(const LAS bf16x8*)(Ks + (kt * 16 + r16) * 72 + ks * 32 + quad * 8); s[kt] = MFMA16(kf, qf[0][ks], s[kt]); }
#pragma unroll
              for (int i = 0; i < 4; ++i) { const int n = kt * 16 + quad * 4 + i; const bool ok = (n < 127) && (16 * n + 31 <= tq); const float v = ok ? s[kt][i] * LOG2E : -1e30f; s[kt][i] = v; mx = fmaxf(mx, v); } }
          mx = fmaxf(mx, __shfl_xor(mx, 16)); mx = fmaxf(mx, __shfl_xor(mx, 32));
          float ps = 0.f;
#pragma unroll
          for (int kt = 0; kt < 8; ++kt)
#pragma unroll
              for (int i = 0; i < 4; ++i) { const float p = (s[kt][i] > -1e29f) ? __builtin_amdgcn_exp2f(s[kt][i] - mx) : 0.f; s[kt][i] = p; ps += p; }
          ps += __shfl_xor(ps, 16); ps += __shfl_xor(ps, 32);
          const float inv = ps > 0.f ? 1.0f / ps : 0.f;
          float so_prev = 0.f; const int src = (lane - 16) & 63;
#pragma unroll
          for (int kt = 0; kt < 8; ++kt) { s[kt] = s[kt] * inv;
              const float so = 0.5f * s[kt][3]; const float a1 = __shfl(so, src), a2 = __shfl(so_prev, src);
              const float v = (s[kt][0] + s[kt][1]) + (s[kt][2] + so) + (quad > 0 ? a1 : a2);
              impS[(hh * 32 + tok) * 32 + kt * 4 + quad] = v; so_prev = so; }
          f32x4 acc[4];
#pragma unroll
          for (int dt = 0; dt < 4; ++dt) acc[dt] = (f32x4){0.f, 0.f, 0.f, 0.f};
#pragma unroll
          for (int kk = 0; kk < 4; ++kk) { u32x4 w; w.x = cvt_pk_bf16(s[2 * kk][0], s[2 * kk][1]); w.y = cvt_pk_bf16(s[2 * kk][2], s[2 * kk][3]); w.z = cvt_pk_bf16(s[2 * kk + 1][0], s[2 * kk + 1][1]); w.w = cvt_pk_bf16(s[2 * kk + 1][2], s[2 * kk + 1][3]);
              const bf16x8 pf = __builtin_bit_cast(bf16x8, w);
#pragma unroll
              for (int dt = 0; dt < 4; ++dt) { const LAS bf16_t* vp = Vt + (dt * 16 + r16) * 136 + kk * 32 + quad * 4;
                  const s16x4 lo = *(const LAS s16x4*)vp, hi = *(const LAS s16x4*)(vp + 16);
                  acc[dt] = MFMA16(__builtin_shufflevector(lo, hi, 0, 1, 2, 3, 4, 5, 6, 7), pf, acc[dt]); } }
#pragma unroll
          for (int dt = 0; dt < 4; ++dt) outv[dt] = acc[dt] * gate[0];
      }
      __syncthreads();
#pragma unroll 1
      for (int pass = 0; pass < 2; ++pass) {
          const int tk = wave * 4 + pass * 2 + (lane >> 5), j = lane & 31;
          const float imp = (impS[tk * 32 + j] + impS[(32 + tk) * 32 + j]) + (impS[(64 + tk) * 32 + j] + impS[(96 + tk) * 32 + j]);
          const bool forced = (j == 0) || (j == cur) || (j == cur - 1);
          unsigned sel = 1u | (1u << cur) | (cur > 0 ? (1u << (cur - 1)) : 0u);
          unsigned key = forced ? 0u : ((j <= cur ? (0x80000000u | (__float_as_uint(imp) & 0x7fffffe0u)) : 0u) | (unsigned)(31 - j));
          const int nr = 8 - __builtin_popcount(sel);
#pragma unroll 1
          for (int rnd = 0; rnd < nr; ++rnd) { unsigned bk = key;
#pragma unroll
              for (int off = 16; off >= 1; off >>= 1) { const unsigned ok = (unsigned)__shfl_xor((int)bk, off); bk = ok > bk ? ok : bk; }
              const int bj = 31 - (int)(bk & 31u);
              sel |= 1u << bj; if (j == bj) key = 0u; }
          if (j == 0) { selS[tk] = sel; atomicOr((unsigned*)uniS, sel); } }
      __syncthreads();
    }
    const unsigned selm = selS[tok];
    unsigned todo = (unsigned)__builtin_amdgcn_readfirstlane((int)uniS[0]) & ((2u << cur) - 1u) & ~1u;
    int jwn = (cur > 4 ? cur - 4 : 0);
    f32x4 acc[1][4]; float mrun[1], lrun[1];
#define NSA_RESET() do { mrun[0] = -1e30f; lrun[0] = 0.f; _Pragma("unroll") for (int dt = 0; dt < 4; ++dt) acc[0][dt] = (f32x4){0.f, 0.f, 0.f, 0.f}; } while (0)
#define NSA_ACCUM(c) do { const float f = (lrun[0] > 0.f ? 1.0f / lrun[0] : 0.f) * gate[c]; _Pragma("unroll") for (int dt = 0; dt < 4; ++dt) outv[dt] = outv[dt] + acc[0][dt] * f; } while (0)
#define NSA_NEXT(jv, wv) do { if (todo) { jv = __builtin_ctz(todo); todo &= todo - 1u; wv = 0; } else if (jwn <= cur) { jv = jwn++; wv = 1; } else { jv = -1; wv = 1; } } while (0)
#define NSA_LOAD(RR, jv, wv) kv_load<64>(RR, ((wv) ? Kwin : Kslc) + (size_t)(jv) * 64 * 768, 768, ((wv) ? Vwin : Vslc) + (jv) * 64, 2048, tid)
    int j0 = 0, w0 = 0, j1, w1;
    NSA_NEXT(j1, w1); NSA_LOAD(R1, j1, w1);
    NSA_RESET(); bool in_win = false;
#define NSA_STEP(RS) do { \
        if (w0 && !in_win) { NSA_ACCUM(1); NSA_RESET(); in_win = true; } \
        kv_store<64>(RS, Ks, Vt, tid); \
        __syncthreads(); \
        int j2, w2; NSA_NEXT(j2, w2); \
        if (j2 >= 0) NSA_LOAD(RS, j2, w2); \
        { const int jj = j0; const bool ww = (w0 != 0); \
          auto mask = [=](int, int kl) { const int kp = jj * 64 + kl; return (kp <= tq) && (ww ? (kp + 256 > tq) : (((selm >> jj) & 1u) != 0u)); }; \
          flash_block<64, 1>(Ks, Vt, qf, acc, mrun, lrun, mask, lane); } \
        __syncthreads(); \
        j0 = j1; w0 = w1; j1 = j2; w1 = w2; } while (0)
#pragma unroll 1
    for (;;) { NSA_STEP(R); if (j0 < 0) break; NSA_STEP(R1); if (j0 < 0) break; }
#undef NSA_STEP
    NSA_ACCUM(2);
#undef NSA_RESET
#undef NSA_ACCUM
#undef NSA_NEXT
#undef NSA_LOAD
#pragma unroll
    for (int dt = 0; dt < 4; ++dt) { u32x2 w; w.x = cvt_pk_bf16(outv[dt][0], outv[dt][1]); w.y = cvt_pk_bf16(outv[dt][2], outv[dt][3]);
        *(u32x2*)(O + row * 512 + h * 64 + dt * 16 + quad * 4) = w; }
}
__device__ __forceinline__ void cross_unit(int unit, const bf16_t* QX, const bf16_t* KM, const bf16_t* VTM, bf16_t* OX, LAS unsigned char* lds, int wave, int lane, int tid) {
    const int qblk = unit & 15, hd = (unit >> 4) & 3, b = unit >> 6;
    const int r16 = lane & 15, quad = lane >> 4;
    LAS bf16_t* Ks = (LAS bf16_t*)lds; LAS bf16_t* Vt = (LAS bf16_t*)(lds + 64 * 264 * 2);
    const size_t row = (size_t)b * SEQ + qblk * 128 + wave * 16 + r16;
    const bf16_t* Kg = KM + ((size_t)b * MEML) * 2048 + hd * 256; const bf16_t* Vg = VTM + (size_t)(b * 4 + hd) * 256 * 256;
    KVRegs<256> R;
    kv_load<256>(R, Kg, 2048, Vg, 256, tid);
    bf16x8 qf[1][8];
#pragma unroll
    for (int ks = 0; ks < 8; ++ks) qf[0][ks] = *(const bf16x8*)(QX + row * DM + hd * 256 + ks * 32 + quad * 8);
    f32x4 acc[1][16]; float mrun[1] = {-1e30f}, lrun[1] = {0.f};
#pragma unroll
    for (int dt = 0; dt < 16; ++dt) acc[0][dt] = (f32x4){0.f, 0.f, 0.f, 0.f};
#pragma unroll 1
    for (int j = 0; j < 4; ++j) {
        kv_store<256>(R, Ks, Vt, tid);
        __syncthreads();
        if (j < 3) kv_load<256>(R, Kg + (size_t)(j + 1) * 64 * 2048, 2048, Vg + (j + 1) * 64, 256, tid);
        auto mask = [](int, int) { return true; };
        flash_block<256, 1>(Ks, Vt, qf, acc, mrun, lrun, mask, lane);
        __syncthreads();
    }
    const float inv = 1.0f / lrun[0];
#pragma unroll
    for (int dt = 0; dt < 16; ++dt) { const f32x4 o = acc[0][dt] * inv; u32x2 w; w.x = cvt_pk_bf16(o[0], o[1]); w.y = cvt_pk_bf16(o[2], o[3]);
        *(u32x2*)(OX + row * DM + hd * 256 + dt * 16 + quad * 4) = w; }
}
#define RLX_AGENT __ATOMIC_RELAXED, __HIP_MEMORY_SCOPE_AGENT
#define XB_TMO      128
#define XB_XCNT(j)  (256  + 64 * (j))
#define XB_XSUB(j)  (1280 + 64 * (j))
#define XB_XGEN(j)  (2304 + 64 * (j))
#define XB_TOP      3328
#define XB_TOPGEN   3392
#define XCD_BAR_WORDS 3456
#define XB_SPIN_CAP (1u << 18)

__device__ __forceinline__ unsigned xb_ld(unsigned* p)              { return __hip_atomic_load(p, __ATOMIC_RELAXED, __HIP_MEMORY_SCOPE_AGENT); }
__device__ __forceinline__ unsigned xb_add(unsigned* p, unsigned v) { return __hip_atomic_fetch_add(p, v, __ATOMIC_RELAXED, __HIP_MEMORY_SCOPE_AGENT); }
__device__ __forceinline__ unsigned xb_xcc_id() { return (unsigned)__builtin_amdgcn_s_getreg((3 << 11) | 20) & 0xFu; }
#define XB_SPIN(cond, bar) do { unsigned _sp = 0; while (cond) { __builtin_amdgcn_s_sleep(1); \
    if ((++_sp & 255u) == 0u) { if (xb_ld(&(bar)[XB_TMO])) break; if (_sp > XB_SPIN_CAP) { atomicAdd(&(bar)[XB_TMO], 1u); break; } } } } while (0)

struct XcdBarrier {
    unsigned* bar; unsigned x;
    volatile LAS unsigned* st;
};

__device__ __forceinline__ XcdBarrier xcd_barrier_post(unsigned* bar, volatile LAS unsigned* st) {
    XcdBarrier b; b.bar = bar; b.x = xb_xcc_id(); b.st = st;
    if (threadIdx.x == 0) (void)xb_add(&bar[XB_XCNT(b.x)], 1u);
    return b;
}
__device__ __forceinline__ void xcd_barrier_complete(unsigned* bar, unsigned x, unsigned& nloc, unsigned& nx) {
    const unsigned G = gridDim.x * gridDim.y * gridDim.z;
    unsigned sum, cnt, mine, sp = 0u;
    for (;;) {
        sum = 0u; cnt = 0u; mine = 0u;
#pragma unroll
        for (unsigned j = 0; j < 16; ++j) { const unsigned c = xb_ld(&bar[XB_XCNT(j)]); sum += c; cnt += (c > 0u) ? 1u : 0u; mine = (j == x) ? c : mine; }
        if (sum == G) break;
        __builtin_amdgcn_s_sleep(1);
        if ((++sp & 255u) == 0u) { if (xb_ld(&bar[XB_TMO])) break; if (sp > XB_SPIN_CAP) { atomicAdd(&bar[XB_TMO], 1u); break; } }
    }
    nloc = mine > 0u ? mine : 1u; nx = cnt > 0u ? cnt : 1u;
}

__device__ __forceinline__ void xcd_barrier(const XcdBarrier& b) {
    asm volatile("s_waitcnt vmcnt(0)" ::: "memory");
    __syncthreads();
    if (threadIdx.x == 0) {
        unsigned* bar = b.bar;
        __builtin_amdgcn_s_waitcnt(0);
        unsigned nloc = b.st[0], nx = b.st[1];
        if (nloc == 0u) { xcd_barrier_complete(bar, b.x, nloc, nx); b.st[0] = nloc; b.st[1] = nx; }
        const unsigned old = xb_add(&bar[XB_XSUB(b.x)], 1u);
        const unsigned gen = old / nloc;
        if (old + 1u == (gen + 1u) * nloc) {
            __builtin_amdgcn_fence(__ATOMIC_RELEASE, "agent");
            asm volatile("s_waitcnt vmcnt(0)" ::: "memory");
            const unsigned og = xb_add(&bar[XB_TOP], 1u);
            const unsigned tg = og / nx;
            if (og + 1u == (tg + 1u) * nx) xb_add(&bar[XB_TOPGEN], 1u);
            else XB_SPIN(xb_ld(&bar[XB_TOPGEN]) == tg, bar);
            __builtin_amdgcn_fence(__ATOMIC_ACQUIRE, "agent");
            xb_add(&bar[XB_XGEN(b.x)], 1u);
            asm volatile("s_waitcnt vmcnt(0)" ::: "memory");
        } else {
            XB_SPIN(xb_ld(&bar[XB_XGEN(b.x)]) == gen, bar);
            __builtin_amdgcn_fence(__ATOMIC_ACQUIRE, "agent");
            asm volatile("s_waitcnt vmcnt(0)" ::: "memory");
        }
    }
    __syncthreads();
}


template <class Epi> __device__ __forceinline__ void run_gemm(LAS unsigned char* lds, const bf16_t* A, const bf16_t* Bt, int M, int N, int K, int G, int c, const Epi& E) {
    asm volatile("" : "+s"(K), "+s"(N), "+s"(M));
    pg8::Gemm g{A, Bt, M, N, K}; pg8::StaticOrder S; S.init(M, N, G, c);
    pg8::gemm_phase<Epi, pg8::StaticOrder, true, true>(lds, g, S, E);
}
__global__ void __launch_bounds__(NTHREADS, 2) hybrid_fwd(Args args) {
    extern __shared__ __attribute__((aligned(16))) unsigned char lds_raw[];
    LAS unsigned char* lds = (LAS unsigned char*)lds_raw;
    bool rep_done = false; bool first = true; int nsync = 0;
    volatile LAS unsigned* bar_st = (volatile LAS unsigned*)(lds + (LDS_BYTES - 64));
    if (threadIdx.x < 16) bar_st[threadIdx.x] = 0u;
    __syncthreads();
    XcdBarrier xbar; xbar.bar = nullptr; xbar.x = 0; xbar.st = nullptr;
    for (int ph = args.ph_lo; ph < args.ph_hi; ) {
        int G = gridDim.x, bid = blockIdx.x; asm volatile("" : "+s"(G), "+s"(bid));
        int tid = threadIdx.x; asm volatile("" : "+v"(tid));
        const int lane = tid & 63, wave = __builtin_amdgcn_readfirstlane(tid >> 6);
        const int gw = bid * NWAVES + wave, NGW = G * NWAVES, gt = bid * NTHREADS + tid, NGT = G * NTHREADS;
        karg_t kp = (karg_t)__builtin_amdgcn_kernarg_segment_ptr(); asm volatile("" : "+s"(kp));
        unsigned char* ws = *(unsigned char* const __attribute__((address_space(4)))*)(kp + 8 * (N_IN + 1));
        float* X = *(float* const __attribute__((address_space(4)))*)(kp + 8 * N_IN); bf16_t* XN = (bf16_t*)(ws + WS_XN);
        if (!first) {
            asm volatile("s_waitcnt vmcnt(0)" ::: "memory");
            if (nsync == 0) { cg::this_grid().sync(); xbar = xcd_barrier_post((unsigned*)(*(unsigned char* const __attribute__((address_space(4)))*)((karg_t)__builtin_amdgcn_kernarg_segment_ptr() + 8 * (N_IN + 1))), bar_st); }
            else xcd_barrier(xbar);
            ++nsync; }
        first = false;
        const int l = ph == 0 ? 0 : (ph - 1) / PH_PER_LAYER, k = ph == 0 ? -1 : (ph - 1) % PH_PER_LAYER;
#define LP(idx, per) (AIN(idx) + (size_t)l * (per))
#ifndef PHM
#define PHM 0xFFFFFFFFu
#endif
#define EN(b) (((PHM) >> (b)) & 1u)
#ifndef REPEAT_MASK
#define REPEAT_MASK 0
#endif
#ifndef REPEAT_PREP
#define REPEAT_PREP 1
#endif
        if (EN(0) && k == -1) {
            for (int pr = 0; pr < REPEAT_PREP; ++pr) { prep_layer(kp, ws, 0, lds, gw, NGW, wave, lane, tid, G, bid); __syncthreads(); }
            row_pass(nullptr, nullptr, 0.f, AIN(I_X), X, AIN(I_FF1_PRE), XN, MT, gw, NGW, lane);
        } else if (EN(1) && (k == 0 || k == 14)) {
            pg8::EpiSwiGLU E{(bf16_t*)(ws + WS_H), DFF};
            run_gemm(lds, XN, (const bf16_t*)(ws + (k == 0 ? WS_W13A : WS_W13B)), MT, 2 * DFF, DM, G, bid, E);
        } else if (EN(2) && (k == 1 || k == 15 || k == 8 || k == 12)) {
            const bf16_t* A; const bf16_t* Bt; int K; float* Y;
            if (k == 1) { A = (const bf16_t*)(ws + WS_H); Bt = (const bf16_t*)(ws + WS_W2A); K = DFF; Y = (float*)(ws + WS_YF); }
            else if (k == 15) { A = (const bf16_t*)(ws + WS_H); Bt = (const bf16_t*)(ws + WS_W2B); K = DFF; Y = (float*)(ws + WS_YF); }
            else if (k == 8) { A = (const bf16_t*)(ws + WS_MRG); Bt = (const bf16_t*)(ws + WS_WMIX); K = DM; Y = (float*)(ws + WS_YM); }
            else { A = (const bf16_t*)(ws + WS_OX); Bt = (const bf16_t*)(ws + WS_WO); K = DM; Y = (float*)(ws + WS_YF); }
            pg8::EpiF32 E{Y, DM};
            run_gemm(lds, A, Bt, MT, DM, K, G, bid, E);
        } else if (EN(3) && (k == 2 || k == 9 || k == 13 || k == 16)) {
            const float *Y, *gpost, *gnext; float coef;
            if (k == 2) { Y = (const float*)(ws + WS_YF); gpost = LP(I_FF1_POST, DM); gnext = LP(I_MIX_PRE, DM); coef = 0.5f; }
            else if (k == 9) { Y = (const float*)(ws + WS_YM); gpost = LP(I_MIX_POST, DM); gnext = LP(I_MEM_PRE, DM); coef = 1.0f; }
            else if (k == 13) { Y = (const float*)(ws + WS_YF); gpost = LP(I_MEM_POST, DM); gnext = LP(I_FF2_PRE, DM); coef = 1.0f; }
            else { Y = (const float*)(ws + WS_YF); gpost = LP(I_FF2_POST, DM); gnext = (l + 1 < DEPTH) ? AIN(I_FF1_PRE) + (size_t)(l + 1) * DM : nullptr; coef = 0.5f; }
            row_pass(Y, gpost, coef, X, X, gnext, XN, MT, gw, NGW, lane);
            if (k == 16 && l + 1 < DEPTH) for (int pr = 0; pr < REPEAT_PREP; ++pr) { prep_layer(kp, ws, l + 1, lds, gw, NGW, wave, lane, tid, G, bid); __syncthreads(); }
        } else if (EN(4) && (k == 3 || k == 6)) {
            const bool gt6 = (k == 6);
            pg8::EpiZin E{gt6 ? LP(I_BIN, INC) + 2840 : (const float*)(ws + WS_BIASIN), (bf16_t*)(ws + (gt6 ? WS_G : WS_ZA)), (bf16_t*)(ws + WS_ZQ), (bf16_t*)(ws + WS_ZKV), (bf16_t*)(ws + WS_ZGM), (bf16_t*)(ws + WS_ZG), gt6 ? 1 : 0, (bf16_t*)(ws + WS_VTS), (bf16_t*)(ws + WS_VTW)};
            run_gemm(lds, XN, (const bf16_t*)(ws + (gt6 ? WS_WMG : WS_WIN)), MT, 3072, DM, G, bid, E);
        } else if (EN(5) && k == 4) {
            for (int u = bid; u < 256; u += G)
                compress_unit(u, (const bf16_t*)(ws + WS_ZKV), (const bf16_t*)(ws + WS_W1K), (const bf16_t*)(ws + WS_W1V), (const bf16_t*)(ws + WS_W2K), (const bf16_t*)(ws + WS_W2V),
                              LP(I_CPK, 2048), LP(I_CPV, 2048), (bf16_t*)(ws + WS_KC), (bf16_t*)(ws + WS_VC), lds, wave, lane);
            pool_pass((const bf16_t*)(ws + WS_ZA), (bf16_t*)(ws + WS_P), gt, NGT);
            for (int u = bid; u < 512; u += G)
                gmlp_unit(u, (const bf16_t*)(ws + WS_ZGM), (const bf16_t*)(ws + WS_GWS), LP(I_GLNG, 512), LP(I_GLNB, 512), LP(I_GBS, 512), (bf16_t*)(ws + WS_U), lds, wave, lane, tid);
        } else if (EN(6) && k == 5) {
            for (int u = bid, it = 0; u < 1024; u += G, ++it) { const int uu = (u & ~63) | ((it & 1) ? (u & 63) : 63 - (u & 63));
                nsa_unit(uu, (const bf16_t*)(ws + WS_ZQ), (const bf16_t*)(ws + WS_ZKV), (const bf16_t*)(ws + WS_ZG), (const bf16_t*)(ws + WS_KC), (const bf16_t*)(ws + WS_VC), (const bf16_t*)(ws + WS_VTS), (const bf16_t*)(ws + WS_VTW), (bf16_t*)(ws + WS_O), lds, wave, lane, tid);
                __syncthreads(); }
        } else if (EN(8) && k == 7) {
#ifndef MERGE_MASK
#define MERGE_MASK 7
#endif
            int nacc = 0;
            for (int i = 0; i < 3; ++i) {
                if (!((MERGE_MASK >> i) & 1)) continue;
                const bf16_t* A = (const bf16_t*)(ws + (i == 0 ? WS_P : (i == 1 ? WS_O : WS_U)));
                const bf16_t* Bt = (const bf16_t*)(ws + (i == 0 ? WS_WCOMB : (i == 1 ? WS_WBRN : WS_WBRG)));
                pg8::EpiMerge E{(const bf16_t*)(ws + WS_G), i * 1024, (bf16_t*)(ws + WS_MRG), nacc}; nacc = 1;
#ifdef PROBE_BF16S
                { pg8::EpiBf16S E2{(bf16_t*)(ws + WS_MRG), DM, 1.0f, nullptr}; run_gemm(lds, A, Bt, MT, DM, 512, G, bid, E2); }
#else
                run_gemm(lds, A, Bt, MT, DM, 512, G, bid, E);
#endif
                asm volatile("s_waitcnt vmcnt(0)" ::: "memory"); __builtin_amdgcn_fence(__ATOMIC_RELEASE, "agent"); __syncthreads(); __builtin_amdgcn_fence(__ATOMIC_ACQUIRE, "agent");
            }
        } else if (k == 10) {
        } else if (EN(9) && k == 11) {
            for (int u = bid; u < 512; u += G) { cross_unit(u, (const bf16_t*)(ws + WS_QX), (const bf16_t*)(ws + WS_KVM), (const bf16_t*)(ws + WS_VTM), (bf16_t*)(ws + WS_OX), lds, wave, lane, tid); __syncthreads(); }
        }
        if (EN(10) && (k == 0 || k == 10)) {
            const bool kv = (k == 0);
            pg8::EpiBf16S E{(bf16_t*)(ws + (kv ? WS_KVM : WS_QX)), kv ? 2048 : DM, kv ? 1.0f : 0.0625f, kv ? (bf16_t*)(ws + WS_VTM) : (bf16_t*)nullptr};
            run_gemm(lds, kv ? (const bf16_t*)(ws + WS_MEMN) : XN, (const bf16_t*)(ws + (kv ? WS_WKV : WS_WQ)), kv ? MM : MT, kv ? 2048 : DM, DM, G, kv ? (bid + G / 2) % G : bid, E);
        }
#undef LP
        if (((REPEAT_MASK >> (k + 1)) & 1) && !rep_done) { rep_done = true; } else { rep_done = false; ++ph; }
    }
}

__global__ void dump_kernel(const unsigned short* src, float* out, size_t n, size_t ld_src, size_t cols) {
    for (size_t i = (size_t)blockIdx.x * blockDim.x + threadIdx.x; i < n; i += (size_t)gridDim.x * blockDim.x) { const size_t r = i / cols, c = i % cols; out[i] = ld_src == 0 ? ((const float*)src)[i] : __uint_as_float((unsigned)src[r * ld_src + c] << 16); }
}
#ifndef MK_SPLIT
#define MK_SPLIT 0
#endif
extern "C" void kernel_launch(void* const* d_in, const int* in_sizes, int n_in, void* d_out, int out_size, void* d_ws, size_t ws_size, hipStream_t stream) {
    static int grid = 0;
    if (grid == 0) {
        if (n_in != N_IN || out_size != MT * DM || ws_size < WS_END) { fprintf(stderr, "kernel_launch: unexpected shapes (n_in %d out %d ws %zu)\n", n_in, out_size, ws_size); grid = -1; return; }
        int dev = 0, cus = 0, per_cu = 0;
        hipGetDevice(&dev); hipDeviceGetAttribute(&cus, hipDeviceAttributeMultiprocessorCount, dev);
        hipFuncSetAttribute((const void*)hybrid_fwd, hipFuncAttributeMaxDynamicSharedMemorySize, LDS_BYTES);
        hipOccupancyMaxActiveBlocksPerMultiprocessor(&per_cu, (const void*)hybrid_fwd, NTHREADS, LDS_BYTES);
        (void)hipGetLastError();
        if (per_cu < 1) per_cu = 1;
        grid = cus;
        if (grid <= 0) grid = 256;
    }
    if (grid < 0) return;
    Args a{};
    for (int i = 0; i < N_IN; ++i) a.in[i] = (const float*)d_in[i];
    a.out = (float*)d_out; a.ws = (unsigned char*)d_ws;
#if MK_SPLIT
#ifndef PH_LIMIT
#define PH_LIMIT NPHASES
#endif
    for (int ph = 0; ph < PH_LIMIT; ++ph) { a.ph_lo = ph; a.ph_hi = ph + 1; hipLaunchKernelGGL(hybrid_fwd, dim3(grid), dim3(NTHREADS), LDS_BYTES, stream, a); }
#ifdef DUMP_OFF
    hipLaunchKernelGGL(dump_kernel, dim3(2048), dim3(256), 0, stream, (const unsigned short*)((unsigned char*)d_ws + (DUMP_OFF)), (float*)d_out, (size_t)MT * DUMP_COLS, (size_t)DUMP_LD, (size_t)DUMP_COLS);
#endif
#else
    a.ph_lo = 0; a.ph_hi = NPHASES;
    if (hipMemsetAsync(d_ws, 0, XCD_BAR_WORDS * sizeof(unsigned), stream) != hipSuccess) { fprintf(stderr, "kernel_launch: memset of the barrier words failed\n"); return; }
    void* kargs[] = {&a};
    hipError_t e = hipLaunchCooperativeKernel((const void*)hybrid_fwd, dim3(grid), dim3(NTHREADS), kargs, LDS_BYTES, stream);
    if (e != hipSuccess) fprintf(stderr, "cooperative launch failed: %s (grid %d)\n", hipGetErrorString(e), grid);
#endif
}
```

```cpp
#include <hip/hip_runtime.h>
#include <hip/hip_cooperative_groups.h>
#include <cstdio>
#include <cstdint>
namespace cg = cooperative_groups;
namespace pg8 {
#define PG8_LAS __attribute__((address_space(3)))
typedef unsigned short bf16_t;
typedef short bf16x8 __attribute__((ext_vector_type(8)));
typedef float f32x4 __attribute__((ext_vector_type(4)));
typedef unsigned u32x4 __attribute__((ext_vector_type(4)));
constexpr int BM = 256, BK = 64, HALF = 128, HTB = HALF * BK * 2  , STAGE_BYTES = 8 * HTB, NXCD = 8, WGM = 8;

__host__ __device__ __forceinline__ int lds_byte(int r, int c) { const int st = (r >> 4) * 2 + (c >> 5), rr = r & 15, cc = c & 31, ob = rr * 64 + cc * 2; return st * 1024 + (ob ^ (((ob >> 9) & 1) << 5)); }
__host__ __device__ __forceinline__ void stage_rc(int b, int& R, int& C) { const int st = b / 1024, sb = b % 1024, swz = sb ^ (((sb >> 9) & 1) << 5); R = (st >> 1) * 16 + swz / 64; C = (st & 1) * 32 + (swz % 64) / 2; }
__host__ __device__ __forceinline__ int perm32(int rho) { const int n = rho >> 4, i = rho & 15; return 8 * (i >> 2) + 4 * n + (i & 3); }

struct Unit { int pm, pn; };
struct Gemm { const bf16_t* A; const bf16_t* Bt; int M, N, K; };

struct StaticOrder {
    int nM, nN, nwg, G, c;
    __host__ __device__ void init(int M, int N, int G_, int c_) { nM = M / BM; nN = N / BM; nwg = nM * nN; G = G_; c = c_; }
    __host__ __device__ bool next(int i, Unit& u) const {
        const long L = (long)i * G + c; if (L >= nwg) return false;
        int wgid = (int)L; { const int q = nwg / NXCD, r = nwg % NXCD, xcd = wgid % NXCD, off = wgid / NXCD; wgid = (xcd < r ? xcd * (q + 1) : r * (q + 1) + (xcd - r) * q) + off; }
        const int nig = WGM * nN, gid = wgid / nig, fm = gid * WGM, gsz = (nM - fm) < WGM ? (nM - fm) : WGM;
        u.pm = fm + ((wgid % nig) % gsz); u.pn = (wgid % nig) / gsz; return true;
    }
    __device__ __forceinline__ void a_ready(const Unit&) const {}
    __device__ __forceinline__ void done(const Unit&) const {}
};

typedef float f32x2_cv __attribute__((ext_vector_type(2))); typedef __bf16 bf16x2_cv __attribute__((ext_vector_type(2)));
__device__ __forceinline__ unsigned cvt_pk_bf16(float lo, float hi) { const f32x2_cv v = {lo, hi}; const bf16x2_cv b = __builtin_convertvector(v, bf16x2_cv); return __builtin_bit_cast(unsigned, b); }
typedef float f32x2 __attribute__((ext_vector_type(2)));
typedef unsigned u32x2 __attribute__((ext_vector_type(2)));
__device__ __forceinline__ float fsigmoid(float v) { return __builtin_amdgcn_rcpf(1.0f + __expf(-v)); }
__device__ __forceinline__ float fgelu_tanh(float v) { const float z = 1.5957691216f * (v + 0.044715f * v * v * v); return v * fsigmoid(z); }
__device__ __forceinline__ float bflo(unsigned w) { return __uint_as_float(w << 16); }
__device__ __forceinline__ float bfhi(unsigned w) { return __uint_as_float(w & 0xffff0000u); }

struct EpiF32 {
    static constexpr bool PERM = false, AFTER_DRAIN = false;
    float* C; int ldc;
    __device__ __forceinline__ void operator()(const f32x4 (&acc)[2][2][4][2], const Unit& u, int wr, int wc, int fr, int fq) const {
        const int row0 = u.pm * BM + wr * 64 + fr, col0 = u.pn * BM + wc * 32 + 4 * fq;
#pragma unroll
        for (int ai = 0; ai < 2; ++ai)
#pragma unroll
            for (int m = 0; m < 4; ++m) { float* rowp = C + (size_t)(row0 + ai * HALF + m * 16) * ldc + col0;
#pragma unroll
                for (int bj = 0; bj < 2; ++bj)
#pragma unroll
                    for (int n = 0; n < 2; ++n) *(f32x4*)(rowp + bj * HALF + n * 16) = acc[ai][bj][m][n]; }
    }
};
struct EpiBf16S {
    static constexpr bool PERM = true, AFTER_DRAIN = false;
    bf16_t* O; int ldc; float scale; bf16_t* vt;
    __device__ __forceinline__ void operator()(const f32x4 (&acc)[2][2][4][2], const Unit& u, int wr, int wc, int fr, int fq) const {
        const int row0 = u.pm * BM + wr * 64 + fr, col0 = u.pn * BM + wc * 32 + 8 * fq;
        const bool tr = (vt != nullptr) && (u.pn >= 4);
#pragma unroll
        for (int ai = 0; ai < 2; ++ai)
#pragma unroll
            for (int m = 0; m < 4; ++m) { const int row = row0 + ai * HALF + m * 16; bf16_t* rowp = O + (size_t)row * ldc + col0;
#pragma unroll
                for (int bj = 0; bj < 2; ++bj) { const f32x4 v0 = acc[ai][bj][m][0] * scale, v1 = acc[ai][bj][m][1] * scale;
                    u32x4 w; w.x = cvt_pk_bf16(v0[0], v0[1]); w.y = cvt_pk_bf16(v0[2], v0[3]); w.z = cvt_pk_bf16(v1[0], v1[1]); w.w = cvt_pk_bf16(v1[2], v1[3]);
                    if (tr) { bf16_t* p = vt + ((size_t)(((row >> 8) * 4 + (u.pn - 4)) * 256 + bj * HALF + wc * 32 + 8 * fq)) * 256 + (row & 255);
                        p[0 * 256] = (bf16_t)(w.x & 0xffffu); p[1 * 256] = (bf16_t)(w.x >> 16); p[2 * 256] = (bf16_t)(w.y & 0xffffu); p[3 * 256] = (bf16_t)(w.y >> 16);
                        p[4 * 256] = (bf16_t)(w.z & 0xffffu); p[5 * 256] = (bf16_t)(w.z >> 16); p[6 * 256] = (bf16_t)(w.w & 0xffffu); p[7 * 256] = (bf16_t)(w.w >> 16); }
                    else *(u32x4*)(rowp + bj * HALF) = w; }
                asm volatile("" ::: "memory"); }
    }
};
struct EpiSwiGLU {
    static constexpr bool PERM = true, AFTER_DRAIN = false;
    bf16_t* H; int ldh;
    __device__ __forceinline__ void operator()(const f32x4 (&acc)[2][2][4][2], const Unit& u, int wr, int wc, int fr, int fq) const {
        const int row0 = u.pm * BM + wr * 64 + fr, col0 = u.pn * HALF + wc * 32 + 8 * fq;
#pragma unroll
        for (int ai = 0; ai < 2; ++ai)
#pragma unroll
            for (int m = 0; m < 4; ++m) { bf16_t* p = H + (size_t)(row0 + ai * HALF + m * 16) * ldh + col0;
                f32x4 h0, h1;
#pragma unroll
                for (int i = 0; i < 4; ++i) { const float g0 = acc[ai][0][m][0][i], g1 = acc[ai][0][m][1][i];
                    h0[i] = g0 * fsigmoid(g0) * acc[ai][1][m][0][i]; h1[i] = g1 * fsigmoid(g1) * acc[ai][1][m][1][i]; }
                u32x4 w; w.x = cvt_pk_bf16(h0[0], h0[1]); w.y = cvt_pk_bf16(h0[2], h0[3]); w.z = cvt_pk_bf16(h1[0], h1[1]); w.w = cvt_pk_bf16(h1[2], h1[3]);
                *(u32x4*)p = w; }
    }
};
struct EpiZin {
    static constexpr bool PERM = true, AFTER_DRAIN = false;
    const float* bias; bf16_t *ZA, *ZQ, *ZKV, *ZGM, *ZG; int mode; bf16_t *VTS, *VTW;
    __device__ __forceinline__ void operator()(const f32x4 (&acc)[2][2][4][2], const Unit& u, int wr, int wc, int fr, int fq) const {
        const int pn = u.pn; const int row0 = u.pm * BM + wr * 64 + fr;
        bf16_t* base; int ld, cb; int act = 0; float sc = 1.f; bool only0 = false;
        if (mode == 1) { base = ZA; ld = 3072; cb = pn * 256; act = 2; }
        else if (pn < 2) { base = ZA; ld = 512; cb = pn * 256; }
        else if (pn < 4) { base = ZQ; ld = 512; cb = (pn - 2) * 256; sc = 0.125f; }
        else if (pn < 7) { base = ZKV; ld = 768; cb = (pn - 4) * 256; }
        else if (pn < 11) { base = ZGM; ld = 1024; cb = (pn - 7) * 256; act = 1; }
        else { base = ZG; ld = 32; cb = 0; only0 = true; }
        const int ct = wc * 32 + 8 * fq;
        bf16_t* bp = base + (size_t)row0 * ld + cb + ct;
        f32x4 bv[2][2];
#pragma unroll
        for (int bj = 0; bj < 2; ++bj)
#pragma unroll
            for (int n = 0; n < 2; ++n) bv[bj][n] = *(const f32x4*)(bias + pn * 256 + bj * HALF + ct + 4 * n);
#pragma unroll
        for (int ai = 0; ai < 2; ++ai)
#pragma unroll
            for (int m = 0; m < 4; ++m) {
#pragma unroll
                for (int bj = 0; bj < 2; ++bj) {
                    f32x4 v0 = (acc[ai][bj][m][0] + bv[bj][0]) * sc, v1 = (acc[ai][bj][m][1] + bv[bj][1]) * sc;
                    if (act == 1) {
#pragma unroll
                        for (int i = 0; i < 4; ++i) { v0[i] = fgelu_tanh(v0[i]); v1[i] = fgelu_tanh(v1[i]); } }
                    else if (act == 2) {
#pragma unroll
                        for (int i = 0; i < 4; ++i) { v0[i] = fsigmoid(v0[i]); v1[i] = fsigmoid(v1[i]); } }
                    u32x4 w; w.x = cvt_pk_bf16(v0[0], v0[1]); w.y = cvt_pk_bf16(v0[2], v0[3]); w.z = cvt_pk_bf16(v1[0], v1[1]); w.w = cvt_pk_bf16(v1[2], v1[3]);
                    if (mode == 0 && bj == 1 && (pn == 5 || pn == 6)) {
                        const int row = row0 + ai * HALF + m * 16, bb = row >> 11, t = row & 2047;
                        bf16_t* vt = (pn == 5 ? VTS : VTW) + ((size_t)((bb * 2 + (wc >> 1)) * 64 + (wc & 1) * 32 + 8 * fq)) * 2048 + t;
                        vt[0 * 2048] = (bf16_t)(w.x & 0xffffu); vt[1 * 2048] = (bf16_t)(w.x >> 16); vt[2 * 2048] = (bf16_t)(w.y & 0xffffu); vt[3 * 2048] = (bf16_t)(w.y >> 16);
                        vt[4 * 2048] = (bf16_t)(w.z & 0xffffu); vt[5 * 2048] = (bf16_t)(w.z >> 16); vt[6 * 2048] = (bf16_t)(w.w & 0xffffu); vt[7 * 2048] = (bf16_t)(w.w >> 16);
                    } else if (!only0 || (wc == 0 && bj == 0)) *(u32x4*)(bp + (ai * HALF + m * 16) * ld + bj * HALF) = w; }
                asm volatile("" ::: "memory"); }
    }
};
struct EpiMerge {
    static constexpr bool PERM = true, AFTER_DRAIN = false;
    const bf16_t* G; int goff; bf16_t* MRG; int accum;
    __device__ __forceinline__ void operator()(const f32x4 (&acc)[2][2][4][2], const Unit& u, int wr, int wc, int fr, int fq) const {
        const int row0 = u.pm * BM + wr * 64 + fr, col0 = u.pn * BM + wc * 32 + 8 * fq;
#pragma unroll
        for (int ai = 0; ai < 2; ++ai)
#pragma unroll
            for (int m = 0; m < 4; ++m) { const size_t r = (size_t)(row0 + ai * HALF + m * 16);
#pragma unroll
                for (int bj = 0; bj < 2; ++bj) {
#ifdef MERGE_NOGATE
                    const u32x4 g = (u32x4){0x3f803f80u, 0x3f803f80u, 0x3f803f80u, 0x3f803f80u};
#else
                    const u32x4 g = *(const u32x4*)(G + r * 3072 + goff + col0 + bj * HALF);
#endif
                    bf16_t* p = MRG + r * 1024 + col0 + bj * HALF;
                    f32x4 v0 = acc[ai][bj][m][0], v1 = acc[ai][bj][m][1];
                    v0[0] *= bflo(g.x); v0[1] *= bfhi(g.x); v0[2] *= bflo(g.y); v0[3] *= bfhi(g.y);
                    v1[0] *= bflo(g.z); v1[1] *= bfhi(g.z); v1[2] *= bflo(g.w); v1[3] *= bfhi(g.w);
                    if (accum) { const u32x4 o = *(const u32x4*)p;
                        v0[0] += bflo(o.x); v0[1] += bfhi(o.x); v0[2] += bflo(o.y); v0[3] += bfhi(o.y);
                        v1[0] += bflo(o.z); v1[1] += bfhi(o.z); v1[2] += bflo(o.w); v1[3] += bfhi(o.w); }
                    u32x4 w; w.x = cvt_pk_bf16(v0[0], v0[1]); w.y = cvt_pk_bf16(v0[2], v0[3]); w.z = cvt_pk_bf16(v1[0], v1[1]); w.w = cvt_pk_bf16(v1[2], v1[3]);
                    *(u32x4*)p = w; } }
    }
};
template <class Epi, class Sched, bool ALIGN_EPI = false, bool SP2 = false>
__device__ __forceinline__ void gemm_phase(PG8_LAS unsigned char* lds, const Gemm g, const Sched& S, const Epi& E) {
    int tid_o = threadIdx.x; asm volatile("" : "+v"(tid_o));
    const int tid = tid_o, wid = __builtin_amdgcn_readfirstlane(tid >> 6), lane = tid & 63, wr = wid >> 2, wc = wid & 3, fr = lane & 15, fq = lane >> 4;
    const int K = g.K, nt = K / BK;
    unsigned voffA[2], voffB[2];
#pragma unroll
    for (int i = 0; i < 2; ++i) { int R, C; stage_rc(tid * 16 + i * 8192, R, C); const int Rb = Epi::PERM ? ((R & ~31) + perm32(R & 31)) : R;
        voffA[i] = (unsigned)(R * K + C) * 2u; voffB[i] = (unsigned)(Rb * K + C) * 2u; }
    const size_t kstep = (size_t)(BK * 2);
    const size_t hstep = (size_t)HALF * K * 2;
    const size_t tstep = 2 * hstep;
    const unsigned ldsw = (unsigned)wid * 1024u;
    const int aoff = lds_byte(wr * 64 + fr, fq * 8), boff = lds_byte(wc * 32 + fr, fq * 8);
#define PG8_SA(b, h) (((b) * 2 + (h)) * HTB)
#define PG8_SB(b, h) ((4 + (b) * 2 + (h)) * HTB)
#define PG8_STAGE(bufoff, gbase, voff) do { _Pragma("unroll") for (int _i = 0; _i < 2; ++_i) \
        __builtin_amdgcn_global_load_lds((const unsigned*)((const char*)(gbase) + (voff)[_i]), (PG8_LAS unsigned*)(lds + (bufoff) + ldsw + _i * 8192), 16, 0, 0); } while (0)
#define PG8_LDA(dst, b, h) do { _Pragma("unroll") for (int m = 0; m < 4; ++m) _Pragma("unroll") for (int k = 0; k < 2; ++k) dst[m][k] = *(const PG8_LAS bf16x8*)(lds + PG8_SA(b, h) + aoff + m * 2048 + k * 1024); } while (0)
#define PG8_LDB(dst, b, h) do { _Pragma("unroll") for (int n = 0; n < 2; ++n) _Pragma("unroll") for (int k = 0; k < 2; ++k) dst[n][k] = *(const PG8_LAS bf16x8*)(lds + PG8_SB(b, h) + boff + n * 2048 + k * 1024); } while (0)
#define PG8_MMA(ai, bj, At, Bt) do { __builtin_amdgcn_s_setprio(1); _Pragma("unroll") for (int m = 0; m < 4; ++m) _Pragma("unroll") for (int n = 0; n < 2; ++n) _Pragma("unroll") for (int k = 0; k < 2; ++k) \
        acc[ai][bj][m][n] = __builtin_amdgcn_mfma_f32_16x16x32_bf16(Bt[n][k], At[m][k], acc[ai][bj][m][n], 0, 0, 0); __builtin_amdgcn_s_setprio(0); } while (0)
#define PG8_WAIT_V(n) asm volatile("s_waitcnt vmcnt(" #n ")" ::: "memory")
#define PG8_WAIT_L(n) asm volatile("s_waitcnt lgkmcnt(" #n ")" ::: "memory")
#define PG8_BAR __builtin_amdgcn_s_barrier()
#define PG8_SCHED __builtin_amdgcn_sched_barrier(0)
    Unit cur, nxt; int ui = 0;
    if (!S.next(0, cur)) return;
    f32x4 acc[2][2][4][2];
#pragma unroll
    for (int a = 0; a < 2; ++a)
#pragma unroll
        for (int b = 0; b < 2; ++b)
#pragma unroll
            for (int m = 0; m < 4; ++m)
#pragma unroll
                for (int n = 0; n < 2; ++n) acc[a][b][m][n] = (f32x4){0.f, 0.f, 0.f, 0.f};
    bf16x8 At[4][2], B0[2][2], B1[2][2];
    const char* cA = (const char*)g.A + (size_t)cur.pm * tstep; const char* cB = (const char*)g.Bt + (size_t)cur.pn * tstep;
    S.a_ready(cur);
    if constexpr (SP2) {
        PG8_STAGE(PG8_SB(0, 0), cB, voffB); PG8_STAGE(PG8_SB(0, 1), cB + hstep, voffB); PG8_STAGE(PG8_SA(0, 0), cA, voffA); PG8_STAGE(PG8_SA(0, 1), cA + hstep, voffA);
        if (wr == 1) PG8_BAR;
        PG8_WAIT_V(2); PG8_BAR;
        PG8_STAGE(PG8_SB(1, 0), cB + kstep, voffB); PG8_STAGE(PG8_SA(1, 0), cA + kstep, voffA); PG8_STAGE(PG8_SB(1, 1), cB + hstep + kstep, voffB);
        PG8_WAIT_V(6); PG8_BAR;
    } else {
        PG8_STAGE(PG8_SB(0, 0), cB, voffB); PG8_STAGE(PG8_SA(0, 0), cA, voffA); PG8_STAGE(PG8_SB(0, 1), cB + hstep, voffB); PG8_STAGE(PG8_SA(0, 1), cA + hstep, voffA);
        if (wr == 1) PG8_BAR;
        PG8_WAIT_V(4); PG8_BAR;
        PG8_STAGE(PG8_SB(1, 0), cB + kstep, voffB); PG8_STAGE(PG8_SA(1, 0), cA + kstep, voffA); PG8_STAGE(PG8_SB(1, 1), cB + hstep + kstep, voffB);
        PG8_WAIT_V(6); PG8_BAR;
    }
    for (;;) {
        const bool has_next = S.next(ui + 1, nxt);
        const char* nA = has_next ? (const char*)g.A + (size_t)nxt.pm * tstep : cA; const char* nB = has_next ? (const char*)g.Bt + (size_t)nxt.pn * tstep : cB;
        for (int t = 0; t < nt; t += 2) {
            const bool last = (t == nt - 2);
            const char* a1 = cA + (size_t)(t + 1) * kstep;
            const char* a2 = last ? nA : cA + (size_t)(t + 2) * kstep; const char* b2 = last ? nB : cB + (size_t)(t + 2) * kstep;
            const char* a3 = a2 + kstep; const char* b3 = b2 + kstep;
            if (last && has_next) S.a_ready(nxt);
            if constexpr (SP2) {
            PG8_LDB(B0, 0, 0); PG8_LDB(B1, 0, 1); PG8_SCHED; PG8_LDA(At, 0, 0); PG8_STAGE(PG8_SA(1, 1), a1 + hstep, voffA);
            PG8_WAIT_V(8); PG8_WAIT_L(0); PG8_BAR; PG8_MMA(0, 0, At, B0); PG8_MMA(0, 1, At, B1); PG8_BAR; PG8_SCHED;
            PG8_LDA(At, 0, 1); PG8_STAGE(PG8_SB(0, 0), b2, voffB); PG8_STAGE(PG8_SB(0, 1), b2 + hstep, voffB); PG8_STAGE(PG8_SA(0, 0), a2, voffA);
            PG8_WAIT_V(8); PG8_WAIT_L(0); PG8_BAR; PG8_MMA(1, 0, At, B0); PG8_MMA(1, 1, At, B1); PG8_BAR; PG8_SCHED;
            PG8_LDB(B0, 1, 0); PG8_LDB(B1, 1, 1); PG8_SCHED; PG8_LDA(At, 1, 0); PG8_STAGE(PG8_SA(0, 1), a2 + hstep, voffA);
            PG8_WAIT_V(8); PG8_WAIT_L(0); PG8_BAR; PG8_MMA(0, 0, At, B0); PG8_MMA(0, 1, At, B1); PG8_BAR; PG8_SCHED;
            PG8_LDA(At, 1, 1); PG8_STAGE(PG8_SB(1, 0), b3, voffB); PG8_STAGE(PG8_SB(1, 1), b3 + hstep, voffB); PG8_STAGE(PG8_SA(1, 0), a3, voffA);
            PG8_WAIT_V(8); PG8_WAIT_L(0); PG8_BAR; PG8_MMA(1, 0, At, B0); PG8_MMA(1, 1, At, B1); PG8_BAR; PG8_SCHED;
            } else {
            PG8_LDB(B0, 0, 0); PG8_SCHED; PG8_LDA(At, 0, 0); PG8_STAGE(PG8_SA(1, 1), a1 + hstep, voffA);
            PG8_WAIT_L(8); PG8_BAR; PG8_WAIT_L(0); PG8_MMA(0, 0, At, B0); PG8_BAR; PG8_SCHED;
            PG8_LDB(B1, 0, 1); PG8_STAGE(PG8_SB(0, 0), b2, voffB);
            PG8_BAR; PG8_WAIT_L(0); PG8_MMA(0, 1, At, B1); PG8_BAR;
            PG8_LDA(At, 0, 1); PG8_STAGE(PG8_SA(0, 0), a2, voffA);
            PG8_BAR; PG8_WAIT_L(0); PG8_MMA(1, 0, At, B0); PG8_BAR; PG8_SCHED;
            PG8_STAGE(PG8_SB(0, 1), b2 + hstep, voffB);
            PG8_WAIT_V(6); PG8_BAR; PG8_MMA(1, 1, At, B1); PG8_BAR;
            PG8_LDB(B0, 1, 0); PG8_SCHED; PG8_LDA(At, 1, 0); PG8_STAGE(PG8_SA(0, 1), a2 + hstep, voffA);
            PG8_WAIT_L(8); PG8_BAR; PG8_WAIT_L(0); PG8_MMA(0, 0, At, B0); PG8_BAR; PG8_SCHED;
            PG8_LDB(B1, 1, 1); PG8_STAGE(PG8_SB(1, 0), b3, voffB);
            PG8_BAR; PG8_WAIT_L(0); PG8_MMA(0, 1, At, B1); PG8_BAR;
            PG8_LDA(At, 1, 1); PG8_STAGE(PG8_SA(1, 0), a3, voffA);
            PG8_BAR; PG8_WAIT_L(0); PG8_MMA(1, 0, At, B0); PG8_BAR; PG8_SCHED;
            PG8_STAGE(PG8_SB(1, 1), b3 + hstep, voffB);
            PG8_WAIT_V(6); PG8_BAR; PG8_MMA(1, 1, At, B1); PG8_BAR;
            }
        }
        if constexpr (ALIGN_EPI) { if (wr == 0) PG8_BAR; }
        if constexpr (!Epi::AFTER_DRAIN) { E(acc, cur, wr, wc, fr, fq); S.done(cur); }
        if (!has_next) break;
#pragma unroll
        for (int a = 0; a < 2; ++a)
#pragma unroll
            for (int b = 0; b < 2; ++b)
#pragma unroll
                for (int m = 0; m < 4; ++m)
#pragma unroll
                    for (int n = 0; n < 2; ++n) acc[a][b][m][n] = (f32x4){0.f, 0.f, 0.f, 0.f};
        cur = nxt; cA = nA; cB = nB; ++ui;
        if constexpr (ALIGN_EPI) { if (wr == 1) PG8_BAR; }
    }
    PG8_WAIT_V(0);
    if constexpr (!ALIGN_EPI) { if (wr == 0) PG8_BAR; }
    PG8_BAR;
    if constexpr (Epi::AFTER_DRAIN) { E.fused(acc, cur, wr, wc, fr, fq, lds, wid, lane); S.done(cur); }
#undef PG8_SA
#undef PG8_SB
#undef PG8_STAGE
#undef PG8_LDA
#undef PG8_LDB
#undef PG8_MMA
#undef PG8_WAIT_V
#undef PG8_WAIT_L
#undef PG8_BAR
#undef PG8_SCHED
}
}
#define LAS __attribute__((address_space(3)))
typedef unsigned short bf16_t;
typedef short bf16x8 __attribute__((ext_vector_type(8)));
typedef short s16x4 __attribute__((ext_vector_type(4)));
typedef float f32x4 __attribute__((ext_vector_type(4)));
typedef unsigned u32x4 __attribute__((ext_vector_type(4)));
typedef unsigned u32x2 __attribute__((ext_vector_type(2)));
using pg8::cvt_pk_bf16; using pg8::fsigmoid; using pg8::bflo; using pg8::bfhi;
#define MFMA16(a, b, c) __builtin_amdgcn_mfma_f32_16x16x32_bf16((a), (b), (c), 0, 0, 0)

constexpr int DM = 1024, NBATCH = 8, SEQ = 2048, MT = NBATCH * SEQ, DFF = 2816, MEML = 256, MM = NBATCH * MEML, DEPTH = 2, INC = 5912;
constexpr int NWAVES = 8, NTHREADS = 512;
constexpr float EPS = 1e-6f, LOG2E = 1.4426950408889634f;
constexpr int PH_PER_LAYER = 17, NPHASES = 1 + DEPTH * PH_PER_LAYER;

enum { I_X = 0, I_MEM, I_FF1_PRE, I_FF1_W1, I_FF1_W3, I_FF1_W2, I_FF1_POST, I_MIX_PRE, I_WIN, I_BIN, I_POOLW, I_POOLS, I_CPK, I_CW1K, I_CW2K, I_CPV, I_CW1V, I_CW2V,
       I_GLNG, I_GLNB, I_GWS, I_GBS, I_WBRP, I_WBRN, I_WBRG, I_WMIX, I_MIX_POST, I_MEM_PRE, I_MEM_KVG, I_WQ, I_WK, I_WV, I_WO, I_MEM_POST, I_FF2_PRE, I_FF2_W1, I_FF2_W3, I_FF2_W2, I_FF2_POST, N_IN };

constexpr size_t MiB = 1u << 20, KiB = 1024;
constexpr size_t WS_W13A = 1 * MiB, WS_W2A = 12 * MiB, WS_W13B = 17 * MiB + 512 * KiB, WS_W2B = 28 * MiB + 512 * KiB, WS_WIN = 34 * MiB, WS_WMG = 40 * MiB,
                 WS_WCOMB = 46 * MiB, WS_WBRN = 47 * MiB, WS_WBRG = 48 * MiB, WS_WMIX = 49 * MiB, WS_WQ = 51 * MiB, WS_WKV = 53 * MiB, WS_WO = 57 * MiB,
                 WS_W1K = 59 * MiB, WS_W1V = 60 * MiB, WS_W2K = 61 * MiB, WS_W2V = 61 * MiB + 32 * KiB, WS_GWS = 61 * MiB + 64 * KiB, WS_BIASIN = 61 * MiB + 192 * KiB,
                 WS_POSB = 61 * MiB + 208 * KiB;
constexpr size_t WS_XN = 62 * MiB, WS_MEMN = 94 * MiB, WS_KVM = 98 * MiB, WS_KC = 106 * MiB, WS_VC = 106 * MiB + 512 * KiB, WS_BIG = 107 * MiB;
constexpr size_t WS_H = WS_BIG, WS_YF = WS_BIG + 88 * MiB;
constexpr size_t WS_ZA = WS_BIG, WS_ZQ = WS_BIG + 16 * MiB, WS_ZKV = WS_BIG + 32 * MiB, WS_ZGM = WS_BIG + 56 * MiB, WS_ZG = WS_BIG + 88 * MiB;
constexpr size_t WS_G = WS_BIG, WS_P = WS_BIG + 96 * MiB, WS_O = WS_BIG + 112 * MiB, WS_U = WS_BIG + 128 * MiB, WS_MRG = WS_BIG + 144 * MiB, WS_YM = WS_BIG;
constexpr size_t WS_QX = WS_BIG, WS_OX = WS_BIG + 32 * MiB;
constexpr size_t WS_VTS = WS_BIG + 176 * MiB, WS_VTW = WS_VTS + 4 * MiB, WS_VTM = WS_VTW + 4 * MiB;
constexpr size_t WS_END = WS_VTM + 4 * MiB;

constexpr int LDS_BYTES = 147456;

struct Args { const float* in[N_IN]; float* out; unsigned char* ws; int ph_lo, ph_hi; };
typedef const unsigned char __attribute__((address_space(4)))* karg_t;
#define AIN(i) (*(const float* const __attribute__((address_space(4)))*)(kp + 8 * (i)))

__device__ __forceinline__ float wave_sum(float v) {
#pragma unroll
    for (int o = 1; o < 64; o <<= 1) v += __shfl_xor(v, o);
    return v;
}
#define LDS_WAIT() asm volatile("s_waitcnt lgkmcnt(0)" ::: "memory")

struct TSeg { const float* W; int K, N, col0, ncols, nvalid; bf16_t* WT; int mode, row0; };
__device__ __forceinline__ void transpose_item(const TSeg& s, LAS float* scr, int item, int lane) {
    const int nblk = s.ncols / 32, kb = item / nblk, nb = item % nblk, k0 = 64 * kb, n0 = 32 * nb;
    const int c4 = (lane & 7) * 4, nl = n0 + c4;
    f32x4 v[8];
#pragma unroll
    for (int i = 0; i < 8; ++i) { const int kk = i * 8 + (lane >> 3);
        v[i] = (nl < s.nvalid) ? *(const f32x4*)(s.W + (size_t)(k0 + kk) * s.N + s.col0 + nl) : (f32x4){0.f, 0.f, 0.f, 0.f}; }
#pragma unroll
    for (int i = 0; i < 8; ++i) { const int kk = i * 8 + (lane >> 3); *(LAS f32x4*)(scr + kk * 36 + c4) = v[i]; }
    LDS_WAIT(); asm volatile("" ::: "memory");
    const int c = lane & 7;
#pragma unroll
    for (int j = 0; j < 4; ++j) { const int nloc = (lane >> 3) + 8 * j, n = n0 + nloc; const LAS float* sp = scr + (8 * c) * 36 + nloc;
        const int drow = s.mode == 0 ? s.row0 + n : (n >> 7) * 256 + (n & 127) + s.row0;
        u32x4 o; o.x = cvt_pk_bf16(sp[0 * 36], sp[1 * 36]); o.y = cvt_pk_bf16(sp[2 * 36], sp[3 * 36]); o.z = cvt_pk_bf16(sp[4 * 36], sp[5 * 36]); o.w = cvt_pk_bf16(sp[6 * 36], sp[7 * 36]);
        *(u32x4*)(s.WT + (size_t)drow * s.K + k0 + 8 * c) = o; }
    LDS_WAIT(); asm volatile("" ::: "memory");
}
constexpr int NSEG = 21;
__device__ __forceinline__ TSeg get_seg(karg_t kp, unsigned char* ws, int l, int seg) {
    TSeg s; s.col0 = 0; s.mode = 0; s.row0 = 0;
#define W(idx, per) (AIN(idx) + (size_t)l * (per))
    switch (seg) {
    case 0: s.W = W(I_FF1_W1, (size_t)DM * DFF); s.K = DM; s.N = DFF; s.ncols = DFF; s.WT = (bf16_t*)(ws + WS_W13A); s.mode = 1; s.row0 = 0; break;
    case 1: s.W = W(I_FF1_W3, (size_t)DM * DFF); s.K = DM; s.N = DFF; s.ncols = DFF; s.WT = (bf16_t*)(ws + WS_W13A); s.mode = 1; s.row0 = 128; break;
    case 2: s.W = W(I_FF1_W2, (size_t)DM * DFF); s.K = DFF; s.N = DM; s.ncols = DM; s.WT = (bf16_t*)(ws + WS_W2A); break;
    case 3: s.W = W(I_FF2_W1, (size_t)DM * DFF); s.K = DM; s.N = DFF; s.ncols = DFF; s.WT = (bf16_t*)(ws + WS_W13B); s.mode = 1; s.row0 = 0; break;
    case 4: s.W = W(I_FF2_W3, (size_t)DM * DFF); s.K = DM; s.N = DFF; s.ncols = DFF; s.WT = (bf16_t*)(ws + WS_W13B); s.mode = 1; s.row0 = 128; break;
    case 5: s.W = W(I_FF2_W2, (size_t)DM * DFF); s.K = DFF; s.N = DM; s.ncols = DM; s.WT = (bf16_t*)(ws + WS_W2B); break;
    case 6: s.W = W(I_WIN, (size_t)DM * INC); s.K = DM; s.N = INC; s.col0 = 0; s.ncols = 1792; s.WT = (bf16_t*)(ws + WS_WIN); s.row0 = 0; break;
    case 7: s.W = W(I_WIN, (size_t)DM * INC); s.K = DM; s.N = INC; s.col0 = 1816; s.ncols = 1024; s.WT = (bf16_t*)(ws + WS_WIN); s.row0 = 1792; break;
    case 8: s.W = W(I_WIN, (size_t)DM * INC); s.K = DM; s.N = INC; s.col0 = 1792; s.ncols = 256; s.WT = (bf16_t*)(ws + WS_WIN); s.row0 = 2816; break;
    case 9: s.W = W(I_WIN, (size_t)DM * INC); s.K = DM; s.N = INC; s.col0 = 2840; s.ncols = 3072; s.WT = (bf16_t*)(ws + WS_WMG); break;
    case 10: s.W = W(I_WBRN, (size_t)512 * DM); s.K = 512; s.N = DM; s.ncols = DM; s.WT = (bf16_t*)(ws + WS_WBRN); break;
    case 11: s.W = W(I_WBRG, (size_t)512 * DM); s.K = 512; s.N = DM; s.ncols = DM; s.WT = (bf16_t*)(ws + WS_WBRG); break;
    case 12: s.W = W(I_WMIX, (size_t)DM * DM); s.K = DM; s.N = DM; s.ncols = DM; s.WT = (bf16_t*)(ws + WS_WMIX); break;
    case 13: s.W = W(I_WQ, (size_t)DM * DM); s.K = DM; s.N = DM; s.ncols = DM; s.WT = (bf16_t*)(ws + WS_WQ); break;
    case 14: s.W = W(I_WK, (size_t)DM * DM); s.K = DM; s.N = DM; s.ncols = DM; s.WT = (bf16_t*)(ws + WS_WKV); s.row0 = 0; break;
    case 15: s.W = W(I_WV, (size_t)DM * DM); s.K = DM; s.N = DM; s.ncols = DM; s.WT = (bf16_t*)(ws + WS_WKV); s.row0 = 1024; break;
    case 16: s.W = W(I_WO, (size_t)DM * DM); s.K = DM; s.N = DM; s.ncols = DM; s.WT = (bf16_t*)(ws + WS_WO); break;
    case 17: s.W = W(I_CW1K, (size_t)2048 * 256); s.K = 2048; s.N = 256; s.ncols = 256; s.WT = (bf16_t*)(ws + WS_W1K); break;
    case 18: s.W = W(I_CW1V, (size_t)2048 * 256); s.K = 2048; s.N = 256; s.ncols = 256; s.WT = (bf16_t*)(ws + WS_W1V); break;
    case 19: s.W = W(I_CW2K, (size_t)256 * 64); s.K = 256; s.N = 64; s.ncols = 64; s.WT = (bf16_t*)(ws + WS_W2K); break;
    default: s.W = W(I_CW2V, (size_t)256 * 64); s.K = 256; s.N = 64; s.ncols = 64; s.WT = (bf16_t*)(ws + WS_W2V); break;
    }
#undef W
    s.nvalid = (seg == 8) ? 24 : s.ncols;
    return s;
}
__device__ __forceinline__ void row_pass(const bf16_t* Y, const float* gpost, float coef, const float* xin, float* xout, const float* gnext, bf16_t* XN, int nrows, int gw, int NGW, int lane) {
    for (int m = gw; m < nrows; m += NGW) {
        f32x4 xv[4];
#pragma unroll
        for (int j = 0; j < 4; ++j) xv[j] = *((const f32x4*)(xin + (size_t)m * DM) + lane + 64 * j);
        if (Y) {
            f32x4 yv[4]; float ss = 0.f;
#pragma unroll
            for (int j = 0; j < 4; ++j) { const u32x2 yw = *((const u32x2*)(Y + (size_t)m * DM) + lane + 64 * j); yv[j] = (f32x4){bflo(yw.x), bfhi(yw.x), bflo(yw.y), bfhi(yw.y)};
                ss += (yv[j].x * yv[j].x + yv[j].y * yv[j].y) + (yv[j].z * yv[j].z + yv[j].w * yv[j].w); }
            const float r = coef / sqrtf(wave_sum(ss) * (1.0f / DM) + EPS);
#pragma unroll
            for (int j = 0; j < 4; ++j) { const f32x4 g = *((const f32x4*)gpost + lane + 64 * j); xv[j] = xv[j] + yv[j] * g * r; }
        }
        if (xout) {
#pragma unroll
            for (int j = 0; j < 4; ++j) *((f32x4*)(xout + (size_t)m * DM) + lane + 64 * j) = xv[j];
        }
        if (gnext) {
            float ss = 0.f;
#pragma unroll
            for (int j = 0; j < 4; ++j) ss += (xv[j].x * xv[j].x + xv[j].y * xv[j].y) + (xv[j].z * xv[j].z + xv[j].w * xv[j].w);
            const float r = 1.0f / sqrtf(wave_sum(ss) * (1.0f / DM) + EPS);
#pragma unroll
            for (int j = 0; j < 4; ++j) { const f32x4 g = *((const f32x4*)gnext + lane + 64 * j); const f32x4 o = xv[j] * g * r;
                u32x2 w; w.x = cvt_pk_bf16(o.x, o.y); w.y = cvt_pk_bf16(o.z, o.w);
                *((u32x2*)(XN + (size_t)m * DM) + lane + 64 * j) = w; }
        }
    }
}
__device__ __forceinline__ void prep_layer(karg_t kp, unsigned char* ws, int l, LAS unsigned char* lds, int gw, int NGW, int wave, int lane, int tid, int G, int bid) {
    LAS float* scr = (LAS float*)(lds + wave * 16384);
#pragma unroll
    for (int seg = 0; seg < NSEG; ++seg) {
        karg_t kq = kp; asm volatile("" : "+s"(kq) :: "memory");
        const TSeg s = get_seg(kq, ws, l, seg);
        const int nitems = (s.K / 64) * (s.ncols / 32);
        for (int it = gw; it < nitems; it += NGW) transpose_item(s, scr, it, lane);
    }
    const int gt = bid * NTHREADS + tid, NGT = G * NTHREADS;
    { const float* pw = AIN(I_POOLW) + (size_t)l * 4 * 128 * 128; const float* psc = AIN(I_POOLS) + (size_t)l * 512; const float* wb = AIN(I_WBRP) + (size_t)l * 512 * DM;
      bf16_t* out = (bf16_t*)(ws + WS_WCOMB);
      for (int o = gt; o < 128 * DM; o += NGT) { const int n = o & (DM - 1), c = o >> 10; float s0 = 0.f, s1 = 0.f, s2 = 0.f, s3 = 0.f;
          const float* pr = pw + (size_t)c * 128;
#pragma unroll 8
          for (int d = 0; d < 128; ++d) {
              s0 += pr[d] * psc[d] * wb[(size_t)d * DM + n];
              s1 += pr[16384 + d] * psc[128 + d] * wb[(size_t)(128 + d) * DM + n];
              s2 += pr[32768 + d] * psc[256 + d] * wb[(size_t)(256 + d) * DM + n];
              s3 += pr[49152 + d] * psc[384 + d] * wb[(size_t)(384 + d) * DM + n]; }
          bf16_t* op = out + (size_t)n * 512 + c;
          op[0] = (bf16_t)(cvt_pk_bf16(s0, 0.f) & 0xffffu); op[128] = (bf16_t)(cvt_pk_bf16(s1, 0.f) & 0xffffu); op[256] = (bf16_t)(cvt_pk_bf16(s2, 0.f) & 0xffffu); op[384] = (bf16_t)(cvt_pk_bf16(s3, 0.f) & 0xffffu); } }
    { const float* gws = AIN(I_GWS) + (size_t)l * 4 * 128 * 128; bf16_t* out = (bf16_t*)(ws + WS_GWS);
      for (int o = gt; o < 4 * 128 * 128; o += NGT) { const int s2 = o & 127, t = (o >> 7) & 127; const float v = (s2 <= t) ? gws[o] : 0.f; out[o] = (bf16_t)(cvt_pk_bf16(v, 0.f) & 0xffffu); } }
    { const float* b = AIN(I_BIN) + (size_t)l * INC; float* out = (float*)(ws + WS_BIASIN);
      for (int o = gt; o < 3072; o += NGT) out[o] = o < 1792 ? b[o] : (o < 2816 ? b[o + 24] : (o < 2840 ? b[1792 + o - 2816] : 0.f)); }
    row_pass(nullptr, nullptr, 0.f, AIN(I_MEM), nullptr, AIN(I_MEM_KVG) + (size_t)l * DM, (bf16_t*)(ws + WS_MEMN), MM, gw, NGW, lane);
}
template <int W> __device__ __forceinline__ void pool_group(const bf16_t* ZA, bf16_t* P, int gi, int gt, int NGT) {
    for (int o = gt; o < MT * 16; o += NGT) {
        const int cc = gi * 16 + (o & 15), m = o >> 4, t = m & (SEQ - 1), cnt = (t + 1 < W) ? t + 1 : W;
        u32x4 v[W];
#pragma unroll
        for (int i = 0; i < W; ++i) v[i] = (i < cnt) ? *(const u32x4*)(ZA + (size_t)(m - i) * 512 + cc * 8) : (u32x4){0u, 0u, 0u, 0u};
        float s[8];
#pragma unroll
        for (int e = 0; e < 8; ++e) s[e] = 0.f;
#pragma unroll
        for (int i = 0; i < W; ++i) { s[0] += bflo(v[i].x); s[1] += bfhi(v[i].x); s[2] += bflo(v[i].y); s[3] += bfhi(v[i].y); s[4] += bflo(v[i].z); s[5] += bfhi(v[i].z); s[6] += bflo(v[i].w); s[7] += bfhi(v[i].w); }
        const float inv = 1.0f / (float)cnt; const u32x4 self = v[0];
        u32x4 r; r.x = cvt_pk_bf16(s[0] * inv - bflo(self.x), s[1] * inv - bfhi(self.x)); r.y = cvt_pk_bf16(s[2] * inv - bflo(self.y), s[3] * inv - bfhi(self.y));
        r.z = cvt_pk_bf16(s[4] * inv - bflo(self.z), s[5] * inv - bfhi(self.z)); r.w = cvt_pk_bf16(s[6] * inv - bflo(self.w), s[7] * inv - bfhi(self.w));
        *(u32x4*)(P + (size_t)m * 512 + cc * 8) = r;
    }
}
__device__ __forceinline__ void pool_pass(const bf16_t* ZA, bf16_t* P, int gt, int NGT) {
    pool_group<2>(ZA, P, 0, gt, NGT); pool_group<4>(ZA, P, 1, gt, NGT); pool_group<8>(ZA, P, 2, gt, NGT); pool_group<16>(ZA, P, 3, gt, NGT);
}
__device__ __forceinline__ void compress_unit(int unit, const bf16_t* ZKV, const bf16_t* W1t_k, const bf16_t* W1t_v, const bf16_t* W2t_k, const bf16_t* W2t_v, const float* pos_k, const float* pos_v,
                                              bf16_t* KC, bf16_t* VC, LAS unsigned char* lds, int wave, int lane) {
    const int which = unit & 1, nc = (unit >> 1) & 7, g = (unit >> 4) & 1, b = unit >> 5;
    const int r16 = lane & 15, quad = lane >> 4;
    const bf16_t* W1t = which ? W1t_v : W1t_k; const bf16_t* W2t = which ? W2t_v : W2t_k;
    const int n = nc * 16 + r16, ne = n < 127 ? n : 126;
    const bf16_t* arow = ZKV + ((size_t)b * SEQ + 16 * ne) * 768 + which * 128 + g * 64 + quad * 8;
    const bf16_t* b0 = W1t + (size_t)(wave * 32 + r16) * 2048 + quad * 8; const bf16_t* b1 = b0 + (size_t)16 * 2048;
    f32x4 acc0 = (f32x4){0.f, 0.f, 0.f, 0.f}, acc1 = acc0;
    const float* pos = (which ? pos_v : pos_k) + quad * 8;
#pragma unroll 8
    for (int ks = 0; ks < 64; ++ks) {
        const u32x4 ar = *(const u32x4*)(arow + (size_t)(ks >> 1) * 768 + (ks & 1) * 32);
        const f32x4 p0 = *(const f32x4*)(pos + ks * 32), p1 = *(const f32x4*)(pos + ks * 32 + 4);
        const bf16x8 bf0 = *(const bf16x8*)(b0 + ks * 32), bf1 = *(const bf16x8*)(b1 + ks * 32);
        u32x4 aw; aw.x = cvt_pk_bf16(bflo(ar.x) + p0.x, bfhi(ar.x) + p0.y); aw.y = cvt_pk_bf16(bflo(ar.y) + p0.z, bfhi(ar.y) + p0.w);
        aw.z = cvt_pk_bf16(bflo(ar.z) + p1.x, bfhi(ar.z) + p1.y); aw.w = cvt_pk_bf16(bflo(ar.w) + p1.z, bfhi(ar.w) + p1.w);
        const bf16x8 af = __builtin_bit_cast(bf16x8, aw);
        acc0 = MFMA16(af, bf0, acc0); acc1 = MFMA16(af, bf1, acc1);
    }
    LAS bf16_t* Hs = (LAS bf16_t*)lds;
    {
#pragma unroll
      for (int i = 0; i < 4; ++i) { const int row = quad * 4 + i;
          Hs[row * 264 + wave * 32 + r16] = (bf16_t)(cvt_pk_bf16(pg8::fgelu_tanh(acc0[i]), 0.f) & 0xffffu);
          Hs[row * 264 + wave * 32 + 16 + r16] = (bf16_t)(cvt_pk_bf16(pg8::fgelu_tanh(acc1[i]), 0.f) & 0xffffu); } }
    __syncthreads();
    if (wave < 4) {
        f32x4 acc = (f32x4){0.f, 0.f, 0.f, 0.f};
#pragma unroll
        for (int ks = 0; ks < 8; ++ks) {
            const bf16x8 af = *(const LAS bf16x8*)(Hs + r16 * 264 + ks * 32 + quad * 8);
            const bf16x8 bfr = *(const bf16x8*)(W2t + (size_t)(wave * 16 + r16) * 256 + ks * 32 + quad * 8);
            acc = MFMA16(af, bfr, acc);
        }
        f32x4 v = acc;
#pragma unroll
        for (int i = 0; i < 4; ++i) if (nc * 16 + quad * 4 + i >= 127) v[i] = 0.f;
        if (which) {
            u32x2 w; w.x = cvt_pk_bf16(v[0], v[1]); w.y = cvt_pk_bf16(v[2], v[3]);
            *(u32x2*)(VC + ((size_t)(b * 2 + g) * 64 + wave * 16 + r16) * 128 + nc * 16 + quad * 4) = w;
        } else {
            bf16_t* out = KC + ((size_t)(b * 2 + g) * 128 + nc * 16) * 64 + wave * 16 + r16;
#pragma unroll
            for (int i = 0; i < 4; ++i) out[(size_t)(quad * 4 + i) * 64] = (bf16_t)(cvt_pk_bf16(v[i], 0.f) & 0xffffu);
        }
    }
    __syncthreads();
}
__device__ __forceinline__ void gmlp_unit(int unit, const bf16_t* ZGM, const bf16_t* Wg, const float* lng, const float* lnb, const float* bs, bf16_t* U, LAS unsigned char* lds, int wave, int lane, int tid) {
    const int gq = unit & 3, c = unit >> 2, m0 = c * 128;
    LAS bf16_t* Vt = (LAS bf16_t*)lds;
    LAS float* st = (LAS float*)(lds + 128 * 136 * 2);
#pragma unroll
    for (int i = 0; i < 16; ++i) { const int tok = wave * 16 + i;
        const u32x4 v = *(const u32x4*)(ZGM + (size_t)(m0 + tok) * 1024 + 512 + lane * 8);
        float f[8] = {bflo(v.x), bfhi(v.x), bflo(v.y), bfhi(v.y), bflo(v.z), bfhi(v.z), bflo(v.w), bfhi(v.w)};
        float s = 0.f;
#pragma unroll
        for (int j = 0; j < 8; ++j) s += f[j];
        const float mean = wave_sum(s) * (1.0f / 512.f); float q = 0.f;
#pragma unroll
        for (int j = 0; j < 8; ++j) { const float d = f[j] - mean; q += d * d; }
        const float rstd = 1.0f / sqrtf(wave_sum(q) * (1.0f / 512.f) + EPS);
        if (lane == 0) { st[tok * 2] = mean; st[tok * 2 + 1] = rstd; } }
    __syncthreads();
    { const int tok = tid >> 2, part = tid & 3; const float mean = st[tok * 2], rstd = st[tok * 2 + 1];
#pragma unroll
      for (int q4 = 0; q4 < 4; ++q4) { const int d0 = part * 32 + q4 * 8, ch = gq * 128 + d0;
          const u32x4 v = *(const u32x4*)(ZGM + (size_t)(m0 + tok) * 1024 + 512 + ch);
          const f32x4 g0 = *(const f32x4*)(lng + ch), g1 = *(const f32x4*)(lng + ch + 4), b0 = *(const f32x4*)(lnb + ch), b1 = *(const f32x4*)(lnb + ch + 4);
          float f[8] = {bflo(v.x), bfhi(v.x), bflo(v.y), bfhi(v.y), bflo(v.z), bfhi(v.z), bflo(v.w), bfhi(v.w)};
          float gg[8] = {g0.x, g0.y, g0.z, g0.w, g1.x, g1.y, g1.z, g1.w}, bb[8] = {b0.x, b0.y, b0.z, b0.w, b1.x, b1.y, b1.z, b1.w};
#pragma unroll
          for (int j = 0; j < 8; ++j) Vt[(d0 + j) * 136 + tok] = (bf16_t)(cvt_pk_bf16((f[j] - mean) * rstd * gg[j] + bb[j], 0.f) & 0xffffu); } }
    __syncthreads();
    { const int r16 = lane & 15, quad = lane >> 4, t = wave * 16 + r16;
      f32x4 acc[8];
#pragma unroll
      for (int dt = 0; dt < 8; ++dt) acc[dt] = (f32x4){0.f, 0.f, 0.f, 0.f};
      const int nks = (wave * 16 + 15) / 32 + 1;
      for (int ks = 0; ks < nks; ++ks) {
          const bf16x8 bfr = *(const bf16x8*)(Wg + ((size_t)gq * 128 + t) * 128 + ks * 32 + quad * 8);
#pragma unroll
          for (int dt = 0; dt < 8; ++dt) { const bf16x8 af = *(const LAS bf16x8*)(Vt + (dt * 16 + r16) * 136 + ks * 32 + quad * 8); acc[dt] = MFMA16(af, bfr, acc[dt]); }
      }
      const float bias = bs[gq * 128 + t];
#pragma unroll
      for (int dt = 0; dt < 8; ++dt) { const int d = gq * 128 + dt * 16 + quad * 4;
          const u32x2 uu = *(const u32x2*)(ZGM + (size_t)(m0 + t) * 1024 + d);
          u32x2 w; w.x = cvt_pk_bf16(bflo(uu.x) * (acc[dt][0] + bias), bfhi(uu.x) * (acc[dt][1] + bias)); w.y = cvt_pk_bf16(bflo(uu.y) * (acc[dt][2] + bias), bfhi(uu.y) * (acc[dt][3] + bias));
          *(u32x2*)(U + (size_t)(m0 + t) * 512 + d) = w; } }
    __syncthreads();
}
template <int D> struct KVRegs { u32x4 k[D / 64], v[D / 64]; };
template <int D> __device__ __forceinline__ void kv_load(KVRegs<D>& R, const bf16_t* Kg, int ldk, const bf16_t* Vg, int ldv, int tid) {
#pragma unroll
    for (int i = 0; i < D / 64; ++i) { const int c = tid + i * NTHREADS;
        { const int r = c / (D / 8), cc = c % (D / 8); R.k[i] = *(const u32x4*)(Kg + (size_t)r * ldk + cc * 8); }
        { const int d = c >> 3, cc = c & 7; R.v[i] = *(const u32x4*)(Vg + (size_t)d * ldv + cc * 8); } }
}
template <int D> __device__ __forceinline__ void kv_store(const KVRegs<D>& R, LAS bf16_t* Ks, LAS bf16_t* Vt, int tid) {
#pragma unroll
    for (int i = 0; i < D / 64; ++i) { const int c = tid + i * NTHREADS;
        { const int r = c / (D / 8), cc = c % (D / 8); *(LAS u32x4*)(Ks + r * (D + 8) + cc * 8) = R.k[i]; }
        { const int d = c >> 3, cc = c & 7; *(LAS u32x4*)(Vt + d * 72 + cc * 8) = R.v[i]; } }
}
template <int D, int QS, class MaskF>
__device__ __forceinline__ void flash_block(const LAS bf16_t* Ks, const LAS bf16_t* Vt, const bf16x8 (&qf)[QS][D / 32], f32x4 (&acc)[QS][D / 16], float (&mrun)[QS], float (&lrun)[QS], const MaskF& allowed, int lane) {
    const int r16 = lane & 15, quad = lane >> 4;
#pragma unroll
    for (int qs = 0; qs < QS; ++qs) {
        f32x4 s[4];
#pragma unroll
        for (int kt = 0; kt < 4; ++kt) { s[kt] = (f32x4){0.f, 0.f, 0.f, 0.f};
#pragma unroll
            for (int ks = 0; ks < D / 32; ++ks) { const bf16x8 kf = *(const LAS bf16x8*)(Ks + (kt * 16 + r16) * (D + 8) + ks * 32 + quad * 8); s[kt] = MFMA16(kf, qf[qs][ks], s[kt]); } }
        float mx = -1e30f;
#pragma unroll
        for (int kt = 0; kt < 4; ++kt)
#pragma unroll
            for (int i = 0; i < 4; ++i) { const bool ok = allowed(qs, kt * 16 + quad * 4 + i); const float v = ok ? s[kt][i] * LOG2E : -1e30f; s[kt][i] = v; mx = fmaxf(mx, v); }
        mx = fmaxf(mx, __shfl_xor(mx, 16)); mx = fmaxf(mx, __shfl_xor(mx, 32));
        const float mnew = fmaxf(mrun[qs], mx), alpha = __builtin_amdgcn_exp2f(mrun[qs] - mnew); mrun[qs] = mnew;
        float ps = 0.f;
#pragma unroll
        for (int kt = 0; kt < 4; ++kt)
#pragma unroll
            for (int i = 0; i < 4; ++i) { const float p = (s[kt][i] > -1e29f) ? __builtin_amdgcn_exp2f(s[kt][i] - mnew) : 0.f; s[kt][i] = p; ps += p; }
        ps += __shfl_xor(ps, 16); ps += __shfl_xor(ps, 32);
        lrun[qs] = lrun[qs] * alpha + ps;
        bf16x8 pf[2];
#pragma unroll
        for (int kk = 0; kk < 2; ++kk) { u32x4 w; w.x = cvt_pk_bf16(s[2 * kk][0], s[2 * kk][1]); w.y = cvt_pk_bf16(s[2 * kk][2], s[2 * kk][3]); w.z = cvt_pk_bf16(s[2 * kk + 1][0], s[2 * kk + 1][1]); w.w = cvt_pk_bf16(s[2 * kk + 1][2], s[2 * kk + 1][3]);
            pf[kk] = __builtin_bit_cast(bf16x8, w); }
#pragma unroll
        for (int dt = 0; dt < D / 16; ++dt) { acc[qs][dt] = acc[qs][dt] * alpha;
#pragma unroll
            for (int kk = 0; kk < 2; ++kk) { const LAS bf16_t* vp = Vt + (dt * 16 + r16) * 72 + kk * 32 + quad * 4;
                const s16x4 lo = *(const LAS s16x4*)vp, hi = *(const LAS s16x4*)(vp + 16);
                const bf16x8 vf = __builtin_shufflevector(lo, hi, 0, 1, 2, 3, 4, 5, 6, 7);
                acc[qs][dt] = MFMA16(vf, pf[kk], acc[qs][dt]); } }
    }
}
constexpr int NSA_KS = 0, NSA_VT = 18432, NSA_IMP = NSA_VT + 17408, NSA_SEL = NSA_IMP + 32768, NSA_UNI = NSA_SEL + 256;
__device__ __forceinline__ void nsa_unit(int unit, const bf16_t* ZQ, const bf16_t* ZKV, const bf16_t* ZG, const bf16_t* KC, const bf16_t* VCT, const bf16_t* VTS, const bf16_t* VTW, bf16_t* O,
                                         LAS unsigned char* lds, int wave, int lane, int tid) {
    const int qb = unit & 63, g = (unit >> 6) & 1, b = unit >> 7, cur = qb >> 1;
    const int r16 = lane & 15, quad = lane >> 4, hh = wave & 3, h = g * 4 + hh, t0 = qb * 32;
    LAS bf16_t* Ks = (LAS bf16_t*)(lds + NSA_KS); LAS bf16_t* Vt = (LAS bf16_t*)(lds + NSA_VT);
    LAS float* impS = (LAS float*)(lds + NSA_IMP); LAS unsigned* selS = (LAS unsigned*)(lds + NSA_SEL); LAS unsigned* uniS = (LAS unsigned*)(lds + NSA_UNI);
    const int tok = (wave >> 2) * 16 + r16, tq = t0 + tok;
    const size_t row = (size_t)b * SEQ + tq;
    bf16x8 qf[1][2]; float gate[3];
#pragma unroll
    for (int ks = 0; ks < 2; ++ks) qf[0][ks] = *(const bf16x8*)(ZQ + row * 512 + h * 64 + ks * 32 + quad * 8);
#pragma unroll
    for (int c = 0; c < 3; ++c) gate[c] = fsigmoid(__uint_as_float((unsigned)ZG[row * 32 + h * 3 + c] << 16));
    const bf16_t* Kslc = ZKV + ((size_t)b * SEQ) * 768 + 2 * 128 + g * 64; const bf16_t* Kwin = Kslc + 2 * 128;
    const bf16_t* Vslc = VTS + (size_t)(b * 2 + g) * 64 * 2048; const bf16_t* Vwin = VTW + (size_t)(b * 2 + g) * 64 * 2048;
    KVRegs<64> R, R1;
    kv_load<64>(R, Kslc, 768, Vslc, 2048, tid);
    f32x4 outv[4];
    { const bf16_t* Kg = KC + (size_t)(b * 2 + g) * 128 * 64; const bf16_t* Vg = VCT + (size_t)(b * 2 + g) * 64 * 128;
#pragma unroll
      for (int i = 0; i < 2; ++i) { const int c = tid + i * NTHREADS;
          { const int r = c >> 3, cc = c & 7; *(LAS u32x4*)(Ks + r * 72 + cc * 8) = *(const u32x4*)(Kg + r * 64 + cc * 8); }
          { const int d = c >> 4, cc = c & 15; *(LAS u32x4*)(Vt + d * 136 + cc * 8) = *(const u32x4*)(Vg + d * 128 + cc * 8); } }
      if (tid == 0) uniS[0] = 0u;
      __syncthreads();
      {
          f32x4 s[8]; float mx = -1e30f;
#pragma unroll
          for (int kt = 0; kt < 8; ++kt) { s[kt] = (f32x4){0.f, 0.f, 0.f, 0.f};
#pragma unroll
              for (int ks = 0; ks < 2; ++ks) { const bf16x8 kf = *(const LAS bf16x8*)(Ks + (kt * 16 + r16) * 72 + ks * 32 + quad * 8); s[kt] = MFMA16(kf, qf[0][ks], s[kt]); }
#pragma unroll
              for (int i = 0; i < 4; ++i) { const int n = kt * 16 + quad * 4 + i; const bool ok = (n < 127) && (16 * n + 31 <= tq); const float v = ok ? s[kt][i] * LOG2E : -1e30f; s[kt][i] = v; mx = fmaxf(mx, v); } }
          mx = fmaxf(mx, __shfl_xor(mx, 16)); mx = fmaxf(mx, __shfl_xor(mx, 32));
          float ps = 0.f;
#pragma unroll
          for (int kt = 0; kt < 8; ++kt)
#pragma unroll
              for (int i = 0; i < 4; ++i) { const float p = (s[kt][i] > -1e29f) ? __builtin_amdgcn_exp2f(s[kt][i] - mx) : 0.f; s[kt][i] = p; ps += p; }
          ps += __shfl_xor(ps, 16); ps += __shfl_xor(ps, 32);
          const float inv = ps > 0.f ? 1.0f / ps : 0.f;
          float so_prev = 0.f; const int src = (lane - 16) & 63;
#pragma unroll
          for (int kt = 0; kt < 8; ++kt) { s[kt] = s[kt] * inv;
              const float so = 0.5f * s[kt][3]; const float a1 = __shfl(so, src), a2 = __shfl(so_prev, src);
              const float v = (s[kt][0] + s[kt][1]) + (s[kt][2] + so) + (quad > 0 ? a1 : a2);
              impS[(hh * 32 + tok) * 32 + kt * 4 + quad] = v; so_prev = so; }
          f32x4 acc[4];
#pragma unroll
          for (int dt = 0; dt < 4; ++dt) acc[dt] = (f32x4){0.f, 0.f, 0.f, 0.f};
#pragma unroll
          for (int kk = 0; kk < 4; ++kk) { u32x4 w; w.x = cvt_pk_bf16(s[2 * kk][0], s[2 * kk][1]); w.y = cvt_pk_bf16(s[2 * kk][2], s[2 * kk][3]); w.z = cvt_pk_bf16(s[2 * kk + 1][0], s[2 * kk + 1][1]); w.w = cvt_pk_bf16(s[2 * kk + 1][2], s[2 * kk + 1][3]);
              const bf16x8 pf = __builtin_bit_cast(bf16x8, w);
#pragma unroll
              for (int dt = 0; dt < 4; ++dt) { const LAS bf16_t* vp = Vt + (dt * 16 + r16) * 136 + kk * 32 + quad * 4;
                  const s16x4 lo = *(const LAS s16x4*)vp, hi = *(const LAS s16x4*)(vp + 16);
                  acc[dt] = MFMA16(__builtin_shufflevector(lo, hi, 0, 1, 2, 3, 4, 5, 6, 7), pf, acc[dt]); } }
#pragma unroll
          for (int dt = 0; dt < 4; ++dt) outv[dt] = acc[dt] * gate[0];
      }
      __syncthreads();
#pragma unroll 1
      for (int pass = 0; pass < 2; ++pass) {
          const int tk = wave * 4 + pass * 2 + (lane >> 5), j = lane & 31;
          const float imp = (impS[tk * 32 + j] + impS[(32 + tk) * 32 + j]) + (impS[(64 + tk) * 32 + j] + impS[(96 + tk) * 32 + j]);
          const bool forced = (j == 0) || (j == cur) || (j == cur - 1);
          unsigned sel = 1u | (1u << cur) | (cur > 0 ? (1u << (cur - 1)) : 0u);
          unsigned key = forced ? 0u : ((j <= cur ? (0x80000000u | (__float_as_uint(imp) & 0x7fffffe0u)) : 0u) | (unsigned)(31 - j));
          const int nr = 8 - __builtin_popcount(sel);
#pragma unroll 1
          for (int rnd = 0; rnd < nr; ++rnd) { unsigned bk = key;
#pragma unroll
              for (int off = 16; off >= 1; off >>= 1) { const unsigned ok = (unsigned)__shfl_xor((int)bk, off); bk = ok > bk ? ok : bk; }
              const int bj = 31 - (int)(bk & 31u);
              sel |= 1u << bj; if (j == bj) key = 0u; }
          if (j == 0) { selS[tk] = sel; atomicOr((unsigned*)uniS, sel); } }
      __syncthreads();
    }
    const unsigned selm = selS[tok];
    unsigned todo = (unsigned)__builtin_amdgcn_readfirstlane((int)uniS[0]) & ((2u << cur) - 1u) & ~1u;
    int jwn = (cur > 4 ? cur - 4 : 0);
    f32x4 acc[1][4]; float mrun[1], lrun[1];
#define NSA_RESET() do { mrun[0] = -1e30f; lrun[0] = 0.f; _Pragma("unroll") for (int dt = 0; dt < 4; ++dt) acc[0][dt] = (f32x4){0.f, 0.f, 0.f, 0.f}; } while (0)
#define NSA_ACCUM(c) do { const float f = (lrun[0] > 0.f ? 1.0f / lrun[0] : 0.f) * gate[c]; _Pragma("unroll") for (int dt = 0; dt < 4; ++dt) outv[dt] = outv[dt] + acc[0][dt] * f; } while (0)
#define NSA_NEXT(jv, wv) do { if (todo) { jv = __builtin_ctz(todo); todo &= todo - 1u; wv = 0; } else if (jwn <= cur) { jv = jwn++; wv = 1; } else { jv = -1; wv = 1; } } while (0)
#define NSA_LOAD(RR, jv, wv) kv_load<64>(RR, ((wv) ? Kwin : Kslc) + (size_t)(jv) * 64 * 768, 768, ((wv) ? Vwin : Vslc) + (jv) * 64, 2048, tid)
    int j0 = 0, w0 = 0, j1, w1;
    NSA_NEXT(j1, w1); NSA_LOAD(R1, j1, w1);
    NSA_RESET(); bool in_win = false;
#define NSA_STEP(RS) do { \
        if (w0 && !in_win) { NSA_ACCUM(1); NSA_RESET(); in_win = true; } \
        kv_store<64>(RS, Ks, Vt, tid); \
        __syncthreads(); \
        int j2, w2; NSA_NEXT(j2, w2); \
        if (j2 >= 0) NSA_LOAD(RS, j2, w2); \
        { const int jj = j0; const bool ww = (w0 != 0); \
          auto mask = [=](int, int kl) { const int kp = jj * 64 + kl; return (kp <= tq) && (ww ? (kp + 256 > tq) : (((selm >> jj) & 1u) != 0u)); }; \
          flash_block<64, 1>(Ks, Vt, qf, acc, mrun, lrun, mask, lane); } \
        __syncthreads(); \
        j0 = j1; w0 = w1; j1 = j2; w1 = w2; } while (0)
#pragma unroll 1
    for (;;) { NSA_STEP(R); if (j0 < 0) break; NSA_STEP(R1); if (j0 < 0) break; }
#undef NSA_STEP
    NSA_ACCUM(2);
#undef NSA_RESET
#undef NSA_ACCUM
#undef NSA_NEXT
#undef NSA_LOAD
#pragma unroll
    for (int dt = 0; dt < 4; ++dt) { u32x2 w; w.x = cvt_pk_bf16(outv[dt][0], outv[dt][1]); w.y = cvt_pk_bf16(outv[dt][2], outv[dt][3]);
        *(u32x2*)(O + row * 512 + h * 64 + dt * 16 + quad * 4) = w; }
}
__device__ __forceinline__ void cross_unit(int unit, const bf16_t* QX, const bf16_t* KM, const bf16_t* VTM, bf16_t* OX, LAS unsigned char* lds, int wave, int lane, int tid) {
    const int qblk = unit & 15, hd = (unit >> 4) & 3, b = unit >> 6;
    const int r16 = lane & 15, quad = lane >> 4;
    LAS bf16_t* Ks = (LAS bf16_t*)lds; LAS bf16_t* Vt = (LAS bf16_t*)(lds + 64 * 264 * 2);
    const size_t row = (size_t)b * SEQ + qblk * 128 + wave * 16 + r16;
    const bf16_t* Kg = KM + ((size_t)b * MEML) * 2048 + hd * 256; const bf16_t* Vg = VTM + (size_t)(b * 4 + hd) * 256 * 256;
    KVRegs<256> R;
    kv_load<256>(R, Kg, 2048, Vg, 256, tid);
    bf16x8 qf[1][8];
#pragma unroll
    for (int ks = 0; ks < 8; ++ks) qf[0][ks] = *(const bf16x8*)(QX + row * DM + hd * 256 + ks * 32 + quad * 8);
    f32x4 acc[1][16]; float mrun[1] = {-1e30f}, lrun[1] = {0.f};
#pragma unroll
    for (int dt = 0; dt < 16; ++dt) acc[0][dt] = (f32x4){0.f, 0.f, 0.f, 0.f};
#pragma unroll 1
    for (int j = 0; j < 4; ++j) {
        kv_store<256>(R, Ks, Vt, tid);
        __syncthreads();
        if (j < 3) kv_load<256>(R, Kg + (size_t)(j + 1) * 64 * 2048, 2048, Vg + (j + 1) * 64, 256, tid);
        auto mask = [](int, int) { return true; };
        flash_block<256, 1>(Ks, Vt, qf, acc, mrun, lrun, mask, lane);
        __syncthreads();
    }
    const float inv = 1.0f / lrun[0];
#pragma unroll
    for (int dt = 0; dt < 16; ++dt) { const f32x4 o = acc[0][dt] * inv; u32x2 w; w.x = cvt_pk_bf16(o[0], o[1]); w.y = cvt_pk_bf16(o[2], o[3]);
        *(u32x2*)(OX + row * DM + hd * 256 + dt * 16 + quad * 4) = w; }
}
#define RLX_AGENT __ATOMIC_RELAXED, __HIP_MEMORY_SCOPE_AGENT
#define XB_TMO      128
#define XB_XCNT(j)  (256  + 64 * (j))
#define XB_XSUB(j)  (1280 + 64 * (j))
#define XB_XGEN(j)  (2304 + 64 * (j))
#define XB_TOP      3328
#define XB_TOPGEN   3392
#define XCD_BAR_WORDS 3456
#define XB_SPIN_CAP (1u << 18)

__device__ __forceinline__ unsigned xb_ld(unsigned* p)              { return __hip_atomic_load(p, __ATOMIC_RELAXED, __HIP_MEMORY_SCOPE_AGENT); }
__device__ __forceinline__ unsigned xb_add(unsigned* p, unsigned v) { return __hip_atomic_fetch_add(p, v, __ATOMIC_RELAXED, __HIP_MEMORY_SCOPE_AGENT); }
__device__ __forceinline__ unsigned xb_xcc_id() { return (unsigned)__builtin_amdgcn_s_getreg((3 << 11) | 20) & 0xFu; }
#define XB_SPIN(cond, bar) do { unsigned _sp = 0; while (cond) { __builtin_amdgcn_s_sleep(1); \
    if ((++_sp & 255u) == 0u) { if (xb_ld(&(bar)[XB_TMO])) break; if (_sp > XB_SPIN_CAP) { atomicAdd(&(bar)[XB_TMO], 1u); break; } } } } while (0)

struct XcdBarrier {
    unsigned* bar; unsigned x;
    volatile LAS unsigned* st;
};

__device__ __forceinline__ XcdBarrier xcd_barrier_post(unsigned* bar, volatile LAS unsigned* st) {
    XcdBarrier b; b.bar = bar; b.x = xb_xcc_id(); b.st = st;
    if (threadIdx.x == 0) (void)xb_add(&bar[XB_XCNT(b.x)], 1u);
    return b;
}
__device__ __forceinline__ void xcd_barrier_complete(unsigned* bar, unsigned x, unsigned& nloc, unsigned& nx) {
    const unsigned G = gridDim.x * gridDim.y * gridDim.z;
    unsigned sum, cnt, mine, sp = 0u;
    for (;;) {
        sum = 0u; cnt = 0u; mine = 0u;
#pragma unroll
        for (unsigned j = 0; j < 16; ++j) { const unsigned c = xb_ld(&bar[XB_XCNT(j)]); sum += c; cnt += (c > 0u) ? 1u : 0u; mine = (j == x) ? c : mine; }
        if (sum == G) break;
        __builtin_amdgcn_s_sleep(1);
        if ((++sp & 255u) == 0u) { if (xb_ld(&bar[XB_TMO])) break; if (sp > XB_SPIN_CAP) { atomicAdd(&bar[XB_TMO], 1u); break; } }
    }
    nloc = mine > 0u ? mine : 1u; nx = cnt > 0u ? cnt : 1u;
}

__device__ __forceinline__ void xcd_barrier(const XcdBarrier& b) {
    asm volatile("s_waitcnt vmcnt(0)" ::: "memory");
    __syncthreads();
    if (threadIdx.x == 0) {
        unsigned* bar = b.bar;
        __builtin_amdgcn_s_waitcnt(0);
        unsigned nloc = b.st[0], nx = b.st[1];
        if (nloc == 0u) { xcd_barrier_complete(bar, b.x, nloc, nx); b.st[0] = nloc; b.st[1] = nx; }
        const unsigned old = xb_add(&bar[XB_XSUB(b.x)], 1u);
        const unsigned gen = old / nloc;
        if (old + 1u == (gen + 1u) * nloc) {
            __builtin_amdgcn_fence(__ATOMIC_RELEASE, "agent");
            asm volatile("s_waitcnt vmcnt(0)" ::: "memory");
            const unsigned og = xb_add(&bar[XB_TOP], 1u);
            const unsigned tg = og / nx;
            if (og + 1u == (tg + 1u) * nx) xb_add(&bar[XB_TOPGEN], 1u);
            else XB_SPIN(xb_ld(&bar[XB_TOPGEN]) == tg, bar);
            __builtin_amdgcn_fence(__ATOMIC_ACQUIRE, "agent");
            xb_add(&bar[XB_XGEN(b.x)], 1u);
            asm volatile("s_waitcnt vmcnt(0)" ::: "memory");
        } else {
            XB_SPIN(xb_ld(&bar[XB_XGEN(b.x)]) == gen, bar);
            __builtin_amdgcn_fence(__ATOMIC_ACQUIRE, "agent");
            asm volatile("s_waitcnt vmcnt(0)" ::: "memory");
        }
    }
    __syncthreads();
}


template <class Epi> __device__ __forceinline__ void run_gemm(LAS unsigned char* lds, const bf16_t* A, const bf16_t* Bt, int M, int N, int K, int G, int c, const Epi& E) {
    asm volatile("" : "+s"(K), "+s"(N), "+s"(M));
    pg8::Gemm g{A, Bt, M, N, K}; pg8::StaticOrder S; S.init(M, N, G, c);
    pg8::gemm_phase<Epi, pg8::StaticOrder, true, true>(lds, g, S, E);
}
__global__ void __launch_bounds__(NTHREADS, 2) hybrid_fwd(Args args) {
    extern __shared__ __attribute__((aligned(16))) unsigned char lds_raw[];
    LAS unsigned char* lds = (LAS unsigned char*)lds_raw;
    bool rep_done = false; bool first = true; int nsync = 0;
    volatile LAS unsigned* bar_st = (volatile LAS unsigned*)(lds + (LDS_BYTES - 64));
    if (threadIdx.x < 16) bar_st[threadIdx.x] = 0u;
    __syncthreads();
    XcdBarrier xbar; xbar.bar = nullptr; xbar.x = 0; xbar.st = nullptr;
    for (int ph = args.ph_lo; ph < args.ph_hi; ) {
        int G = gridDim.x, bid = blockIdx.x; asm volatile("" : "+s"(G), "+s"(bid));
        int tid = threadIdx.x; asm volatile("" : "+v"(tid));
        const int lane = tid & 63, wave = __builtin_amdgcn_readfirstlane(tid >> 6);
        const int gw = bid * NWAVES + wave, NGW = G * NWAVES, gt = bid * NTHREADS + tid, NGT = G * NTHREADS;
        karg_t kp = (karg_t)__builtin_amdgcn_kernarg_segment_ptr(); asm volatile("" : "+s"(kp));
        unsigned char* ws = *(unsigned char* const __attribute__((address_space(4)))*)(kp + 8 * (N_IN + 1));
        float* X = *(float* const __attribute__((address_space(4)))*)(kp + 8 * N_IN); bf16_t* XN = (bf16_t*)(ws + WS_XN);
        if (!first) {
            asm volatile("s_waitcnt vmcnt(0)" ::: "memory");
            if (nsync == 0) { cg::this_grid().sync(); xbar = xcd_barrier_post((unsigned*)(*(unsigned char* const __attribute__((address_space(4)))*)((karg_t)__builtin_amdgcn_kernarg_segment_ptr() + 8 * (N_IN + 1))), bar_st); }
            else xcd_barrier(xbar);
            ++nsync; }
        first = false;
        const int l = ph == 0 ? 0 : (ph - 1) / PH_PER_LAYER, k = ph == 0 ? -1 : (ph - 1) % PH_PER_LAYER;
#define LP(idx, per) (AIN(idx) + (size_t)l * (per))
#ifndef PHM
#define PHM 0xFFFFFFFFu
#endif
#define EN(b) (((PHM) >> (b)) & 1u)
#ifndef REPEAT_MASK
#define REPEAT_MASK 0
#endif
#ifndef REPEAT_PREP
#define REPEAT_PREP 1
#endif
        if (EN(0) && k == -1) {
            for (int pr = 0; pr < REPEAT_PREP; ++pr) { prep_layer(kp, ws, 0, lds, gw, NGW, wave, lane, tid, G, bid); __syncthreads(); }
            row_pass(nullptr, nullptr, 0.f, AIN(I_X), X, AIN(I_FF1_PRE), XN, MT, gw, NGW, lane);
        } else if (EN(1) && (k == 0 || k == 14)) {
            pg8::EpiSwiGLU E{(bf16_t*)(ws + WS_H), DFF};
            run_gemm(lds, XN, (const bf16_t*)(ws + (k == 0 ? WS_W13A : WS_W13B)), MT, 2 * DFF, DM, G, bid, E);
        } else if (EN(3) && (k == 2 || k == 9 || k == 13 || k == 16)) {
            const bf16_t* Y; const float *gpost, *gnext; float coef;
            if (k == 2) { Y = (const bf16_t*)(ws + WS_YF); gpost = LP(I_FF1_POST, DM); gnext = LP(I_MIX_PRE, DM); coef = 0.5f; }
            else if (k == 9) { Y = (const bf16_t*)(ws + WS_YM); gpost = LP(I_MIX_POST, DM); gnext = LP(I_MEM_PRE, DM); coef = 1.0f; }
            else if (k == 13) { Y = (const bf16_t*)(ws + WS_YF); gpost = LP(I_MEM_POST, DM); gnext = LP(I_FF2_PRE, DM); coef = 1.0f; }
            else { Y = (const bf16_t*)(ws + WS_YF); gpost = LP(I_FF2_POST, DM); gnext = (l + 1 < DEPTH) ? AIN(I_FF1_PRE) + (size_t)(l + 1) * DM : nullptr; coef = 0.5f; }
            row_pass(Y, gpost, coef, X, X, gnext, XN, MT, gw, NGW, lane);
            if (k == 16 && l + 1 < DEPTH) for (int pr = 0; pr < REPEAT_PREP; ++pr) { prep_layer(kp, ws, l + 1, lds, gw, NGW, wave, lane, tid, G, bid); __syncthreads(); }
        } else if (EN(4) && (k == 3 || k == 6)) {
            const bool gt6 = (k == 6);
            pg8::EpiZin E{gt6 ? LP(I_BIN, INC) + 2840 : (const float*)(ws + WS_BIASIN), (bf16_t*)(ws + (gt6 ? WS_G : WS_ZA)), (bf16_t*)(ws + WS_ZQ), (bf16_t*)(ws + WS_ZKV), (bf16_t*)(ws + WS_ZGM), (bf16_t*)(ws + WS_ZG), gt6 ? 1 : 0, (bf16_t*)(ws + WS_VTS), (bf16_t*)(ws + WS_VTW)};
            run_gemm(lds, XN, (const bf16_t*)(ws + (gt6 ? WS_WMG : WS_WIN)), MT, 3072, DM, G, bid, E);
        } else if (EN(5) && k == 4) {
            for (int u = bid; u < 256; u += G)
                compress_unit(u, (const bf16_t*)(ws + WS_ZKV), (const bf16_t*)(ws + WS_W1K), (const bf16_t*)(ws + WS_W1V), (const bf16_t*)(ws + WS_W2K), (const bf16_t*)(ws + WS_W2V),
                              LP(I_CPK, 2048), LP(I_CPV, 2048), (bf16_t*)(ws + WS_KC), (bf16_t*)(ws + WS_VC), lds, wave, lane);
            pool_pass((const bf16_t*)(ws + WS_ZA), (bf16_t*)(ws + WS_P), gt, NGT);
            for (int u = bid; u < 512; u += G)
                gmlp_unit(u, (const bf16_t*)(ws + WS_ZGM), (const bf16_t*)(ws + WS_GWS), LP(I_GLNG, 512), LP(I_GLNB, 512), LP(I_GBS, 512), (bf16_t*)(ws + WS_U), lds, wave, lane, tid);
        } else if (EN(6) && k == 5) {
            for (int u = bid, it = 0; u < 1024; u += G, ++it) { const int uu = (u & ~63) | ((it & 1) ? (u & 63) : 63 - (u & 63));
                nsa_unit(uu, (const bf16_t*)(ws + WS_ZQ), (const bf16_t*)(ws + WS_ZKV), (const bf16_t*)(ws + WS_ZG), (const bf16_t*)(ws + WS_KC), (const bf16_t*)(ws + WS_VC), (const bf16_t*)(ws + WS_VTS), (const bf16_t*)(ws + WS_VTW), (bf16_t*)(ws + WS_O), lds, wave, lane, tid);
                __syncthreads(); }
        } else if (EN(8) && k == 7) {
#ifndef MERGE_MASK
#define MERGE_MASK 7
#endif
            int nacc = 0;
            for (int i = 0; i < 3; ++i) {
                if (!((MERGE_MASK >> i) & 1)) continue;
                const bf16_t* A = (const bf16_t*)(ws + (i == 0 ? WS_P : (i == 1 ? WS_O : WS_U)));
                const bf16_t* Bt = (const bf16_t*)(ws + (i == 0 ? WS_WCOMB : (i == 1 ? WS_WBRN : WS_WBRG)));
                pg8::EpiMerge E{(const bf16_t*)(ws + WS_G), i * 1024, (bf16_t*)(ws + WS_MRG), nacc}; nacc = 1;
#ifdef PROBE_BF16S
                { pg8::EpiBf16S E2{(bf16_t*)(ws + WS_MRG), DM, 1.0f, nullptr}; run_gemm(lds, A, Bt, MT, DM, 512, G, bid, E2); }
#else
                run_gemm(lds, A, Bt, MT, DM, 512, G, bid, E);
#endif
                asm volatile("s_waitcnt vmcnt(0)" ::: "memory"); __builtin_amdgcn_fence(__ATOMIC_RELEASE, "agent"); __syncthreads(); __builtin_amdgcn_fence(__ATOMIC_ACQUIRE, "agent");
            }
        } else if (k == 10) {
        } else if (EN(9) && k == 11) {
            for (int u = bid; u < 512; u += G) { cross_unit(u, (const bf16_t*)(ws + WS_QX), (const bf16_t*)(ws + WS_KVM), (const bf16_t*)(ws + WS_VTM), (bf16_t*)(ws + WS_OX), lds, wave, lane, tid); __syncthreads(); }
        }
        if (EN(10) && (k == 0 || k == 10 || k == 1 || k == 15 || k == 8 || k == 12)) {
            const bf16_t* A; const bf16_t* Bt; bf16_t* Oo; bf16_t* vt = nullptr; int M = MT, N = DM, K = DM, ldc = DM, c = bid; float sc = 1.0f;
            if (k == 0) { A = (const bf16_t*)(ws + WS_MEMN); Bt = (const bf16_t*)(ws + WS_WKV); Oo = (bf16_t*)(ws + WS_KVM); vt = (bf16_t*)(ws + WS_VTM); M = MM; N = 2048; ldc = 2048; c = (bid + G / 2) % G; }
            else if (k == 10) { A = XN; Bt = (const bf16_t*)(ws + WS_WQ); Oo = (bf16_t*)(ws + WS_QX); sc = 0.0625f; }
            else if (k == 1) { A = (const bf16_t*)(ws + WS_H); Bt = (const bf16_t*)(ws + WS_W2A); K = DFF; Oo = (bf16_t*)(ws + WS_YF); }
            else if (k == 15) { A = (const bf16_t*)(ws + WS_H); Bt = (const bf16_t*)(ws + WS_W2B); K = DFF; Oo = (bf16_t*)(ws + WS_YF); }
            else if (k == 8) { A = (const bf16_t*)(ws + WS_MRG); Bt = (const bf16_t*)(ws + WS_WMIX); Oo = (bf16_t*)(ws + WS_YM); }
            else { A = (const bf16_t*)(ws + WS_OX); Bt = (const bf16_t*)(ws + WS_WO); Oo = (bf16_t*)(ws + WS_YF); }
            pg8::EpiBf16S E{Oo, ldc, sc, vt};
            run_gemm(lds, A, Bt, M, N, K, G, c, E);
        }
#undef LP
        if (((REPEAT_MASK >> (k + 1)) & 1) && !rep_done) { rep_done = true; } else { rep_done = false; ++ph; }
    }
}

__global__ void dump_kernel(const unsigned short* src, float* out, size_t n, size_t ld_src, size_t cols) {
    for (size_t i = (size_t)blockIdx.x * blockDim.x + threadIdx.x; i < n; i += (size_t)gridDim.x * blockDim.x) { const size_t r = i / cols, c = i % cols; out[i] = ld_src == 0 ? ((const float*)src)[i] : __uint_as_float((unsigned)src[r * ld_src + c] << 16); }
}
#ifndef MK_SPLIT
#define MK_SPLIT 0
#endif
extern "C" void kernel_launch(void* const* d_in, const int* in_sizes, int n_in, void* d_out, int out_size, void* d_ws, size_t ws_size, hipStream_t stream) {
    static int grid = 0;
    if (grid == 0) {
        if (n_in != N_IN || out_size != MT * DM || ws_size < WS_END) { fprintf(stderr, "kernel_launch: unexpected shapes (n_in %d out %d ws %zu)\n", n_in, out_size, ws_size); grid = -1; return; }
        int dev = 0, cus = 0, per_cu = 0;
        hipGetDevice(&dev); hipDeviceGetAttribute(&cus, hipDeviceAttributeMultiprocessorCount, dev);
        hipFuncSetAttribute((const void*)hybrid_fwd, hipFuncAttributeMaxDynamicSharedMemorySize, LDS_BYTES);
        hipOccupancyMaxActiveBlocksPerMultiprocessor(&per_cu, (const void*)hybrid_fwd, NTHREADS, LDS_BYTES);
        (void)hipGetLastError();
        if (per_cu < 1) per_cu = 1;
        grid = cus;
        if (grid <= 0) grid = 256;
    }
    if (grid < 0) return;
    Args a{};
    for (int i = 0; i < N_IN; ++i) a.in[i] = (const float*)d_in[i];
    a.out = (float*)d_out; a.ws = (unsigned char*)d_ws;
#if MK_SPLIT
#ifndef PH_LIMIT
#define PH_LIMIT NPHASES
#endif
    for (int ph = 0; ph < PH_LIMIT; ++ph) { a.ph_lo = ph; a.ph_hi = ph + 1; hipLaunchKernelGGL(hybrid_fwd, dim3(grid), dim3(NTHREADS), LDS_BYTES, stream, a); }
#ifdef DUMP_OFF
    hipLaunchKernelGGL(dump_kernel, dim3(2048), dim3(256), 0, stream, (const unsigned short*)((unsigned char*)d_ws + (DUMP_OFF)), (float*)d_out, (size_t)MT * DUMP_COLS, (size_t)DUMP_LD, (size_t)DUMP_COLS);
#endif
#else
    a.ph_lo = 0; a.ph_hi = NPHASES;
    if (hipMemsetAsync(d_ws, 0, XCD_BAR_WORDS * sizeof(unsigned), stream) != hipSuccess) { fprintf(stderr, "kernel_launch: memset of the barrier words failed\n"); return; }
    void* kargs[] = {&a};
    hipError_t e = hipLaunchCooperativeKernel((const void*)hybrid_fwd, dim3(grid), dim3(NTHREADS), kargs, LDS_BYTES, stream);
    if (e != hipSuccess) fprintf(stderr, "cooperative launch failed: %s (grid %d)\n", hipGetErrorString(e), grid);
#endif
}
```
